# Optimizing an MI355X kernel written in HIP

```python
import math
import jax, jax.numpy as jnp
from jax import lax
import numpy as np

D_MODEL = 1024
BATCH = 8
SEQ = 2048
DEPTH = 1
DEC_BATCH = 128
DEC_SEQ = 4
PAST_LEN = 16384
PAGE_SIZE = 128

D_CONV = D_MODEL
CONV_W = 3
N_HEADS = 4
D_HEAD = D_MODEL // N_HEADS
D_MLSTM = N_HEADS * D_HEAD
D_FF = 4 * D_MODEL
CHUNK = 128
LN_EPS = 1e-5
ALPHA = (2.0 * DEPTH) ** 0.25
BETA = (8.0 * DEPTH) ** -0.25
F_BIAS_LO = 3.0
F_BIAS_HI = 6.0
D_IN = 3 * D_CONV + 4 * D_MLSTM + 2 * N_HEADS + 2 * D_MODEL

kernel_name = "hybrid_shortconv_mlstm_gated_merge_step"


def _split_points():
    sizes = (D_CONV, D_CONV, D_CONV, D_MLSTM, D_MLSTM, D_MLSTM, D_MLSTM,
             N_HEADS, N_HEADS, D_MODEL, D_MODEL)
    pts, acc = [], 0
    for s in sizes[:-1]:
        acc += s
        pts.append(acc)
    return pts


def layer_norm(x, g, b):
    xf = x.astype(jnp.float32)
    mu = jnp.mean(xf, axis=-1, keepdims=True)
    xc = xf - mu
    var = jnp.mean(xc * xc, axis=-1, keepdims=True)
    y = xc * lax.rsqrt(var + LN_EPS) * g.astype(jnp.float32) + b.astype(jnp.float32)
    return y.astype(x.dtype)


def short_conv(u, buf, w):
    T = u.shape[1]
    up = jnp.concatenate([buf.astype(u.dtype), u], axis=1)
    y = up[:, 0:T] * w[0]
    for j in range(1, CONV_W):
        y = y + up[:, j:j + T] * w[j]
    return y, up[:, -(CONV_W - 1):]


def mlstm_chunkwise(q, k, v, logi, logf, C0, n0, m0, chunk):
    Bsz, T, H, D = q.shape
    nc = T // chunk
    L = chunk

    def to_chunks(a):
        return a.reshape(Bsz, nc, L, H, D).transpose(1, 0, 3, 2, 4)

    def g_chunks(a):
        return a.reshape(Bsz, nc, L, H).transpose(1, 0, 3, 2)

    mask = jnp.tril(jnp.ones((L, L), dtype=bool))

    def step(carry, xs):
        C, n, m = carry
        qc, kc, vc, ic, fc = xs
        b = jnp.cumsum(fc, axis=-1)
        inter = b + m[..., None]
        Dm = b[..., :, None] - b[..., None, :] + ic[..., None, :]
        Dm = jnp.where(mask, Dm, -jnp.inf)
        m_t = jnp.maximum(inter, jnp.max(Dm, axis=-1))
        w_inter = jnp.exp(inter - m_t)
        S = jnp.einsum('bhtd,bhsd->bhts', qc, kc) * jnp.exp(Dm - m_t[..., None])
        num = (w_inter[..., None] * jnp.einsum('bhtd,bhdv->bhtv', qc, C)
               + jnp.einsum('bhts,bhsv->bhtv', S, vc))
        den = w_inter * jnp.einsum('bhtd,bhd->bht', qc, n) + jnp.sum(S, axis=-1)
        h = num / jnp.maximum(jnp.abs(den), jnp.exp(-m_t))[..., None]
        m_new = m_t[..., -1]
        decay = jnp.exp(b[..., -1] + m - m_new)
        ws = jnp.exp(ic + b[..., -1:] - b - m_new[..., None])
        C_new = decay[..., None, None] * C + jnp.einsum('bhs,bhsd,bhsv->bhdv', ws, kc, vc)
        n_new = decay[..., None] * n + jnp.einsum('bhs,bhsd->bhd', ws, kc)
        return (C_new, n_new, m_new), h

    (C, n, m), hs = lax.scan(step, (C0, n0, m0),
                             (to_chunks(q), to_chunks(k), to_chunks(v), g_chunks(logi), g_chunks(logf)))
    h = hs.transpose(1, 0, 3, 2, 4).reshape(Bsz, T, H, D)
    return h, C, n, m


def hybrid_layer(x, conv_buf, C0, n0, m0, chunk, w_in, b_gate, conv_w, w_conv_out, mh_g,
                 w_m_out, w_o, ln1_g, ln1_b, w_ff1, w_ff2, ln2_g, ln2_b):
    Bsz, T, _ = x.shape
    f32 = jnp.float32
    z = x @ w_in
    (bg, cg, hc, q, k, v, o, ig, fg, gc, gm) = jnp.split(z, _split_points(), axis=-1)
    conv, new_buf = short_conv(cg * hc, conv_buf, conv_w)
    y_conv = (bg * conv) @ w_conv_out
    qf = q.reshape(Bsz, T, N_HEADS, D_HEAD).astype(f32)
    kf = k.reshape(Bsz, T, N_HEADS, D_HEAD).astype(f32) * (D_HEAD ** -0.5)
    vf = v.reshape(Bsz, T, N_HEADS, D_HEAD).astype(f32)
    bgf = b_gate.astype(f32)
    logi = ig.astype(f32) + bgf[:N_HEADS]
    logf = jax.nn.log_sigmoid(fg.astype(f32) + bgf[N_HEADS:])
    h, C, n, m = mlstm_chunkwise(qf, kf, vf, logi, logf, C0.astype(f32), n0.astype(f32),
                                 m0.astype(f32), chunk)
    mu = jnp.mean(h, axis=-1, keepdims=True)
    hc_ = h - mu
    h = hc_ * lax.rsqrt(jnp.mean(hc_ * hc_, axis=-1, keepdims=True) + LN_EPS)
    h = h.reshape(Bsz, T, D_MLSTM) * mh_g.astype(f32) * jax.nn.sigmoid(o.astype(f32))
    y_m = h.astype(x.dtype) @ w_m_out
    merged = jax.nn.sigmoid(gc) * y_conv + jax.nn.sigmoid(gm) * y_m
    x1 = layer_norm(ALPHA * x + merged @ w_o, ln1_g, ln1_b)
    hid = jnp.square(jax.nn.relu(x1 @ w_ff1))
    x2 = layer_norm(ALPHA * x1 + hid @ w_ff2, ln2_g, ln2_b)
    dt = x.dtype
    return x2, new_buf.astype(dt), C.astype(dt), n.astype(dt), m.astype(dt)


def setup_inputs(seed: int = 0) -> dict:
    key = jax.random.key(seed)
    ks = jax.random.split(key, 24)
    nrm = lambda kk, shape, s: jax.random.normal(kk, shape, jnp.float32) * s
    f_bias = jnp.linspace(F_BIAS_LO, F_BIAS_HI, N_HEADS, dtype=jnp.float32)
    b_gate = jnp.concatenate([
        nrm(ks[9], (DEPTH, N_HEADS), 0.1),
        f_bias[None, :] + nrm(ks[10], (DEPTH, N_HEADS), 0.1)], axis=-1)
    return {
        "x_prompt": nrm(ks[0], (BATCH, SEQ, D_MODEL), 1.0),
        "x_sample": nrm(ks[1], (DEC_BATCH, DEC_SEQ, D_MODEL), 1.0),
        "state_conv": nrm(ks[2], (DEPTH, DEC_BATCH, CONV_W - 1, D_CONV), 1.0),
        "state_C": nrm(ks[3], (DEPTH, DEC_BATCH, N_HEADS, D_HEAD, D_HEAD), 0.1),
        "state_n": nrm(ks[4], (DEPTH, DEC_BATCH, N_HEADS, D_HEAD), 0.1),
        "state_m": 1.0 + nrm(ks[5], (DEPTH, DEC_BATCH, N_HEADS), 0.5),
        "w_in": nrm(ks[6], (DEPTH, D_MODEL, D_IN), D_MODEL ** -0.5),
        "b_gate": b_gate,
        "conv_w": nrm(ks[7], (DEPTH, CONV_W, D_CONV), CONV_W ** -0.5),
        "w_conv_out": nrm(ks[8], (DEPTH, D_CONV, D_MODEL), BETA * D_CONV ** -0.5),
        "mh_g": 1.0 + nrm(ks[11], (DEPTH, D_MLSTM), 0.02),
        "w_m_out": nrm(ks[12], (DEPTH, D_MLSTM, D_MODEL), BETA * D_MLSTM ** -0.5),
        "w_o": nrm(ks[13], (DEPTH, D_MODEL, D_MODEL), BETA * D_MODEL ** -0.5),
        "ln1_g": 1.0 + nrm(ks[14], (DEPTH, D_MODEL), 0.02),
        "ln1_b": nrm(ks[15], (DEPTH, D_MODEL), 0.02),
        "w_ff1": nrm(ks[16], (DEPTH, D_MODEL, D_FF), BETA * D_MODEL ** -0.5),
        "w_ff2": nrm(ks[17], (DEPTH, D_FF, D_MODEL), BETA * D_FF ** -0.5),
        "ln2_g": 1.0 + nrm(ks[18], (DEPTH, D_MODEL), 0.02),
        "ln2_b": nrm(ks[19], (DEPTH, D_MODEL), 0.02),
    }


def reference(x_prompt, x_sample, state_conv, state_C, state_n, state_m, w_in, b_gate, conv_w,
              w_conv_out, mh_g, w_m_out, w_o, ln1_g, ln1_b, w_ff1, w_ff2, ln2_g, ln2_b):
    dt = x_prompt.dtype
    chunk_p = CHUNK if SEQ % CHUNK == 0 else SEQ
    xp, xs = x_prompt, x_sample
    cp_l, cs_l, Cp_l, Cs_l, np_l, ns_l, mp_l, ms_l = [], [], [], [], [], [], [], []
    for l in range(DEPTH):
        params = (w_in[l], b_gate[l], conv_w[l], w_conv_out[l], mh_g[l], w_m_out[l], w_o[l],
                  ln1_g[l], ln1_b[l], w_ff1[l], w_ff2[l], ln2_g[l], ln2_b[l])
        xp, cp, Cp, np_, mp = hybrid_layer(
            xp, jnp.zeros((BATCH, CONV_W - 1, D_CONV), dt),
            jnp.zeros((BATCH, N_HEADS, D_HEAD, D_HEAD), jnp.float32),
            jnp.zeros((BATCH, N_HEADS, D_HEAD), jnp.float32),
            jnp.zeros((BATCH, N_HEADS), jnp.float32), chunk_p, *params)
        xs, cs, Cs, ns, ms = hybrid_layer(
            xs, state_conv[l], state_C[l], state_n[l], state_m[l], DEC_SEQ, *params)
        cp_l.append(cp); cs_l.append(cs); Cp_l.append(Cp); Cs_l.append(Cs)
        np_l.append(np_); ns_l.append(ns); mp_l.append(mp); ms_l.append(ms)
    return (xp, xs, jnp.stack(cp_l), jnp.stack(cs_l), jnp.stack(Cp_l), jnp.stack(Cs_l),
            jnp.stack(np_l), jnp.stack(ns_l), jnp.stack(mp_l), jnp.stack(ms_l))
```

```cpp
#include <hip/hip_runtime.h>
#include <hip/hip_cooperative_groups.h>
#include <cstdio>
namespace cg = cooperative_groups;

#ifndef PHMASK
#define PHMASK 1023
#endif
#ifndef MK_MULTI
#define MK_MULTI 0
#endif

#define LAS __attribute__((address_space(3)))
typedef unsigned short bf16_t;
typedef short bf16x8 __attribute__((ext_vector_type(8)));
typedef float f32x4 __attribute__((ext_vector_type(4)));
typedef float f32x2 __attribute__((ext_vector_type(2)));
typedef unsigned u32x4 __attribute__((ext_vector_type(4)));
typedef unsigned u32x2 __attribute__((ext_vector_type(2)));

constexpr int DM = 1024, NPROMPT = 8 * 2048, NSAMPLE = 128 * 4, NTOK = NPROMPT + NSAMPLE;
constexpr int SEQ = 2048, NH = 4, DH = 256, DFF = 4096, DIN = 9224, NZ = 9216, ZC = 8192;
constexpr float ALPHA = 1.189207115002721f;
constexpr float LN_EPS = 1e-5f;
constexpr int Z_BG = 0, Z_U = 1024, Z_Q = 2048, Z_K = 3072, Z_V = 4096, Z_O = 5120, Z_GC = 6144, Z_GM = 7168;
constexpr size_t O_Y = 0, O_CONVP = 17301504, O_CONVS = 17317888, O_CP = 17580032, O_CS = 19677184, O_NP = 53231616, O_NS = 53239808, O_MP = 53370880, O_MS = 53370912;
constexpr size_t SZ_ACT = (size_t)NTOK * DM * 2;
constexpr size_t WS_XB = 0;
constexpr size_t WS_WIN = WS_XB + SZ_ACT;
constexpr size_t WS_WC = WS_WIN + (size_t)NZ * DM * 2;
constexpr size_t WS_WM = WS_WC + (size_t)DM * DM * 2;
constexpr size_t WS_WO = WS_WM + (size_t)DM * DM * 2;
constexpr size_t WS_W1 = WS_WO + (size_t)DM * DM * 2;
constexpr size_t WS_W2 = WS_W1 + (size_t)DFF * DM * 2;
constexpr size_t WS_G = WS_W2 + (size_t)DFF * DM * 2;
constexpr size_t WS_Z = WS_G + (size_t)NTOK * 8 * 4;
constexpr size_t WS_HID = WS_Z;
constexpr size_t WS_R = WS_Z + (size_t)NTOK * DFF * 2;
constexpr size_t WS_KT = WS_Z + (size_t)NTOK * ZC * 2;
constexpr size_t WS_H = WS_KT + (size_t)32 * 256 * 2048 * 2;
constexpr size_t WS_AC = WS_H + SZ_ACT;
constexpr size_t WS_HN = WS_AC + SZ_ACT;
constexpr size_t WS_END = WS_HN + SZ_ACT;
constexpr int LDS_BYTES = 131072;

struct Params {
    const float *xp, *xs, *sconv, *sC, *sn, *sm, *w_in, *b_gate, *conv_w, *w_co, *mh_g, *w_mo, *w_o, *ln1g, *ln1b, *w_ff1, *w_ff2, *ln2g, *ln2b;
    float* out; unsigned char* ws; int ph_lo, ph_hi;
};

__device__ __forceinline__ unsigned cvt_pk_bf16(float lo, float hi) { unsigned r; asm volatile("v_cvt_pk_bf16_f32 %0, %1, %2" : "=v"(r) : "v"(lo), "v"(hi)); return r; }
__device__ __forceinline__ float bf_lo(unsigned w) { return __uint_as_float(w << 16); }
__device__ __forceinline__ float bf_hi(unsigned w) { return __uint_as_float(w & 0xffff0000u); }
__device__ __forceinline__ float bf2f(bf16_t b) { return __uint_as_float(((unsigned)b) << 16); }
__device__ __forceinline__ float sigmoidf_(float x) { return 1.0f / (1.0f + __expf(-x)); }
__device__ __forceinline__ float wave_sum(float v) {
#pragma unroll
    for (int o = 1; o < 64; o <<= 1) v += __shfl_xor(v, o);
    return v;
}
__device__ __forceinline__ const float* xrow(const Params& p, int r) { return r < NPROMPT ? p.xp + (size_t)r * DM : p.xs + (size_t)(r - NPROMPT) * DM; }
#define LDS_WAIT() asm volatile("s_waitcnt lgkmcnt(0)" ::: "memory")

namespace pg8 {
constexpr int BM = 256, BK = 64, HALF = 128, HTB = HALF * BK * 2, NXCD = 8, WGM = 8;
__host__ __device__ __forceinline__ int lds_byte(int r, int c) { const int st = (r >> 4) * 2 + (c >> 5), rr = r & 15, cc = c & 31, ob = rr * 64 + cc * 2; return st * 1024 + (ob ^ (((ob >> 9) & 1) << 5)); }
__host__ __device__ __forceinline__ void stage_rc(int b, int& R, int& C) { const int st = b / 1024, sb = b % 1024, swz = sb ^ (((sb >> 9) & 1) << 5); R = (st >> 1) * 16 + swz / 64; C = (st & 1) * 32 + (swz % 64) / 2; }
__host__ __device__ __forceinline__ int perm32(int rho) { const int n = rho >> 4, i = rho & 15; return 8 * (i >> 2) + 4 * n + (i & 3); }
struct Unit { int pm, pn; };
struct Gemm { const bf16_t* A; const bf16_t* Bt; int M, N, K; };
struct StaticOrder {
    int nM, nN, nwg, G, c;
    __device__ void init(int M, int N, int G_, int c_) { nM = M / BM; nN = N / BM; nwg = nM * nN; G = G_; c = c_; }
    __device__ bool next(int i, Unit& u) const {
        const long L = (long)i * G + c; if (L >= nwg) return false;
        int wgid = (int)L; { const int q = nwg / NXCD, r = nwg % NXCD, xcd = wgid % NXCD, off = wgid / NXCD; wgid = (xcd < r ? xcd * (q + 1) : r * (q + 1) + (xcd - r) * q) + off; }
        const int nig = WGM * nN, gid = wgid / nig, fm = gid * WGM, gsz = (nM - fm) < WGM ? (nM - fm) : WGM;
        u.pm = fm + ((wgid % nig) % gsz); u.pn = (wgid % nig) / gsz; return true;
    }
};

template <class Epi>
__device__ __forceinline__ void gemm_phase(LAS unsigned char* lds, const Gemm g, const StaticOrder& S, const Epi& E) {
    const int tid = threadIdx.x, wid = __builtin_amdgcn_readfirstlane(tid >> 6), lane = tid & 63, wr = wid >> 2, wc = wid & 3, fr = lane & 15, fq = lane >> 4;
    const int K = g.K, nt = K / BK;
    unsigned voffA[2], voffB[2];
#pragma unroll
    for (int i = 0; i < 2; ++i) { int R, C; stage_rc(tid * 16 + i * 8192, R, C); const int Rb = (R & ~31) + perm32(R & 31);
        voffA[i] = (unsigned)(R * K + C) * 2u; voffB[i] = (unsigned)(Rb * K + C) * 2u; }
    const size_t kstep = (size_t)(BK * 2);
    const size_t hstep = (size_t)HALF * K * 2;
    const size_t tstep = 2 * hstep;
    const unsigned ldsw = (unsigned)wid * 1024u;
    const int aoff = lds_byte(wr * 64 + fr, fq * 8), boff = lds_byte(wc * 32 + fr, fq * 8);
#define PG8_SA(b, h) (((b) * 2 + (h)) * HTB)
#define PG8_SB(b, h) ((4 + (b) * 2 + (h)) * HTB)
#define PG8_STAGE(bufoff, gbase, voff) do { _Pragma("unroll") for (int _i = 0; _i < 2; ++_i) \
        __builtin_amdgcn_global_load_lds((const unsigned*)((const char*)(gbase) + (voff)[_i]), (LAS unsigned*)(lds + (bufoff) + ldsw + _i * 8192), 16, 0, 0); } while (0)
#define PG8_LDA(dst, b, h) do { _Pragma("unroll") for (int m = 0; m < 4; ++m) _Pragma("unroll") for (int k = 0; k < 2; ++k) dst[m][k] = *(const LAS bf16x8*)(lds + PG8_SA(b, h) + aoff + m * 2048 + k * 1024); } while (0)
#define PG8_LDB(dst, b, h) do { _Pragma("unroll") for (int n = 0; n < 2; ++n) _Pragma("unroll") for (int k = 0; k < 2; ++k) dst[n][k] = *(const LAS bf16x8*)(lds + PG8_SB(b, h) + boff + n * 2048 + k * 1024); } while (0)
#define PG8_MMA(ai, bj, At, Bt) do { __builtin_amdgcn_s_setprio(1); _Pragma("unroll") for (int m = 0; m < 4; ++m) _Pragma("unroll") for (int n = 0; n < 2; ++n) _Pragma("unroll") for (int k = 0; k < 2; ++k) \
        acc[ai][bj][m][n] = __builtin_amdgcn_mfma_f32_16x16x32_bf16(Bt[n][k], At[m][k], acc[ai][bj][m][n], 0, 0, 0); __builtin_amdgcn_s_setprio(0); } while (0)
#define PG8_WAIT_V(n) asm volatile("s_waitcnt vmcnt(" #n ")" ::: "memory")
#define PG8_WAIT_L(n) asm volatile("s_waitcnt lgkmcnt(" #n ")" ::: "memory")
#define PG8_BAR __builtin_amdgcn_s_barrier()
#define PG8_SCHED __builtin_amdgcn_sched_barrier(0)
    Unit cur, nxt; int ui = 0;
    if (!S.next(0, cur)) return;
    f32x4 acc[2][2][4][2];
#pragma unroll
    for (int a = 0; a < 2; ++a)
#pragma unroll
        for (int b = 0; b < 2; ++b)
#pragma unroll
            for (int m = 0; m < 4; ++m)
#pragma unroll
                for (int n = 0; n < 2; ++n) acc[a][b][m][n] = (f32x4){0.f, 0.f, 0.f, 0.f};
    bf16x8 At[4][2], B0[2][2], B1[2][2];
    const char* cA = (const char*)g.A + (size_t)cur.pm * tstep; const char* cB = (const char*)g.Bt + (size_t)cur.pn * tstep;
    PG8_STAGE(PG8_SB(0, 0), cB, voffB); PG8_STAGE(PG8_SA(0, 0), cA, voffA); PG8_STAGE(PG8_SB(0, 1), cB + hstep, voffB); PG8_STAGE(PG8_SA(0, 1), cA + hstep, voffA);
    if (wr == 1) PG8_BAR;
    PG8_WAIT_V(4); PG8_BAR;
    PG8_STAGE(PG8_SB(1, 0), cB + kstep, voffB); PG8_STAGE(PG8_SA(1, 0), cA + kstep, voffA); PG8_STAGE(PG8_SB(1, 1), cB + hstep + kstep, voffB);
    PG8_WAIT_V(6); PG8_BAR;
    for (;;) {
        const bool has_next = S.next(ui + 1, nxt);
        const char* nA = has_next ? (const char*)g.A + (size_t)nxt.pm * tstep : cA; const char* nB = has_next ? (const char*)g.Bt + (size_t)nxt.pn * tstep : cB;
        for (int t = 0; t < nt; t += 2) {
            const bool last = (t == nt - 2);
            const char* a1 = cA + (size_t)(t + 1) * kstep;
            const char* a2 = last ? nA : cA + (size_t)(t + 2) * kstep; const char* b2 = last ? nB : cB + (size_t)(t + 2) * kstep;
            const char* a3 = a2 + kstep; const char* b3 = b2 + kstep;
            PG8_LDB(B0, 0, 0); PG8_SCHED; PG8_LDA(At, 0, 0); PG8_STAGE(PG8_SA(1, 1), a1 + hstep, voffA);
            PG8_WAIT_L(8); PG8_BAR; PG8_WAIT_L(0); PG8_MMA(0, 0, At, B0); PG8_BAR; PG8_SCHED;
            PG8_LDB(B1, 0, 1); PG8_STAGE(PG8_SB(0, 0), b2, voffB);
            PG8_BAR; PG8_WAIT_L(0); PG8_MMA(0, 1, At, B1); PG8_BAR;
            PG8_LDA(At, 0, 1); PG8_STAGE(PG8_SA(0, 0), a2, voffA);
            PG8_BAR; PG8_WAIT_L(0); PG8_MMA(1, 0, At, B0); PG8_BAR; PG8_SCHED;
            PG8_STAGE(PG8_SB(0, 1), b2 + hstep, voffB);
            PG8_WAIT_V(6); PG8_BAR; PG8_MMA(1, 1, At, B1); PG8_BAR;
            PG8_LDB(B0, 1, 0); PG8_SCHED; PG8_LDA(At, 1, 0); PG8_STAGE(PG8_SA(0, 1), a2 + hstep, voffA);
            PG8_WAIT_L(8); PG8_BAR; PG8_WAIT_L(0); PG8_MMA(0, 0, At, B0); PG8_BAR; PG8_SCHED;
            PG8_LDB(B1, 1, 1); PG8_STAGE(PG8_SB(1, 0), b3, voffB);
            PG8_BAR; PG8_WAIT_L(0); PG8_MMA(0, 1, At, B1); PG8_BAR;
            PG8_LDA(At, 1, 1); PG8_STAGE(PG8_SA(1, 0), a3, voffA);
            PG8_BAR; PG8_WAIT_L(0); PG8_MMA(1, 0, At, B0); PG8_BAR; PG8_SCHED;
            PG8_STAGE(PG8_SB(1, 1), b3 + hstep, voffB);
            PG8_WAIT_V(6); PG8_BAR; PG8_MMA(1, 1, At, B1); PG8_BAR;
        }
        E(acc, cur, wr, wc, fr, fq);
        if (!has_next) break;
#pragma unroll
        for (int a = 0; a < 2; ++a)
#pragma unroll
            for (int b = 0; b < 2; ++b)
#pragma unroll
                for (int m = 0; m < 4; ++m)
#pragma unroll
                    for (int n = 0; n < 2; ++n) acc[a][b][m][n] = (f32x4){0.f, 0.f, 0.f, 0.f};
        cur = nxt; cA = nA; cB = nB; ++ui;
    }
    PG8_WAIT_V(0);
    if (wr == 0) PG8_BAR;
    PG8_BAR;
#undef PG8_SA
#undef PG8_SB
#undef PG8_STAGE
#undef PG8_LDA
#undef PG8_LDB
#undef PG8_MMA
#undef PG8_WAIT_V
#undef PG8_WAIT_L
#undef PG8_BAR
#undef PG8_SCHED
}
}
using pg8::Unit;

#define EPI_LOOP_BEGIN \
    _Pragma("unroll") for (int ai = 0; ai < 2; ++ai) _Pragma("unroll") for (int m = 0; m < 4; ++m) { const int row = u.pm * 256 + ai * 128 + wr * 64 + m * 16 + fr; \
    _Pragma("unroll") for (int bj = 0; bj < 2; ++bj) { const int lc = bj * 128 + wc * 32 + 8 * fq; const f32x4 v0 = acc[ai][bj][m][0], v1 = acc[ai][bj][m][1];
#define EPI_LOOP_END } }

struct EpiZ {
    bf16_t* Z; bf16_t* KT;
    __device__ __forceinline__ void operator()(const f32x4 (&acc)[2][2][4][2], const Unit& u, int wr, int wc, int fr, int fq) const {
        const int pn = u.pn;
        if (pn >= 4 && pn < 12) {
#pragma unroll
            for (int ai = 0; ai < 2; ++ai)
#pragma unroll
                for (int m = 0; m < 4; ++m) { const int row = u.pm * 256 + ai * 128 + wr * 64 + m * 16 + fr;
                    const f32x4 a0 = acc[ai][0][m][0] * acc[ai][1][m][0], a1 = acc[ai][0][m][1] * acc[ai][1][m][1];
                    u32x4 w; w.x = cvt_pk_bf16(a0[0], a0[1]); w.y = cvt_pk_bf16(a0[2], a0[3]); w.z = cvt_pk_bf16(a1[0], a1[1]); w.w = cvt_pk_bf16(a1[2], a1[3]);
                    *(u32x4*)(Z + (size_t)row * ZC + Z_U + (pn - 4) * 128 + wc * 32 + 8 * fq) = w; }
            return;
        }
        const int zc0 = pn < 4 ? pn * 256 : Z_Q + (pn - 12) * 256;
        const int grp = pn < 4 ? -1 : (pn - 12) >> 2;
        EPI_LOOP_BEGIN
            f32x4 a0 = v0, a1 = v1;
            if (grp >= 3) {
#pragma unroll
                for (int j = 0; j < 4; ++j) { a0[j] = sigmoidf_(a0[j]); a1[j] = sigmoidf_(a1[j]); }
            }
            u32x4 w; w.x = cvt_pk_bf16(a0[0], a0[1]); w.y = cvt_pk_bf16(a0[2], a0[3]); w.z = cvt_pk_bf16(a1[0], a1[1]); w.w = cvt_pk_bf16(a1[2], a1[3]);
            *(u32x4*)(Z + (size_t)row * ZC + zc0 + lc) = w;
            if (grp == 1 && row < NPROMPT) {
                const int b = row >> 11, t = row & 2047, hd = (pn - 16) * 256 + lc;
                bf16_t* kt = KT + ((size_t)(b * 1024 + hd)) * SEQ + t;
                kt[0 * SEQ] = (bf16_t)(w.x & 0xffff); kt[1 * SEQ] = (bf16_t)(w.x >> 16); kt[2 * SEQ] = (bf16_t)(w.y & 0xffff); kt[3 * SEQ] = (bf16_t)(w.y >> 16);
                kt[4 * SEQ] = (bf16_t)(w.z & 0xffff); kt[5 * SEQ] = (bf16_t)(w.z >> 16); kt[6 * SEQ] = (bf16_t)(w.w & 0xffff); kt[7 * SEQ] = (bf16_t)(w.w >> 16);
            }
        EPI_LOOP_END
    }
};
struct EpiGate {
    bf16_t* O; const bf16_t* T; const bf16_t* Z; int gcol; int add;
    __device__ __forceinline__ void operator()(const f32x4 (&acc)[2][2][4][2], const Unit& u, int wr, int wc, int fr, int fq) const {
        EPI_LOOP_BEGIN
            const int col = u.pn * 256 + lc;
            const u32x4 gw = *(const u32x4*)(Z + (size_t)row * ZC + gcol + col);
            f32x4 a0, a1;
            a0[0] = bf_lo(gw.x) * v0[0]; a0[1] = bf_hi(gw.x) * v0[1]; a0[2] = bf_lo(gw.y) * v0[2]; a0[3] = bf_hi(gw.y) * v0[3];
            a1[0] = bf_lo(gw.z) * v1[0]; a1[1] = bf_hi(gw.z) * v1[1]; a1[2] = bf_lo(gw.w) * v1[2]; a1[3] = bf_hi(gw.w) * v1[3];
            if (add) { const u32x4 tw = *(const u32x4*)(T + (size_t)row * DM + col);
                a0[0] += bf_lo(tw.x); a0[1] += bf_hi(tw.x); a0[2] += bf_lo(tw.y); a0[3] += bf_hi(tw.y); a1[0] += bf_lo(tw.z); a1[1] += bf_hi(tw.z); a1[2] += bf_lo(tw.w); a1[3] += bf_hi(tw.w); }
            u32x4 w; w.x = cvt_pk_bf16(a0[0], a0[1]); w.y = cvt_pk_bf16(a0[2], a0[3]); w.z = cvt_pk_bf16(a1[0], a1[1]); w.w = cvt_pk_bf16(a1[2], a1[3]);
            *(u32x4*)(O + (size_t)row * DM + col) = w;
        EPI_LOOP_END
    }
};
struct EpiResX {
    float* R; const float* xp; const float* xs;
    __device__ __forceinline__ void operator()(const f32x4 (&acc)[2][2][4][2], const Unit& u, int wr, int wc, int fr, int fq) const {
        EPI_LOOP_BEGIN
            const int col = u.pn * 256 + lc;
            const float* xr = (row < NPROMPT ? xp + (size_t)row * DM : xs + (size_t)(row - NPROMPT) * DM) + col;
            const f32x4 x0 = *(const f32x4*)xr, x1 = *(const f32x4*)(xr + 4);
            *(f32x4*)(R + (size_t)row * DM + col) = x0 * ALPHA + v0; *(f32x4*)(R + (size_t)row * DM + col + 4) = x1 * ALPHA + v1;
        EPI_LOOP_END
    }
};
struct EpiResB {
    float* R; const bf16_t* X1;
    __device__ __forceinline__ void operator()(const f32x4 (&acc)[2][2][4][2], const Unit& u, int wr, int wc, int fr, int fq) const {
        EPI_LOOP_BEGIN
            const int col = u.pn * 256 + lc;
            const u32x4 xw = *(const u32x4*)(X1 + (size_t)row * DM + col);
            f32x4 a0, a1;
            a0[0] = bf_lo(xw.x) * ALPHA + v0[0]; a0[1] = bf_hi(xw.x) * ALPHA + v0[1]; a0[2] = bf_lo(xw.y) * ALPHA + v0[2]; a0[3] = bf_hi(xw.y) * ALPHA + v0[3];
            a1[0] = bf_lo(xw.z) * ALPHA + v1[0]; a1[1] = bf_hi(xw.z) * ALPHA + v1[1]; a1[2] = bf_lo(xw.w) * ALPHA + v1[2]; a1[3] = bf_hi(xw.w) * ALPHA + v1[3];
            *(f32x4*)(R + (size_t)row * DM + col) = a0; *(f32x4*)(R + (size_t)row * DM + col + 4) = a1;
        EPI_LOOP_END
    }
};
struct EpiHid {
    bf16_t* Hd;
    __device__ __forceinline__ void operator()(const f32x4 (&acc)[2][2][4][2], const Unit& u, int wr, int wc, int fr, int fq) const {
        EPI_LOOP_BEGIN
            const int col = u.pn * 256 + lc;
            f32x4 a0, a1;
#pragma unroll
            for (int j = 0; j < 4; ++j) { const float r0 = fmaxf(v0[j], 0.f), r1 = fmaxf(v1[j], 0.f); a0[j] = r0 * r0; a1[j] = r1 * r1; }
            u32x4 w; w.x = cvt_pk_bf16(a0[0], a0[1]); w.y = cvt_pk_bf16(a0[2], a0[3]); w.z = cvt_pk_bf16(a1[0], a1[1]); w.w = cvt_pk_bf16(a1[2], a1[3]);
            *(u32x4*)(Hd + (size_t)row * DFF + col) = w;
        EPI_LOOP_END
    }
};

__device__ __forceinline__ void transpose_item(const float* W, int ldw, int K, int src0, bf16_t* WT, int dst0, int kb, float scale, LAS float* scr, int lane) {
    const int k0 = kb * 64;
#pragma unroll 8
    for (int i = 0; i < 32; ++i) { const int kk = 2 * i + (lane >> 5); scr[kk * 33 + (lane & 31)] = W[(size_t)(k0 + kk) * ldw + src0 + (lane & 31)]; }
    LDS_WAIT();
    const int c = lane & 7;
#pragma unroll
    for (int j = 0; j < 4; ++j) { const int n = (lane >> 3) + 8 * j; const LAS float* s = scr + (8 * c) * 33 + n;
        u32x4 o; o.x = cvt_pk_bf16(s[0 * 33] * scale, s[1 * 33] * scale); o.y = cvt_pk_bf16(s[2 * 33] * scale, s[3 * 33] * scale);
        o.z = cvt_pk_bf16(s[4 * 33] * scale, s[5 * 33] * scale); o.w = cvt_pk_bf16(s[6 * 33] * scale, s[7 * 33] * scale);
        *(u32x4*)(WT + (size_t)(dst0 + n) * K + k0 + 8 * c) = o; }
    LDS_WAIT();
}
__device__ __forceinline__ void phase0(const Params& p, LAS unsigned char* lds) {
    const int tid = threadIdx.x, wid = tid >> 6, lane = tid & 63;
    const int gw = blockIdx.x * 8 + wid, NGW = gridDim.x * 8;
    LAS float* scr = (LAS float*)(lds + wid * 8704);
    LAS float* wg = (LAS float*)(lds + 73728);
    for (int e = tid; e < 2048; e += 512) { const int k = e >> 1, hf = e & 1; *(LAS f32x4*)(wg + k * 8 + hf * 4) = *(const f32x4*)(p.w_in + (size_t)k * DIN + 7168 + hf * 4); }
    __syncthreads();
    bf16_t* WIN = (bf16_t*)(p.ws + WS_WIN);
    constexpr int I_IN = 72 * 4 * 16, I_SQ = 32 * 16, I_F1 = 128 * 16, I_F2 = 32 * 64;
    constexpr int NITEMS = I_IN + 3 * I_SQ + I_F1 + I_F2;
    for (int it = gw; it < NITEMS; it += NGW) {
        int r = it;
        if (r < I_IN) { const int kb = r & 15, nb = r >> 4, g = nb >> 2, sub = nb & 3;
            int src; if (g < 8) src = g * 128; else if (g < 24) { const int pr = (g - 8) >> 1, hf = (g - 8) & 1; src = (hf ? 2048 : 1024) + pr * 128; } else if (g < 56) src = 3072 + (g - 24) * 128; else src = 7176 + (g - 56) * 128;
            const float sc = (g >= 32 && g < 40) ? 0.0625f : 1.0f;
            transpose_item(p.w_in, DIN, DM, src + sub * 32, WIN, g * 128 + sub * 32, kb, sc, scr, lane); continue; }
        r -= I_IN;
        if (r < 3 * I_SQ) { const int w = r / I_SQ, q = r % I_SQ, kb = q & 15, nb = q >> 4;
            const float* W = w == 0 ? p.w_co : (w == 1 ? p.w_mo : p.w_o); bf16_t* WT = (bf16_t*)(p.ws + (w == 0 ? WS_WC : (w == 1 ? WS_WM : WS_WO)));
            transpose_item(W, DM, DM, nb * 32, WT, nb * 32, kb, 1.0f, scr, lane); continue; }
        r -= 3 * I_SQ;
        if (r < I_F1) { const int kb = r & 15, nb = r >> 4; transpose_item(p.w_ff1, DFF, DM, nb * 32, (bf16_t*)(p.ws + WS_W1), nb * 32, kb, 1.0f, scr, lane); continue; }
        r -= I_F1;
        { const int kb = r & 63, nb = r >> 6; transpose_item(p.w_ff2, DM, DFF, nb * 32, (bf16_t*)(p.ws + WS_W2), nb * 32, kb, 1.0f, scr, lane); }
    }
    bf16_t* XB = (bf16_t*)(p.ws + WS_XB); float* G = (float*)(p.ws + WS_G);
    for (int r = gw; r < NTOK; r += NGW) {
        const float* xr = xrow(p, r);
        float g8[8];
#pragma unroll
        for (int j = 0; j < 8; ++j) g8[j] = 0.f;
#pragma unroll
        for (int j = 0; j < 4; ++j) { const int k = j * 256 + lane * 4; const f32x4 v = *(const f32x4*)(xr + k);
            u32x2 w; w.x = cvt_pk_bf16(v[0], v[1]); w.y = cvt_pk_bf16(v[2], v[3]); *(u32x2*)(XB + (size_t)r * DM + k) = w;
#pragma unroll
            for (int e = 0; e < 4; ++e) { const f32x4 wa = *(const LAS f32x4*)(wg + (k + e) * 8), wb = *(const LAS f32x4*)(wg + (k + e) * 8 + 4);
#pragma unroll
                for (int q = 0; q < 4; ++q) { g8[q] += v[e] * wa[q]; g8[4 + q] += v[e] * wb[q]; } } }
#pragma unroll
        for (int j = 0; j < 8; ++j) g8[j] = wave_sum(g8[j]);
        if (lane < 4) { G[(size_t)r * 8 + lane] = g8[0] * (lane == 0) + g8[1] * (lane == 1) + g8[2] * (lane == 2) + g8[3] * (lane == 3) + p.b_gate[lane]; }
        else if (lane < 8) { const float f = g8[4] * (lane == 4) + g8[5] * (lane == 5) + g8[6] * (lane == 6) + g8[7] * (lane == 7) + p.b_gate[lane];
            G[(size_t)r * 8 + lane] = fminf(f, 0.f) - log1pf(__expf(-fabsf(f))); }
    }
    __syncthreads();
}

constexpr int KS_LD = 264, VT_LD = 136;
constexpr int L_KSH = 0, L_CT = 128 * KS_LD * 2, L_VT = L_CT + 48 * KS_LD * 2, L_VW = L_VT + 48 * VT_LD * 2, L_SC = L_VW + 48 * VT_LD * 2;
__device__ __forceinline__ void mlstm_prompt_item(const Params& p, LAS unsigned char* lds, int bh, int vs) {
    const int tid = threadIdx.x, wid = __builtin_amdgcn_readfirstlane(tid >> 6), lane = tid & 63, li = lane & 15, kg = lane >> 4;
    const int b = bh >> 2, h = bh & 3, j0 = vs * 32;
    LAS bf16_t* Ksh = (LAS bf16_t*)(lds + L_KSH); LAS bf16_t* CTsh = (LAS bf16_t*)(lds + L_CT); LAS bf16_t* VTsh = (LAS bf16_t*)(lds + L_VT); LAS bf16_t* VWsh = (LAS bf16_t*)(lds + L_VW);
    LAS float* sA = (LAS float*)(lds + L_SC); LAS float* sG = sA + 128; LAS float* sB = sG + 128;
    const bf16_t* Z = (const bf16_t*)(p.ws + WS_Z); const bf16_t* KT = (const bf16_t*)(p.ws + WS_KT); const float* G = (const float*)(p.ws + WS_G); bf16_t* H = (bf16_t*)(p.ws + WS_H);
    for (int e = tid; e < 48 * KS_LD / 2; e += 512) ((LAS unsigned*)CTsh)[e] = 0u;
    for (int e = tid; e < 16 * VT_LD; e += 512) { const int rr = e / VT_LD; VTsh[32 * VT_LD + e] = rr == 0 ? (bf16_t)0x3F80 : (bf16_t)0; VWsh[32 * VT_LD + e] = 0; }
    f32x4 Cacc[2][3];
#pragma unroll
    for (int db = 0; db < 2; ++db)
#pragma unroll
        for (int jb = 0; jb < 3; ++jb) Cacc[db][jb] = (f32x4){0.f, 0.f, 0.f, 0.f};
    float m_prev = 0.f;
    for (int c = 0; c < 16; ++c) {
        const int tok0 = b * SEQ + c * 128;
        u32x4 kp[8];
#pragma unroll
        for (int i = 0; i < 8; ++i) { const int pc = i * 512 + tid, row = pc >> 5, c8 = pc & 31; kp[i] = *(const u32x4*)(Z + (size_t)(tok0 + row) * ZC + Z_K + h * 256 + c8 * 8); }
        const int vs_s = tid >> 2, vs_q = tid & 3;
        const u32x4 vp = *(const u32x4*)(Z + (size_t)(tok0 + vs_s) * ZC + Z_V + h * 256 + j0 + vs_q * 8);
        bf16x8 qf[8];
#pragma unroll
        for (int kk = 0; kk < 8; ++kk) qf[kk] = *(const bf16x8*)(Z + (size_t)(tok0 + 16 * wid + li) * ZC + Z_Q + h * 256 + kk * 32 + kg * 8);
        bf16x8 ktf[2][4];
#pragma unroll
        for (int db = 0; db < 2; ++db)
#pragma unroll
            for (int k2 = 0; k2 < 4; ++k2) ktf[db][k2] = *(const bf16x8*)(KT + ((size_t)(bh * 256 + (2 * wid + db) * 16 + li)) * SEQ + c * 128 + k2 * 32 + kg * 8);
        if (wid == 0) {
            const float i0 = G[(size_t)(tok0 + lane) * 8 + h], f0 = G[(size_t)(tok0 + lane) * 8 + 4 + h];
            const float i1 = G[(size_t)(tok0 + 64 + lane) * 8 + h], f1 = G[(size_t)(tok0 + 64 + lane) * 8 + 4 + h];
            float b0 = f0, b1 = f1;
#pragma unroll
            for (int o = 1; o < 64; o <<= 1) { const float t0 = __shfl_up(b0, o), t1 = __shfl_up(b1, o); if (lane >= o) { b0 += t0; b1 += t1; } }
            b1 += __shfl(b0, 63);
            const float a0 = i0 - b0, a1 = i1 - b1;
            float p0 = a0, p1 = a1;
#pragma unroll
            for (int o = 1; o < 64; o <<= 1) { const float t0 = __shfl_up(p0, o), t1 = __shfl_up(p1, o); if (lane >= o) { p0 = fmaxf(p0, t0); p1 = fmaxf(p1, t1); } }
            p1 = fmaxf(p1, __shfl(p0, 63));
            sA[lane] = a0; sA[64 + lane] = a1; sG[lane] = fmaxf(m_prev, p0); sG[64 + lane] = fmaxf(m_prev, p1); sB[lane] = b0; sB[64 + lane] = b1;
        }
        __syncthreads();
        const float g_last = sG[127], b_last = sB[127];
#pragma unroll
        for (int i = 0; i < 8; ++i) { const int pc = i * 512 + tid, row = pc >> 5, c8 = pc & 31; *(LAS u32x4*)(Ksh + row * KS_LD + c8 * 8) = kp[i]; }
        {
            const float wsv = __expf(sA[vs_s] - g_last);
            const unsigned vw[4] = {vp.x, vp.y, vp.z, vp.w};
#pragma unroll
            for (int e = 0; e < 4; ++e) { const int j = vs_q * 8 + 2 * e; const float lo = bf_lo(vw[e]), hi = bf_hi(vw[e]);
                VTsh[j * VT_LD + vs_s] = (bf16_t)(vw[e] & 0xffff); VTsh[(j + 1) * VT_LD + vs_s] = (bf16_t)(vw[e] >> 16);
                const unsigned sw = cvt_pk_bf16(lo * wsv, hi * wsv);
                VWsh[j * VT_LD + vs_s] = (bf16_t)(sw & 0xffff); VWsh[(j + 1) * VT_LD + vs_s] = (bf16_t)(sw >> 16); }
            if (vs_q == 0) VWsh[32 * VT_LD + vs_s] = (bf16_t)(cvt_pk_bf16(wsv, 0.f) & 0xffff);
        }
        __syncthreads();
        {
            const int t_loc = 16 * wid + li;
            const float g_t = sG[t_loc], b_t = sB[t_loc];
            f32x4 ST[8];
#pragma unroll
            for (int sb = 0; sb < 8; ++sb) { ST[sb] = (f32x4){0.f, 0.f, 0.f, 0.f};
                if (sb <= wid) {
#pragma unroll
                    for (int kk = 0; kk < 8; ++kk) { const bf16x8 kf = *(const LAS bf16x8*)(Ksh + (sb * 16 + li) * KS_LD + kk * 32 + kg * 8);
                        ST[sb] = __builtin_amdgcn_mfma_f32_16x16x32_bf16(kf, qf[kk], ST[sb], 0, 0, 0); }
                    const f32x4 av = *(const LAS f32x4*)(sA + sb * 16 + kg * 4);
#pragma unroll
                    for (int r = 0; r < 4; ++r) { const float wgt = __expf(av[r] - g_t); const bool ok = (sb < wid) || (kg * 4 + r <= li); ST[sb][r] = ok ? ST[sb][r] * wgt : 0.f; }
                } }
            f32x4 nt[3], it[3];
#pragma unroll
            for (int jb = 0; jb < 3; ++jb) { nt[jb] = (f32x4){0.f, 0.f, 0.f, 0.f}; it[jb] = (f32x4){0.f, 0.f, 0.f, 0.f}; }
#pragma unroll
            for (int k2 = 0; k2 < 4; ++k2) if (2 * k2 <= wid) {
                u32x4 pw; pw.x = cvt_pk_bf16(ST[2 * k2][0], ST[2 * k2][1]); pw.y = cvt_pk_bf16(ST[2 * k2][2], ST[2 * k2][3]);
                pw.z = cvt_pk_bf16(ST[2 * k2 + 1][0], ST[2 * k2 + 1][1]); pw.w = cvt_pk_bf16(ST[2 * k2 + 1][2], ST[2 * k2 + 1][3]);
                bf16x8 pf; __builtin_memcpy(&pf, &pw, 16);
#pragma unroll
                for (int jb = 0; jb < 3; ++jb) { const LAS bf16_t* vr = VTsh + (jb * 16 + li) * VT_LD + k2 * 32 + kg * 4;
                    u32x4 vw4; const u32x2 lo = *(const LAS u32x2*)vr, hi = *(const LAS u32x2*)(vr + 16); vw4.x = lo.x; vw4.y = lo.y; vw4.z = hi.x; vw4.w = hi.y;
                    bf16x8 vf; __builtin_memcpy(&vf, &vw4, 16);
                    nt[jb] = __builtin_amdgcn_mfma_f32_16x16x32_bf16(vf, pf, nt[jb], 0, 0, 0); } }
#pragma unroll
            for (int kk = 0; kk < 8; ++kk)
#pragma unroll
                for (int jb = 0; jb < 3; ++jb) { const bf16x8 cf = *(const LAS bf16x8*)(CTsh + (jb * 16 + li) * KS_LD + kk * 32 + kg * 8);
                    it[jb] = __builtin_amdgcn_mfma_f32_16x16x32_bf16(cf, qf[kk], it[jb], 0, 0, 0); }
            const float w_int = __expf(m_prev - g_t);
#pragma unroll
            for (int jb = 0; jb < 3; ++jb) nt[jb] = nt[jb] + it[jb] * w_int;
            const float den = __shfl(nt[2][0], li);
            const float rden = 1.0f / fmaxf(fabsf(den), __expf(-(b_t + g_t)));
#pragma unroll
            for (int jb = 0; jb < 2; ++jb) { u32x2 w; w.x = cvt_pk_bf16(nt[jb][0] * rden, nt[jb][1] * rden); w.y = cvt_pk_bf16(nt[jb][2] * rden, nt[jb][3] * rden);
                *(u32x2*)(H + (size_t)(tok0 + t_loc) * DM + h * 256 + j0 + jb * 16 + kg * 4) = w; }
        }
        __syncthreads();
        {
            const float decay = __expf(m_prev - g_last);
#pragma unroll
            for (int db = 0; db < 2; ++db)
#pragma unroll
                for (int jb = 0; jb < 3; ++jb) Cacc[db][jb] = Cacc[db][jb] * decay;
#pragma unroll
            for (int k2 = 0; k2 < 4; ++k2)
#pragma unroll
                for (int jb = 0; jb < 3; ++jb) { const bf16x8 vf = *(const LAS bf16x8*)(VWsh + (jb * 16 + li) * VT_LD + k2 * 32 + kg * 8);
#pragma unroll
                    for (int db = 0; db < 2; ++db) Cacc[db][jb] = __builtin_amdgcn_mfma_f32_16x16x32_bf16(ktf[db][k2], vf, Cacc[db][jb], 0, 0, 0); }
#pragma unroll
            for (int db = 0; db < 2; ++db)
#pragma unroll
                for (int jb = 0; jb < 3; ++jb) { u32x2 w; w.x = cvt_pk_bf16(Cacc[db][jb][0], Cacc[db][jb][1]); w.y = cvt_pk_bf16(Cacc[db][jb][2], Cacc[db][jb][3]);
                    *(LAS u32x2*)(CTsh + (jb * 16 + li) * KS_LD + (2 * wid + db) * 16 + kg * 4) = w; }
            m_prev = b_last + g_last;
        }
    }
#pragma unroll
    for (int db = 0; db < 2; ++db) { const int d0 = (2 * wid + db) * 16 + kg * 4;
#pragma unroll
        for (int jb = 0; jb < 2; ++jb)
#pragma unroll
            for (int r = 0; r < 4; ++r) p.out[O_CP + ((size_t)(bh * 256 + d0 + r)) * 256 + j0 + jb * 16 + li] = Cacc[db][jb][r];
        if (vs == 0 && li == 0) {
#pragma unroll
            for (int r = 0; r < 4; ++r) p.out[O_NP + (size_t)bh * 256 + d0 + r] = Cacc[db][2][r]; } }
    if (vs == 0 && tid == 0) p.out[O_MP + bh] = m_prev;
    __syncthreads();
}

__device__ __forceinline__ void mlstm_sample_item(const Params& p, LAS unsigned char* lds, int item) {
    const int tid = threadIdx.x, bs = item >> 2, h = item & 3, tok0 = NPROMPT + bs * 4;
    LAS float* sq = (LAS float*)lds; LAS float* sk = sq + 1024; LAS float* sv = sk + 1024; LAS float* sn0 = sv + 1024; LAS float* sdot = sn0 + 256; LAS float* sc = sdot + 32; LAS float* sred = sc + 64;
    const bf16_t* Z = (const bf16_t*)(p.ws + WS_Z); const float* G = (const float*)(p.ws + WS_G); bf16_t* H = (bf16_t*)(p.ws + WS_H);
    for (int e = tid; e < 3072; e += 512) { const int which = e >> 10, idx = e & 1023, t = idx >> 8, d = idx & 255;
        sq[e] = bf2f(Z[(size_t)(tok0 + t) * ZC + Z_Q + which * 1024 + h * 256 + d]); }
    if (tid < 256) sn0[tid] = p.sn[(size_t)item * 256 + tid];
    __syncthreads();
    {
        const int id = tid >> 4, part = tid & 15;
        if (id < 20) { const LAS float* va = id < 16 ? sq + (id >> 2) * 256 : sq + (id - 16) * 256; const LAS float* vb = id < 16 ? sk + (id & 3) * 256 : sn0;
            float s = 0.f;
#pragma unroll
            for (int e = 0; e < 16; ++e) s += va[part * 16 + e] * vb[part * 16 + e];
            s += __shfl_xor(s, 8); s += __shfl_xor(s, 4); s += __shfl_xor(s, 2); s += __shfl_xor(s, 1);
            if (part == 0) sdot[id] = s; }
    }
    __syncthreads();
    if (tid == 0) {
        const float m0 = p.sm[item];
        float li_[4], lf_[4], bb[4], aa[4], gg[4];
#pragma unroll
        for (int s = 0; s < 4; ++s) { li_[s] = G[(size_t)(tok0 + s) * 8 + h]; lf_[s] = G[(size_t)(tok0 + s) * 8 + 4 + h]; }
        float cum = 0.f, pm = m0;
#pragma unroll
        for (int s = 0; s < 4; ++s) { cum += lf_[s]; bb[s] = cum; aa[s] = li_[s] - cum; pm = fmaxf(pm, aa[s]); gg[s] = pm; }
#pragma unroll
        for (int t = 0; t < 4; ++t) { const float wi = __expf(m0 - gg[t]); float den = wi * sdot[16 + t];
#pragma unroll
            for (int s = 0; s < 4; ++s) { const float S = s <= t ? sdot[t * 4 + s] * __expf(aa[s] - gg[t]) : 0.f; sc[16 + t * 4 + s] = S; den += S; }
            sc[t] = wi; sc[12 + t] = 1.0f / fmaxf(fabsf(den), __expf(-(bb[t] + gg[t]))); }
#pragma unroll
        for (int s = 0; s < 4; ++s) sc[4 + s] = __expf(aa[s] - gg[3]);
        sc[8] = __expf(m0 - gg[3]); sc[9] = bb[3] + gg[3];
    }
    __syncthreads();
    const float decay = sc[8]; const float ws0 = sc[4], ws1 = sc[5], ws2 = sc[6], ws3 = sc[7];
    const int c4 = tid & 63, rw = tid >> 6, col = c4 * 4;
    const f32x4 v0 = *(const LAS f32x4*)(sv + col), v1 = *(const LAS f32x4*)(sv + 256 + col), v2 = *(const LAS f32x4*)(sv + 512 + col), v3 = *(const LAS f32x4*)(sv + 768 + col);
    f32x4 a0 = {0.f, 0.f, 0.f, 0.f}, a1 = a0, a2 = a0, a3 = a0;
    const float* C0 = p.sC + (size_t)item * 65536; float* C1 = p.out + O_CS + (size_t)item * 65536;
#pragma unroll 8
    for (int r = 0; r < 32; ++r) { const int d = rw * 32 + r;
        const f32x4 cv = *(const f32x4*)(C0 + (size_t)d * 256 + col);
        a0 += cv * sq[d]; a1 += cv * sq[256 + d]; a2 += cv * sq[512 + d]; a3 += cv * sq[768 + d];
        const f32x4 cn = cv * decay + v0 * (ws0 * sk[d]) + v1 * (ws1 * sk[256 + d]) + v2 * (ws2 * sk[512 + d]) + v3 * (ws3 * sk[768 + d]);
        *(f32x4*)(C1 + (size_t)d * 256 + col) = cn; }
    *(LAS f32x4*)(sred + (rw * 4 + 0) * 256 + col) = a0; *(LAS f32x4*)(sred + (rw * 4 + 1) * 256 + col) = a1; *(LAS f32x4*)(sred + (rw * 4 + 2) * 256 + col) = a2; *(LAS f32x4*)(sred + (rw * 4 + 3) * 256 + col) = a3;
    __syncthreads();
#pragma unroll
    for (int e = 0; e < 2; ++e) { const int o = tid + 512 * e, t = o >> 8, cx = o & 255;
        float inter = 0.f;
#pragma unroll
        for (int w = 0; w < 8; ++w) inter += sred[(w * 4 + t) * 256 + cx];
        float num = sc[t] * inter;
#pragma unroll
        for (int s = 0; s < 4; ++s) num += sc[16 + t * 4 + s] * sv[s * 256 + cx];
        H[(size_t)(tok0 + t) * DM + h * 256 + cx] = (bf16_t)(cvt_pk_bf16(num * sc[12 + t], 0.f) & 0xffff); }
    if (tid < 256) p.out[O_NS + (size_t)item * 256 + tid] = decay * sn0[tid] + ws0 * sk[tid] + ws1 * sk[256 + tid] + ws2 * sk[512 + tid] + ws3 * sk[768 + tid];
    if (tid == 0) p.out[O_MS + item] = sc[9];
    __syncthreads();
}

__device__ __forceinline__ void conv_items(const Params& p) {
    const bf16_t* Z = (const bf16_t*)(p.ws + WS_Z); bf16_t* AC = (bf16_t*)(p.ws + WS_AC);
    const int gt = blockIdx.x * 512 + threadIdx.x, NG = gridDim.x * 512;
    for (int unit = gt; unit < NTOK * 128; unit += NG) {
        const int r = unit >> 7, ch = (unit & 127) * 8;
        const u32x4 uw = *(const u32x4*)(Z + (size_t)r * ZC + Z_U + ch), bw = *(const u32x4*)(Z + (size_t)r * ZC + Z_BG + ch);
        float u0[8], u1[8], u2[8], bg[8];
        const unsigned uu[4] = {uw.x, uw.y, uw.z, uw.w}, bb[4] = {bw.x, bw.y, bw.z, bw.w};
#pragma unroll
        for (int e = 0; e < 4; ++e) { u2[2 * e] = bf_lo(uu[e]); u2[2 * e + 1] = bf_hi(uu[e]); bg[2 * e] = bf_lo(bb[e]); bg[2 * e + 1] = bf_hi(bb[e]); }
        const bool prompt = r < NPROMPT; const int t = prompt ? (r & 2047) : ((r - NPROMPT) & 3); const int bs = (r - NPROMPT) >> 2;
        if (t >= 1) { const u32x4 w = *(const u32x4*)(Z + (size_t)(r - 1) * ZC + Z_U + ch); const unsigned q[4] = {w.x, w.y, w.z, w.w};
#pragma unroll
            for (int e = 0; e < 4; ++e) { u1[2 * e] = bf_lo(q[e]); u1[2 * e + 1] = bf_hi(q[e]); } }
        else if (prompt) {
#pragma unroll
            for (int e = 0; e < 8; ++e) u1[e] = 0.f; }
        else { const float* sp = p.sconv + ((size_t)bs * 2 + 1) * DM + ch;
#pragma unroll
            for (int e = 0; e < 8; ++e) u1[e] = sp[e]; }
        if (t >= 2) { const u32x4 w = *(const u32x4*)(Z + (size_t)(r - 2) * ZC + Z_U + ch); const unsigned q[4] = {w.x, w.y, w.z, w.w};
#pragma unroll
            for (int e = 0; e < 4; ++e) { u0[2 * e] = bf_lo(q[e]); u0[2 * e + 1] = bf_hi(q[e]); } }
        else if (prompt) {
#pragma unroll
            for (int e = 0; e < 8; ++e) u0[e] = 0.f; }
        else { const float* sp = p.sconv + ((size_t)bs * 2 + t) * DM + ch;
#pragma unroll
            for (int e = 0; e < 8; ++e) u0[e] = sp[e]; }
        float o[8];
#pragma unroll
        for (int e = 0; e < 8; ++e) o[e] = bg[e] * (p.conv_w[ch + e] * u0[e] + p.conv_w[DM + ch + e] * u1[e] + p.conv_w[2 * DM + ch + e] * u2[e]);
        u32x4 w; w.x = cvt_pk_bf16(o[0], o[1]); w.y = cvt_pk_bf16(o[2], o[3]); w.z = cvt_pk_bf16(o[4], o[5]); w.w = cvt_pk_bf16(o[6], o[7]);
        *(u32x4*)(AC + (size_t)r * DM + ch) = w;
        float* so = nullptr;
        if (prompt) { if (t >= SEQ - 2) so = p.out + O_CONVP + ((size_t)(r >> 11) * 2 + (t - (SEQ - 2))) * DM + ch; }
        else if (t >= 2) so = p.out + O_CONVS + ((size_t)bs * 2 + (t - 2)) * DM + ch;
        if (so) {
#pragma unroll
            for (int e = 0; e < 8; ++e) so[e] = u2[e]; }
    }
}

__device__ __forceinline__ void hn_items(const Params& p) {
    const bf16_t* Z = (const bf16_t*)(p.ws + WS_Z); const bf16_t* H = (const bf16_t*)(p.ws + WS_H); bf16_t* HN = (bf16_t*)(p.ws + WS_HN);
    const int lane = threadIdx.x & 63, gw = blockIdx.x * 8 + (threadIdx.x >> 6), NGW = gridDim.x * 8, c0 = lane * 16;
    f32x4 mg[4];
#pragma unroll
    for (int j = 0; j < 4; ++j) mg[j] = *(const f32x4*)(p.mh_g + c0 + 4 * j);
    for (int r = gw; r < NTOK; r += NGW) {
        const u32x4 h0 = *(const u32x4*)(H + (size_t)r * DM + c0), h1 = *(const u32x4*)(H + (size_t)r * DM + c0 + 8);
        const u32x4 o0 = *(const u32x4*)(Z + (size_t)r * ZC + Z_O + c0), o1 = *(const u32x4*)(Z + (size_t)r * ZC + Z_O + c0 + 8);
        const unsigned hw[8] = {h0.x, h0.y, h0.z, h0.w, h1.x, h1.y, h1.z, h1.w}, ow[8] = {o0.x, o0.y, o0.z, o0.w, o1.x, o1.y, o1.z, o1.w};
        float v[16]; float s = 0.f;
#pragma unroll
        for (int e = 0; e < 8; ++e) { v[2 * e] = bf_lo(hw[e]); v[2 * e + 1] = bf_hi(hw[e]); s += v[2 * e] + v[2 * e + 1]; }
        s += __shfl_xor(s, 1); s += __shfl_xor(s, 2); s += __shfl_xor(s, 4); s += __shfl_xor(s, 8);
        const float mean = s * (1.0f / 256.0f); float q = 0.f;
#pragma unroll
        for (int e = 0; e < 16; ++e) { v[e] -= mean; q += v[e] * v[e]; }
        q += __shfl_xor(q, 1); q += __shfl_xor(q, 2); q += __shfl_xor(q, 4); q += __shfl_xor(q, 8);
        const float rstd = 1.0f / sqrtf(q * (1.0f / 256.0f) + LN_EPS);
        unsigned ww[8];
#pragma unroll
        for (int e = 0; e < 8; ++e) { const float g0 = mg[(2 * e) >> 2][(2 * e) & 3], g1 = mg[(2 * e + 1) >> 2][(2 * e + 1) & 3];
            ww[e] = cvt_pk_bf16(v[2 * e] * rstd * g0 * bf_lo(ow[e]), v[2 * e + 1] * rstd * g1 * bf_hi(ow[e])); }
        u32x4 w0, w1; w0.x = ww[0]; w0.y = ww[1]; w0.z = ww[2]; w0.w = ww[3]; w1.x = ww[4]; w1.y = ww[5]; w1.z = ww[6]; w1.w = ww[7];
        *(u32x4*)(HN + (size_t)r * DM + c0) = w0; *(u32x4*)(HN + (size_t)r * DM + c0 + 8) = w1;
    }
}

template <bool OUT_F32>
__device__ __forceinline__ void ln_rows(const float* R, const float* gam, const float* bet, void* out) {
    const int lane = threadIdx.x & 63, gw = blockIdx.x * 8 + (threadIdx.x >> 6), NGW = gridDim.x * 8;
    f32x4 gv[4], bv[4];
#pragma unroll
    for (int j = 0; j < 4; ++j) { gv[j] = *(const f32x4*)(gam + j * 256 + lane * 4); bv[j] = *(const f32x4*)(bet + j * 256 + lane * 4); }
    for (int r = gw; r < NTOK; r += NGW) {
        f32x4 v[4]; float s = 0.f;
#pragma unroll
        for (int j = 0; j < 4; ++j) { v[j] = *(const f32x4*)(R + (size_t)r * DM + j * 256 + lane * 4); s += (v[j][0] + v[j][1]) + (v[j][2] + v[j][3]); }
        const float mean = wave_sum(s) * (1.0f / DM); float q = 0.f;
#pragma unroll
        for (int j = 0; j < 4; ++j) { v[j] = v[j] - mean; q += (v[j][0] * v[j][0] + v[j][1] * v[j][1]) + (v[j][2] * v[j][2] + v[j][3] * v[j][3]); }
        const float rstd = 1.0f / sqrtf(wave_sum(q) * (1.0f / DM) + LN_EPS);
#pragma unroll
        for (int j = 0; j < 4; ++j) { const f32x4 y = v[j] * rstd * gv[j] + bv[j];
            if (OUT_F32) *(f32x4*)((float*)out + (size_t)r * DM + j * 256 + lane * 4) = y;
            else { u32x2 w; w.x = cvt_pk_bf16(y[0], y[1]); w.y = cvt_pk_bf16(y[2], y[3]); *(u32x2*)((bf16_t*)out + (size_t)r * DM + j * 256 + lane * 4) = w; } }
    }
}

__global__ void __launch_bounds__(512, 2) mega(Params p) {
    extern __shared__ __attribute__((aligned(16))) unsigned char shm_raw[];
    LAS unsigned char* lds = (LAS unsigned char*)shm_raw;
    const int G = gridDim.x, c = blockIdx.x;
    unsigned char* ws = p.ws;
#if MK_MULTI
#define PH_SYNC(k)
#else
#define PH_SYNC(k) do { if (p.ph_lo <= (k) && (k) + 1 < p.ph_hi) { __threadfence(); cg::this_grid().sync(); } } while (0)
#endif
#define PH_ON(k) (((PHMASK >> (k)) & 1) && p.ph_lo <= (k) && (k) < p.ph_hi)
    if (PH_ON(0)) phase0(p, lds);
    PH_SYNC(0);
    if (PH_ON(1)) { pg8::StaticOrder S; S.init(NTOK, NZ, G, c); pg8::Gemm g{(const bf16_t*)(ws + WS_XB), (const bf16_t*)(ws + WS_WIN), NTOK, NZ, DM};
        EpiZ E{(bf16_t*)(ws + WS_Z), (bf16_t*)(ws + WS_KT)}; pg8::gemm_phase(lds, g, S, E); }
    PH_SYNC(1);
    if (PH_ON(2)) {
        for (int it = c; it < 256; it += G) { const int xcd = it & 7, idx = it >> 3; mlstm_prompt_item(p, lds, xcd * 4 + (idx >> 3), idx & 7); }
        for (int it = c; it < 512; it += G) mlstm_sample_item(p, lds, it);
        conv_items(p);
    }
    PH_SYNC(2);
    if (PH_ON(3)) { hn_items(p);
        pg8::StaticOrder S; S.init(NTOK, DM, G, c); pg8::Gemm g{(const bf16_t*)(ws + WS_AC), (const bf16_t*)(ws + WS_WC), NTOK, DM, DM};
        EpiGate E{(bf16_t*)(ws + WS_XB), nullptr, (const bf16_t*)(ws + WS_Z), Z_GC, 0}; pg8::gemm_phase(lds, g, S, E); }
    PH_SYNC(3);
    if (PH_ON(4)) { pg8::StaticOrder S; S.init(NTOK, DM, G, c); pg8::Gemm g{(const bf16_t*)(ws + WS_HN), (const bf16_t*)(ws + WS_WM), NTOK, DM, DM};
        EpiGate E{(bf16_t*)(ws + WS_AC), (const bf16_t*)(ws + WS_XB), (const bf16_t*)(ws + WS_Z), Z_GM, 1}; pg8::gemm_phase(lds, g, S, E); }
    PH_SYNC(4);
    if (PH_ON(5)) { pg8::StaticOrder S; S.init(NTOK, DM, G, c); pg8::Gemm g{(const bf16_t*)(ws + WS_AC), (const bf16_t*)(ws + WS_WO), NTOK, DM, DM};
        EpiResX E{(float*)(ws + WS_R), p.xp, p.xs}; pg8::gemm_phase(lds, g, S, E); }
    PH_SYNC(5);
    if (PH_ON(6)) ln_rows<false>((const float*)(ws + WS_R), p.ln1g, p.ln1b, ws + WS_H);
    PH_SYNC(6);
    if (PH_ON(7)) { pg8::StaticOrder S; S.init(NTOK, DFF, G, c); pg8::Gemm g{(const bf16_t*)(ws + WS_H), (const bf16_t*)(ws + WS_W1), NTOK, DFF, DM};
        EpiHid E{(bf16_t*)(ws + WS_HID)}; pg8::gemm_phase(lds, g, S, E); }
    PH_SYNC(7);
    if (PH_ON(8)) { pg8::StaticOrder S; S.init(NTOK, DM, G, c); pg8::Gemm g{(const bf16_t*)(ws + WS_HID), (const bf16_t*)(ws + WS_W2), NTOK, DM, DFF};
        EpiResB E{(float*)(ws + WS_R), (const bf16_t*)(ws + WS_H)}; pg8::gemm_phase(lds, g, S, E); }
    PH_SYNC(8);
    if (PH_ON(9)) ln_rows<true>((const float*)(ws + WS_R), p.ln2g, p.ln2b, p.out + O_Y);
}

extern "C" void kernel_launch(void* const* d_in, const int* in_sizes, int n_in, void* d_out, int out_size, void* d_ws, size_t ws_size, hipStream_t stream) {
    static int grid = 0;
    if (grid == 0) {
        if (n_in != 19 || ws_size < WS_END) { fprintf(stderr, "kernel_launch: unexpected inputs (n_in %d, ws %zu, need %zu)\n", n_in, ws_size, (size_t)WS_END); grid = -1; return; }
        int dev = 0, cus = 0, per_cu = 0;
        hipGetDevice(&dev); hipDeviceGetAttribute(&cus, hipDeviceAttributeMultiprocessorCount, dev);
        hipFuncSetAttribute((const void*)mega, hipFuncAttributeMaxDynamicSharedMemorySize, LDS_BYTES);
        hipOccupancyMaxActiveBlocksPerMultiprocessor(&per_cu, (const void*)mega, 512, LDS_BYTES);
        if (per_cu < 1 || cus < 1) { fprintf(stderr, "kernel_launch: occupancy query says %d blocks/CU on %d CUs\n", per_cu, cus); grid = -1; return; }
        grid = cus;
    }
    if (grid < 0) return;
    Params p{};
    const float** f = (const float**)&p;
    for (int i = 0; i < 19; ++i) f[i] = (const float*)d_in[i];
    p.out = (float*)d_out; p.ws = (unsigned char*)d_ws;
#if MK_MULTI
    for (int ph = 0; ph < 10; ++ph) { p.ph_lo = ph; p.ph_hi = ph + 1; hipLaunchKernelGGL(mega, dim3(grid), dim3(512), LDS_BYTES, stream, p); }
#else
    p.ph_lo = 0; p.ph_hi = 10;
    void* args[] = {&p};
    hipError_t e = hipLaunchCooperativeKernel((const void*)mega, dim3(grid), dim3(512), args, LDS_BYTES, stream);
    if (e != hipSuccess) fprintf(stderr, "cooperative launch failed: %s (grid %d)\n", hipGetErrorString(e), grid);
#endif
}
```

```cpp
#include <hip/hip_runtime.h>
#include <hip/hip_cooperative_groups.h>
#include <cstdio>
namespace cg = cooperative_groups;

#ifndef PHMASK
#define PHMASK 1023
#endif
#ifndef MK_MULTI
#define MK_MULTI 0
#endif

#define LAS __attribute__((address_space(3)))
typedef unsigned short bf16_t;
typedef short bf16x8 __attribute__((ext_vector_type(8)));
typedef float f32x4 __attribute__((ext_vector_type(4)));
typedef float f32x2 __attribute__((ext_vector_type(2)));
typedef unsigned u32x4 __attribute__((ext_vector_type(4)));
typedef unsigned u32x2 __attribute__((ext_vector_type(2)));

constexpr int DM = 1024, NPROMPT = 8 * 2048, NSAMPLE = 128 * 4, NTOK = NPROMPT + NSAMPLE;
constexpr int SEQ = 2048, NH = 4, DH = 256, DFF = 4096, DIN = 9224, NZ = 9216, ZC = 8192;
constexpr float ALPHA = 1.189207115002721f;
constexpr float LN_EPS = 1e-5f;
constexpr int Z_BG = 0, Z_U = 1024, Z_Q = 2048, Z_K = 3072, Z_V = 4096, Z_O = 5120, Z_GC = 6144, Z_GM = 7168;
constexpr size_t O_Y = 0, O_CONVP = 17301504, O_CONVS = 17317888, O_CP = 17580032, O_CS = 19677184, O_NP = 53231616, O_NS = 53239808, O_MP = 53370880, O_MS = 53370912;
constexpr size_t SZ_ACT = (size_t)NTOK * DM * 2;
constexpr size_t WS_XB = 0;
constexpr size_t WS_WIN = WS_XB + SZ_ACT;
constexpr size_t WS_WC = WS_WIN + (size_t)NZ * DM * 2;
constexpr size_t WS_WM = WS_WC + (size_t)DM * DM * 2;
constexpr size_t WS_WO = WS_WM + (size_t)DM * DM * 2;
constexpr size_t WS_W1 = WS_WO + (size_t)DM * DM * 2;
constexpr size_t WS_W2 = WS_W1 + (size_t)DFF * DM * 2;
constexpr size_t WS_G = WS_W2 + (size_t)DFF * DM * 2;
constexpr size_t WS_Z = WS_G + (size_t)NTOK * 8 * 4;
constexpr size_t WS_HID = WS_Z;
constexpr size_t WS_R = WS_Z + (size_t)NTOK * DFF * 2;
constexpr size_t WS_KT = WS_Z + (size_t)NTOK * ZC * 2;
constexpr size_t WS_H = WS_KT + (size_t)32 * 256 * 2048 * 2;
constexpr size_t WS_AC = WS_H + SZ_ACT;
constexpr size_t WS_HN = WS_AC + SZ_ACT;
constexpr size_t WS_BAR = WS_HN + SZ_ACT;
constexpr size_t WS_END = WS_BAR + 16384;
constexpr int LDS_BYTES = 131072 + 16;

struct Params {
    const float *xp, *xs, *sconv, *sC, *sn, *sm, *w_in, *b_gate, *conv_w, *w_co, *mh_g, *w_mo, *w_o, *ln1g, *ln1b, *w_ff1, *w_ff2, *ln2g, *ln2b;
    float* out; unsigned char* ws; int ph_lo, ph_hi;
};

__device__ __forceinline__ unsigned cvt_pk_bf16(float lo, float hi) { unsigned r; asm volatile("v_cvt_pk_bf16_f32 %0, %1, %2" : "=v"(r) : "v"(lo), "v"(hi)); return r; }
__device__ __forceinline__ float bf_lo(unsigned w) { return __uint_as_float(w << 16); }
__device__ __forceinline__ float bf_hi(unsigned w) { return __uint_as_float(w & 0xffff0000u); }
__device__ __forceinline__ float bf2f(bf16_t b) { return __uint_as_float(((unsigned)b) << 16); }
__device__ __forceinline__ float sigmoidf_(float x) { return 1.0f / (1.0f + __expf(-x)); }
__device__ __forceinline__ float wave_sum(float v) {
#pragma unroll
    for (int o = 1; o < 64; o <<= 1) v += __shfl_xor(v, o);
    return v;
}
__device__ __forceinline__ const float* xrow(const Params& p, int r) { return r < NPROMPT ? p.xp + (size_t)r * DM : p.xs + (size_t)(r - NPROMPT) * DM; }
#define LDS_WAIT() asm volatile("s_waitcnt lgkmcnt(0)" ::: "memory")

#define XB_TMO      128
#define XB_XCNT(j)  (256  + 64 * (j))
#define XB_XSUB(j)  (1280 + 64 * (j))
#define XB_XGEN(j)  (2304 + 64 * (j))
#define XB_TOP      3328
#define XB_TOPGEN   3392
#define XCD_BAR_WORDS 3456
#define XB_SPIN_CAP (1u << 22)
__device__ __forceinline__ unsigned xb_ld(unsigned* p)              { return __hip_atomic_load(p, __ATOMIC_RELAXED, __HIP_MEMORY_SCOPE_AGENT); }
__device__ __forceinline__ unsigned xb_add(unsigned* p, unsigned v) { return __hip_atomic_fetch_add(p, v, __ATOMIC_RELAXED, __HIP_MEMORY_SCOPE_AGENT); }
__device__ __forceinline__ unsigned xb_xcc_id() { return (unsigned)__builtin_amdgcn_s_getreg((3 << 11) | 20) & 0xFu; }
#define XB_SPIN(cond, bar) do { unsigned _sp = 0; while (cond) { __builtin_amdgcn_s_sleep(1); \
    if ((++_sp & 255u) == 0u) { if (xb_ld(&(bar)[XB_TMO])) break; if (_sp > XB_SPIN_CAP) { atomicAdd(&(bar)[XB_TMO], 1u); break; } } } } while (0)
struct XcdBarrier { unsigned* bar; unsigned x; volatile LAS unsigned* st; };
__device__ __forceinline__ XcdBarrier xcd_barrier_post(unsigned* bar, volatile LAS unsigned* st) {
    XcdBarrier b; b.bar = bar; b.x = xb_xcc_id(); b.st = st;
    if (threadIdx.x == 0) (void)xb_add(&bar[XB_XCNT(b.x)], 1u);
    return b;
}
__device__ __forceinline__ void xcd_barrier_complete(unsigned* bar, unsigned x, unsigned& nloc, unsigned& nx) {
    const unsigned G = gridDim.x * gridDim.y * gridDim.z;
    unsigned sum, cnt, mine, sp = 0u;
    for (;;) {
        sum = 0u; cnt = 0u; mine = 0u;
#pragma unroll
        for (unsigned j = 0; j < 16; ++j) { const unsigned c = xb_ld(&bar[XB_XCNT(j)]); sum += c; cnt += (c > 0u) ? 1u : 0u; mine = (j == x) ? c : mine; }
        if (sum == G) break;
        __builtin_amdgcn_s_sleep(1);
        if ((++sp & 255u) == 0u) { if (xb_ld(&bar[XB_TMO])) break; if (sp > XB_SPIN_CAP) { atomicAdd(&bar[XB_TMO], 1u); break; } }
    }
    nloc = mine > 0u ? mine : 1u; nx = cnt > 0u ? cnt : 1u;
}
__device__ __forceinline__ void xcd_barrier(const XcdBarrier& b) {
    asm volatile("s_waitcnt vmcnt(0)" ::: "memory");
    __syncthreads();
    if (threadIdx.x == 0) {
        unsigned* bar = b.bar;
        __builtin_amdgcn_s_waitcnt(0);
        unsigned nloc = b.st[0], nx = b.st[1];
        if (nloc == 0u) { xcd_barrier_complete(bar, b.x, nloc, nx); b.st[0] = nloc; b.st[1] = nx; }
        const unsigned old = xb_add(&bar[XB_XSUB(b.x)], 1u);
        const unsigned gen = old / nloc;
        if (old + 1u == (gen + 1u) * nloc) {
            __builtin_amdgcn_fence(__ATOMIC_RELEASE, "agent");
            asm volatile("s_waitcnt vmcnt(0)" ::: "memory");
            const unsigned og = xb_add(&bar[XB_TOP], 1u);
            const unsigned tg = og / nx;
            if (og + 1u == (tg + 1u) * nx) xb_add(&bar[XB_TOPGEN], 1u);
            else XB_SPIN(xb_ld(&bar[XB_TOPGEN]) == tg, bar);
            __builtin_amdgcn_fence(__ATOMIC_ACQUIRE, "agent");
            xb_add(&bar[XB_XGEN(b.x)], 1u);
            asm volatile("s_waitcnt vmcnt(0)" ::: "memory");
        } else {
            XB_SPIN(xb_ld(&bar[XB_XGEN(b.x)]) == gen, bar);
            __builtin_amdgcn_fence(__ATOMIC_ACQUIRE, "agent");
            asm volatile("s_waitcnt vmcnt(0)" ::: "memory");
        }
    }
    __syncthreads();
}

namespace pg8 {
constexpr int BM = 256, BK = 64, HALF = 128, HTB = HALF * BK * 2, NXCD = 8, WGM = 8;
__host__ __device__ __forceinline__ int lds_byte(int r, int c) { const int st = (r >> 4) * 2 + (c >> 5), rr = r & 15, cc = c & 31, ob = rr * 64 + cc * 2; return st * 1024 + (ob ^ (((ob >> 9) & 1) << 5)); }
__host__ __device__ __forceinline__ void stage_rc(int b, int& R, int& C) { const int st = b / 1024, sb = b % 1024, swz = sb ^ (((sb >> 9) & 1) << 5); R = (st >> 1) * 16 + swz / 64; C = (st & 1) * 32 + (swz % 64) / 2; }
__host__ __device__ __forceinline__ int perm32(int rho) { const int n = rho >> 4, i = rho & 15; return 8 * (i >> 2) + 4 * n + (i & 3); }
struct Unit { int pm, pn; };
struct Gemm { const bf16_t* A; const bf16_t* Bt; int M, N, K; };
struct StaticOrder {
    int nM, nN, nwg, G, c;
    __device__ void init(int M, int N, int G_, int c_) { nM = M / BM; nN = N / BM; nwg = nM * nN; G = G_; c = c_; }
    __device__ bool next(int i, Unit& u) const {
        const long L = (long)i * G + c; if (L >= nwg) return false;
        int wgid = (int)L; { const int q = nwg / NXCD, r = nwg % NXCD, xcd = wgid % NXCD, off = wgid / NXCD; wgid = (xcd < r ? xcd * (q + 1) : r * (q + 1) + (xcd - r) * q) + off; }
        const int nig = WGM * nN, gid = wgid / nig, fm = gid * WGM, gsz = (nM - fm) < WGM ? (nM - fm) : WGM;
        u.pm = fm + ((wgid % nig) % gsz); u.pn = (wgid % nig) / gsz; return true;
    }
};

template <class Epi>
__device__ __forceinline__ void gemm_phase(LAS unsigned char* lds, const Gemm g, const StaticOrder& S, const Epi& E) {
    const int tid = threadIdx.x, wid = __builtin_amdgcn_readfirstlane(tid >> 6), lane = tid & 63, wr = wid >> 2, wc = wid & 3, fr = lane & 15, fq = lane >> 4;
    const int K = g.K, nt = K / BK;
    unsigned voffA[2], voffB[2];
#pragma unroll
    for (int i = 0; i < 2; ++i) { int R, C; stage_rc(tid * 16 + i * 8192, R, C); const int Rb = (R & ~31) + perm32(R & 31);
        voffA[i] = (unsigned)(R * K + C) * 2u; voffB[i] = (unsigned)(Rb * K + C) * 2u; }
    const size_t kstep = (size_t)(BK * 2);
    const size_t hstep = (size_t)HALF * K * 2;
    const size_t tstep = 2 * hstep;
    const unsigned ldsw = (unsigned)wid * 1024u;
    const int aoff = lds_byte(wr * 64 + fr, fq * 8), boff = lds_byte(wc * 32 + fr, fq * 8);
#define PG8_SA(b, h) (((b) * 2 + (h)) * HTB)
#define PG8_SB(b, h) ((4 + (b) * 2 + (h)) * HTB)
#define PG8_STAGE(bufoff, gbase, voff) do { _Pragma("unroll") for (int _i = 0; _i < 2; ++_i) \
        __builtin_amdgcn_global_load_lds((const unsigned*)((const char*)(gbase) + (voff)[_i]), (LAS unsigned*)(lds + (bufoff) + ldsw + _i * 8192), 16, 0, 0); } while (0)
#define PG8_LDA(dst, b, h) do { _Pragma("unroll") for (int m = 0; m < 4; ++m) _Pragma("unroll") for (int k = 0; k < 2; ++k) dst[m][k] = *(const LAS bf16x8*)(lds + PG8_SA(b, h) + aoff + m * 2048 + k * 1024); } while (0)
#define PG8_LDB(dst, b, h) do { _Pragma("unroll") for (int n = 0; n < 2; ++n) _Pragma("unroll") for (int k = 0; k < 2; ++k) dst[n][k] = *(const LAS bf16x8*)(lds + PG8_SB(b, h) + boff + n * 2048 + k * 1024); } while (0)
#define PG8_MMA(ai, bj, At, Bt) do { __builtin_amdgcn_s_setprio(1); _Pragma("unroll") for (int m = 0; m < 4; ++m) _Pragma("unroll") for (int n = 0; n < 2; ++n) _Pragma("unroll") for (int k = 0; k < 2; ++k) \
        acc[ai][bj][m][n] = __builtin_amdgcn_mfma_f32_16x16x32_bf16(Bt[n][k], At[m][k], acc[ai][bj][m][n], 0, 0, 0); __builtin_amdgcn_s_setprio(0); } while (0)
#define PG8_WAIT_V(n) asm volatile("s_waitcnt vmcnt(" #n ")" ::: "memory")
#define PG8_WAIT_L(n) asm volatile("s_waitcnt lgkmcnt(" #n ")" ::: "memory")
#define PG8_BAR __builtin_amdgcn_s_barrier()
#define PG8_SCHED __builtin_amdgcn_sched_barrier(0)
    Unit cur, nxt; int ui = 0;
    if (!S.next(0, cur)) return;
    f32x4 acc[2][2][4][2];
#pragma unroll
    for (int a = 0; a < 2; ++a)
#pragma unroll
        for (int b = 0; b < 2; ++b)
#pragma unroll
            for (int m = 0; m < 4; ++m)
#pragma unroll
                for (int n = 0; n < 2; ++n) acc[a][b][m][n] = (f32x4){0.f, 0.f, 0.f, 0.f};
    bf16x8 At[4][2], B0[2][2], B1[2][2];
    const char* cA = (const char*)g.A + (size_t)cur.pm * tstep; const char* cB = (const char*)g.Bt + (size_t)cur.pn * tstep;
    PG8_STAGE(PG8_SB(0, 0), cB, voffB); PG8_STAGE(PG8_SA(0, 0), cA, voffA); PG8_STAGE(PG8_SB(0, 1), cB + hstep, voffB); PG8_STAGE(PG8_SA(0, 1), cA + hstep, voffA);
    if (wr == 1) PG8_BAR;
    PG8_WAIT_V(4); PG8_BAR;
    PG8_STAGE(PG8_SB(1, 0), cB + kstep, voffB); PG8_STAGE(PG8_SA(1, 0), cA + kstep, voffA); PG8_STAGE(PG8_SB(1, 1), cB + hstep + kstep, voffB);
    PG8_WAIT_V(6); PG8_BAR;
    for (;;) {
        const bool has_next = S.next(ui + 1, nxt);
        const char* nA = has_next ? (const char*)g.A + (size_t)nxt.pm * tstep : cA; const char* nB = has_next ? (const char*)g.Bt + (size_t)nxt.pn * tstep : cB;
        for (int t = 0; t < nt; t += 2) {
            const bool last = (t == nt - 2);
            const char* a1 = cA + (size_t)(t + 1) * kstep;
            const char* a2 = last ? nA : cA + (size_t)(t + 2) * kstep; const char* b2 = last ? nB : cB + (size_t)(t + 2) * kstep;
            const char* a3 = a2 + kstep; const char* b3 = b2 + kstep;
            PG8_LDB(B0, 0, 0); PG8_SCHED; PG8_LDA(At, 0, 0); PG8_STAGE(PG8_SA(1, 1), a1 + hstep, voffA);
            PG8_WAIT_L(8); PG8_BAR; PG8_WAIT_L(0); PG8_MMA(0, 0, At, B0); PG8_BAR; PG8_SCHED;
            PG8_LDB(B1, 0, 1); PG8_STAGE(PG8_SB(0, 0), b2, voffB);
            PG8_BAR; PG8_WAIT_L(0); PG8_MMA(0, 1, At, B1); PG8_BAR;
            PG8_LDA(At, 0, 1); PG8_STAGE(PG8_SA(0, 0), a2, voffA);
            PG8_BAR; PG8_WAIT_L(0); PG8_MMA(1, 0, At, B0); PG8_BAR; PG8_SCHED;
            PG8_STAGE(PG8_SB(0, 1), b2 + hstep, voffB);
            PG8_WAIT_V(6); PG8_BAR; PG8_MMA(1, 1, At, B1); PG8_BAR;
            PG8_LDB(B0, 1, 0); PG8_SCHED; PG8_LDA(At, 1, 0); PG8_STAGE(PG8_SA(0, 1), a2 + hstep, voffA);
            PG8_WAIT_L(8); PG8_BAR; PG8_WAIT_L(0); PG8_MMA(0, 0, At, B0); PG8_BAR; PG8_SCHED;
            PG8_LDB(B1, 1, 1); PG8_STAGE(PG8_SB(1, 0), b3, voffB);
            PG8_BAR; PG8_WAIT_L(0); PG8_MMA(0, 1, At, B1); PG8_BAR;
            PG8_LDA(At, 1, 1); PG8_STAGE(PG8_SA(1, 0), a3, voffA);
            PG8_BAR; PG8_WAIT_L(0); PG8_MMA(1, 0, At, B0); PG8_BAR; PG8_SCHED;
            PG8_STAGE(PG8_SB(1, 1), b3 + hstep, voffB);
            PG8_WAIT_V(6); PG8_BAR; PG8_MMA(1, 1, At, B1); PG8_BAR;
        }
        E(acc, cur, wr, wc, fr, fq);
        if (!has_next) break;
#pragma unroll
        for (int a = 0; a < 2; ++a)
#pragma unroll
            for (int b = 0; b < 2; ++b)
#pragma unroll
                for (int m = 0; m < 4; ++m)
#pragma unroll
                    for (int n = 0; n < 2; ++n) acc[a][b][m][n] = (f32x4){0.f, 0.f, 0.f, 0.f};
        cur = nxt; cA = nA; cB = nB; ++ui;
    }
    PG8_WAIT_V(0);
    if (wr == 0) PG8_BAR;
    PG8_BAR;
#undef PG8_SA
#undef PG8_SB
#undef PG8_STAGE
#undef PG8_LDA
#undef PG8_LDB
#undef PG8_MMA
#undef PG8_WAIT_V
#undef PG8_WAIT_L
#undef PG8_BAR
#undef PG8_SCHED
}
}
using pg8::Unit;

#define EPI_LOOP_BEGIN \
    _Pragma("unroll") for (int ai = 0; ai < 2; ++ai) _Pragma("unroll") for (int m = 0; m < 4; ++m) { const int row = u.pm * 256 + ai * 128 + wr * 64 + m * 16 + fr; \
    _Pragma("unroll") for (int bj = 0; bj < 2; ++bj) { const int lc = bj * 128 + wc * 32 + 8 * fq; const f32x4 v0 = acc[ai][bj][m][0], v1 = acc[ai][bj][m][1];
#define EPI_LOOP_END } }

struct EpiZ {
    bf16_t* Z; bf16_t* KT;
    __device__ __forceinline__ void operator()(const f32x4 (&acc)[2][2][4][2], const Unit& u, int wr, int wc, int fr, int fq) const {
        const int pn = u.pn;
        if (pn >= 4 && pn < 12) {
#pragma unroll
            for (int ai = 0; ai < 2; ++ai)
#pragma unroll
                for (int m = 0; m < 4; ++m) { const int row = u.pm * 256 + ai * 128 + wr * 64 + m * 16 + fr;
                    const f32x4 a0 = acc[ai][0][m][0] * acc[ai][1][m][0], a1 = acc[ai][0][m][1] * acc[ai][1][m][1];
                    u32x4 w; w.x = cvt_pk_bf16(a0[0], a0[1]); w.y = cvt_pk_bf16(a0[2], a0[3]); w.z = cvt_pk_bf16(a1[0], a1[1]); w.w = cvt_pk_bf16(a1[2], a1[3]);
                    *(u32x4*)(Z + (size_t)row * ZC + Z_U + (pn - 4) * 128 + wc * 32 + 8 * fq) = w; }
            return;
        }
        const int zc0 = pn < 4 ? pn * 256 : Z_Q + (pn - 12) * 256;
        const int grp = pn < 4 ? -1 : (pn - 12) >> 2;
        EPI_LOOP_BEGIN
            f32x4 a0 = v0, a1 = v1;
            if (grp >= 3) {
#pragma unroll
                for (int j = 0; j < 4; ++j) { a0[j] = sigmoidf_(a0[j]); a1[j] = sigmoidf_(a1[j]); }
            }
            u32x4 w; w.x = cvt_pk_bf16(a0[0], a0[1]); w.y = cvt_pk_bf16(a0[2], a0[3]); w.z = cvt_pk_bf16(a1[0], a1[1]); w.w = cvt_pk_bf16(a1[2], a1[3]);
            *(u32x4*)(Z + (size_t)row * ZC + zc0 + lc) = w;
            if (grp == 1 && row < NPROMPT) {
                const int b = row >> 11, t = row & 2047, hd = (pn - 16) * 256 + lc;
                bf16_t* kt = KT + ((size_t)(b * 1024 + hd)) * SEQ + t;
                kt[0 * SEQ] = (bf16_t)(w.x & 0xffff); kt[1 * SEQ] = (bf16_t)(w.x >> 16); kt[2 * SEQ] = (bf16_t)(w.y & 0xffff); kt[3 * SEQ] = (bf16_t)(w.y >> 16);
                kt[4 * SEQ] = (bf16_t)(w.z & 0xffff); kt[5 * SEQ] = (bf16_t)(w.z >> 16); kt[6 * SEQ] = (bf16_t)(w.w & 0xffff); kt[7 * SEQ] = (bf16_t)(w.w >> 16);
            }
        EPI_LOOP_END
    }
};
struct EpiGate {
    bf16_t* O; const bf16_t* T; const bf16_t* Z; int gcol; int add;
    __device__ __forceinline__ void operator()(const f32x4 (&acc)[2][2][4][2], const Unit& u, int wr, int wc, int fr, int fq) const {
        EPI_LOOP_BEGIN
            const int col = u.pn * 256 + lc;
            const u32x4 gw = *(const u32x4*)(Z + (size_t)row * ZC + gcol + col);
            f32x4 a0, a1;
            a0[0] = bf_lo(gw.x) * v0[0]; a0[1] = bf_hi(gw.x) * v0[1]; a0[2] = bf_lo(gw.y) * v0[2]; a0[3] = bf_hi(gw.y) * v0[3];
            a1[0] = bf_lo(gw.z) * v1[0]; a1[1] = bf_hi(gw.z) * v1[1]; a1[2] = bf_lo(gw.w) * v1[2]; a1[3] = bf_hi(gw.w) * v1[3];
            if (add) { const u32x4 tw = *(const u32x4*)(T + (size_t)row * DM + col);
                a0[0] += bf_lo(tw.x); a0[1] += bf_hi(tw.x); a0[2] += bf_lo(tw.y); a0[3] += bf_hi(tw.y); a1[0] += bf_lo(tw.z); a1[1] += bf_hi(tw.z); a1[2] += bf_lo(tw.w); a1[3] += bf_hi(tw.w); }
            u32x4 w; w.x = cvt_pk_bf16(a0[0], a0[1]); w.y = cvt_pk_bf16(a0[2], a0[3]); w.z = cvt_pk_bf16(a1[0], a1[1]); w.w = cvt_pk_bf16(a1[2], a1[3]);
            *(u32x4*)(O + (size_t)row * DM + col) = w;
        EPI_LOOP_END
    }
};
struct EpiResX {
    float* R; const float* xp; const float* xs;
    __device__ __forceinline__ void operator()(const f32x4 (&acc)[2][2][4][2], const Unit& u, int wr, int wc, int fr, int fq) const {
        EPI_LOOP_BEGIN
            const int col = u.pn * 256 + lc;
            const float* xr = (row < NPROMPT ? xp + (size_t)row * DM : xs + (size_t)(row - NPROMPT) * DM) + col;
            const f32x4 x0 = *(const f32x4*)xr, x1 = *(const f32x4*)(xr + 4);
            *(f32x4*)(R + (size_t)row * DM + col) = x0 * ALPHA + v0; *(f32x4*)(R + (size_t)row * DM + col + 4) = x1 * ALPHA + v1;
        EPI_LOOP_END
    }
};
struct EpiResB {
    float* R; const bf16_t* X1;
    __device__ __forceinline__ void operator()(const f32x4 (&acc)[2][2][4][2], const Unit& u, int wr, int wc, int fr, int fq) const {
        EPI_LOOP_BEGIN
            const int col = u.pn * 256 + lc;
            const u32x4 xw = *(const u32x4*)(X1 + (size_t)row * DM + col);
            f32x4 a0, a1;
            a0[0] = bf_lo(xw.x) * ALPHA + v0[0]; a0[1] = bf_hi(xw.x) * ALPHA + v0[1]; a0[2] = bf_lo(xw.y) * ALPHA + v0[2]; a0[3] = bf_hi(xw.y) * ALPHA + v0[3];
            a1[0] = bf_lo(xw.z) * ALPHA + v1[0]; a1[1] = bf_hi(xw.z) * ALPHA + v1[1]; a1[2] = bf_lo(xw.w) * ALPHA + v1[2]; a1[3] = bf_hi(xw.w) * ALPHA + v1[3];
            *(f32x4*)(R + (size_t)row * DM + col) = a0; *(f32x4*)(R + (size_t)row * DM + col + 4) = a1;
        EPI_LOOP_END
    }
};
struct EpiHid {
    bf16_t* Hd;
    __device__ __forceinline__ void operator()(const f32x4 (&acc)[2][2][4][2], const Unit& u, int wr, int wc, int fr, int fq) const {
        EPI_LOOP_BEGIN
            const int col = u.pn * 256 + lc;
            f32x4 a0, a1;
#pragma unroll
            for (int j = 0; j < 4; ++j) { const float r0 = fmaxf(v0[j], 0.f), r1 = fmaxf(v1[j], 0.f); a0[j] = r0 * r0; a1[j] = r1 * r1; }
            u32x4 w; w.x = cvt_pk_bf16(a0[0], a0[1]); w.y = cvt_pk_bf16(a0[2], a0[3]); w.z = cvt_pk_bf16(a1[0], a1[1]); w.w = cvt_pk_bf16(a1[2], a1[3]);
            *(u32x4*)(Hd + (size_t)row * DFF + col) = w;
        EPI_LOOP_END
    }
};

__device__ __forceinline__ void transpose_item(const float* W, int ldw, int K, int src0, bf16_t* WT, int dst0, int kb, float scale, LAS float* scr, int lane) {
    const int k0 = kb * 64;
#pragma unroll 8
    for (int i = 0; i < 32; ++i) { const int kk = 2 * i + (lane >> 5); scr[kk * 33 + (lane & 31)] = W[(size_t)(k0 + kk) * ldw + src0 + (lane & 31)]; }
    LDS_WAIT();
    const int c = lane & 7;
#pragma unroll
    for (int j = 0; j < 4; ++j) { const int n = (lane >> 3) + 8 * j; const LAS float* s = scr + (8 * c) * 33 + n;
        u32x4 o; o.x = cvt_pk_bf16(s[0 * 33] * scale, s[1 * 33] * scale); o.y = cvt_pk_bf16(s[2 * 33] * scale, s[3 * 33] * scale);
        o.z = cvt_pk_bf16(s[4 * 33] * scale, s[5 * 33] * scale); o.w = cvt_pk_bf16(s[6 * 33] * scale, s[7 * 33] * scale);
        *(u32x4*)(WT + (size_t)(dst0 + n) * K + k0 + 8 * c) = o; }
    LDS_WAIT();
}
__device__ __forceinline__ void phase0(const Params& p, LAS unsigned char* lds) {
    const int tid = threadIdx.x, wid = tid >> 6, lane = tid & 63;
    const int gw = blockIdx.x * 8 + wid, NGW = gridDim.x * 8;
    LAS float* scr = (LAS float*)(lds + wid * 8704);
    LAS float* wg = (LAS float*)(lds + 73728);
    for (int e = tid; e < 2048; e += 512) { const int k = e >> 1, hf = e & 1; *(LAS f32x4*)(wg + k * 8 + hf * 4) = *(const f32x4*)(p.w_in + (size_t)k * DIN + 7168 + hf * 4); }
    __syncthreads();
    bf16_t* WIN = (bf16_t*)(p.ws + WS_WIN);
    constexpr int I_IN = 72 * 4 * 16, I_SQ = 32 * 16, I_F1 = 128 * 16, I_F2 = 32 * 64;
    constexpr int NITEMS = I_IN + 3 * I_SQ + I_F1 + I_F2;
    for (int it = gw; it < NITEMS; it += NGW) {
        int r = it;
        if (r < I_IN) { const int kb = r & 15, nb = r >> 4, g = nb >> 2, sub = nb & 3;
            int src; if (g < 8) src = g * 128; else if (g < 24) { const int pr = (g - 8) >> 1, hf = (g - 8) & 1; src = (hf ? 2048 : 1024) + pr * 128; } else if (g < 56) src = 3072 + (g - 24) * 128; else src = 7176 + (g - 56) * 128;
            const float sc = (g >= 32 && g < 40) ? 0.0625f : 1.0f;
            transpose_item(p.w_in, DIN, DM, src + sub * 32, WIN, g * 128 + sub * 32, kb, sc, scr, lane); continue; }
        r -= I_IN;
        if (r < 3 * I_SQ) { const int w = r / I_SQ, q = r % I_SQ, kb = q & 15, nb = q >> 4;
            const float* W = w == 0 ? p.w_co : (w == 1 ? p.w_mo : p.w_o); bf16_t* WT = (bf16_t*)(p.ws + (w == 0 ? WS_WC : (w == 1 ? WS_WM : WS_WO)));
            transpose_item(W, DM, DM, nb * 32, WT, nb * 32, kb, 1.0f, scr, lane); continue; }
        r -= 3 * I_SQ;
        if (r < I_F1) { const int kb = r & 15, nb = r >> 4; transpose_item(p.w_ff1, DFF, DM, nb * 32, (bf16_t*)(p.ws + WS_W1), nb * 32, kb, 1.0f, scr, lane); continue; }
        r -= I_F1;
        { const int kb = r & 63, nb = r >> 6; transpose_item(p.w_ff2, DM, DFF, nb * 32, (bf16_t*)(p.ws + WS_W2), nb * 32, kb, 1.0f, scr, lane); }
    }
    bf16_t* XB = (bf16_t*)(p.ws + WS_XB); float* G = (float*)(p.ws + WS_G);
    for (int r = gw; r < NTOK; r += NGW) {
        const float* xr = xrow(p, r);
        float g8[8];
#pragma unroll
        for (int j = 0; j < 8; ++j) g8[j] = 0.f;
#pragma unroll
        for (int j = 0; j < 4; ++j) { const int k = j * 256 + lane * 4; const f32x4 v = *(const f32x4*)(xr + k);
            u32x2 w; w.x = cvt_pk_bf16(v[0], v[1]); w.y = cvt_pk_bf16(v[2], v[3]); *(u32x2*)(XB + (size_t)r * DM + k) = w;
#pragma unroll
            for (int e = 0; e < 4; ++e) { const f32x4 wa = *(const LAS f32x4*)(wg + (k + e) * 8), wb = *(const LAS f32x4*)(wg + (k + e) * 8 + 4);
#pragma unroll
                for (int q = 0; q < 4; ++q) { g8[q] += v[e] * wa[q]; g8[4 + q] += v[e] * wb[q]; } } }
#pragma unroll
        for (int j = 0; j < 8; ++j) g8[j] = wave_sum(g8[j]);
        if (lane < 4) { G[(size_t)r * 8 + lane] = g8[0] * (lane == 0) + g8[1] * (lane == 1) + g8[2] * (lane == 2) + g8[3] * (lane == 3) + p.b_gate[lane]; }
        else if (lane < 8) { const float f = g8[4] * (lane == 4) + g8[5] * (lane == 5) + g8[6] * (lane == 6) + g8[7] * (lane == 7) + p.b_gate[lane];
            G[(size_t)r * 8 + lane] = fminf(f, 0.f) - log1pf(__expf(-fabsf(f))); }
    }
    __syncthreads();
}

constexpr int KS_LD = 264, VT_LD = 136;
constexpr int L_KSH = 0, L_CT = 128 * KS_LD * 2, L_VT = L_CT + 48 * KS_LD * 2, L_VW = L_VT + 48 * VT_LD * 2, L_SC = L_VW + 48 * VT_LD * 2;
__device__ __forceinline__ void mlstm_prompt_item(const Params& p, LAS unsigned char* lds, int bh, int vs) {
    const int tid = threadIdx.x, wid = __builtin_amdgcn_readfirstlane(tid >> 6), lane = tid & 63, li = lane & 15, kg = lane >> 4;
    const int b = bh >> 2, h = bh & 3, j0 = vs * 32;
    LAS bf16_t* Ksh = (LAS bf16_t*)(lds + L_KSH); LAS bf16_t* CTsh = (LAS bf16_t*)(lds + L_CT); LAS bf16_t* VTsh = (LAS bf16_t*)(lds + L_VT); LAS bf16_t* VWsh = (LAS bf16_t*)(lds + L_VW);
    LAS float* sA = (LAS float*)(lds + L_SC); LAS float* sG = sA + 128; LAS float* sB = sG + 128;
    const bf16_t* Z = (const bf16_t*)(p.ws + WS_Z); const bf16_t* KT = (const bf16_t*)(p.ws + WS_KT); const float* G = (const float*)(p.ws + WS_G); bf16_t* H = (bf16_t*)(p.ws + WS_H);
    for (int e = tid; e < 48 * KS_LD / 2; e += 512) ((LAS unsigned*)CTsh)[e] = 0u;
    for (int e = tid; e < 16 * VT_LD; e += 512) { const int rr = e / VT_LD; VTsh[32 * VT_LD + e] = rr == 0 ? (bf16_t)0x3F80 : (bf16_t)0; VWsh[32 * VT_LD + e] = 0; }
    f32x4 Cacc[2][3];
#pragma unroll
    for (int db = 0; db < 2; ++db)
#pragma unroll
        for (int jb = 0; jb < 3; ++jb) Cacc[db][jb] = (f32x4){0.f, 0.f, 0.f, 0.f};
    float m_prev = 0.f;
    for (int c = 0; c < 16; ++c) {
        const int tok0 = b * SEQ + c * 128;
        u32x4 kp[8];
#pragma unroll
        for (int i = 0; i < 8; ++i) { const int pc = i * 512 + tid, row = pc >> 5, c8 = pc & 31; kp[i] = *(const u32x4*)(Z + (size_t)(tok0 + row) * ZC + Z_K + h * 256 + c8 * 8); }
        const int vs_s = tid >> 2, vs_q = tid & 3;
        const u32x4 vp = *(const u32x4*)(Z + (size_t)(tok0 + vs_s) * ZC + Z_V + h * 256 + j0 + vs_q * 8);
        bf16x8 qf[8];
#pragma unroll
        for (int kk = 0; kk < 8; ++kk) qf[kk] = *(const bf16x8*)(Z + (size_t)(tok0 + 16 * wid + li) * ZC + Z_Q + h * 256 + kk * 32 + kg * 8);
        bf16x8 ktf[2][4];
#pragma unroll
        for (int db = 0; db < 2; ++db)
#pragma unroll
            for (int k2 = 0; k2 < 4; ++k2) ktf[db][k2] = *(const bf16x8*)(KT + ((size_t)(bh * 256 + (2 * wid + db) * 16 + li)) * SEQ + c * 128 + k2 * 32 + kg * 8);
        if (wid == 0) {
            const float i0 = G[(size_t)(tok0 + lane) * 8 + h], f0 = G[(size_t)(tok0 + lane) * 8 + 4 + h];
            const float i1 = G[(size_t)(tok0 + 64 + lane) * 8 + h], f1 = G[(size_t)(tok0 + 64 + lane) * 8 + 4 + h];
            float b0 = f0, b1 = f1;
#pragma unroll
            for (int o = 1; o < 64; o <<= 1) { const float t0 = __shfl_up(b0, o), t1 = __shfl_up(b1, o); if (lane >= o) { b0 += t0; b1 += t1; } }
            b1 += __shfl(b0, 63);
            const float a0 = i0 - b0, a1 = i1 - b1;
            float p0 = a0, p1 = a1;
#pragma unroll
            for (int o = 1; o < 64; o <<= 1) { const float t0 = __shfl_up(p0, o), t1 = __shfl_up(p1, o); if (lane >= o) { p0 = fmaxf(p0, t0); p1 = fmaxf(p1, t1); } }
            p1 = fmaxf(p1, __shfl(p0, 63));
            sA[lane] = a0; sA[64 + lane] = a1; sG[lane] = fmaxf(m_prev, p0); sG[64 + lane] = fmaxf(m_prev, p1); sB[lane] = b0; sB[64 + lane] = b1;
        }
        __syncthreads();
        const float g_last = sG[127], b_last = sB[127];
#pragma unroll
        for (int i = 0; i < 8; ++i) { const int pc = i * 512 + tid, row = pc >> 5, c8 = pc & 31; *(LAS u32x4*)(Ksh + row * KS_LD + c8 * 8) = kp[i]; }
        {
            const float wsv = __expf(sA[vs_s] - g_last);
            const unsigned vw[4] = {vp.x, vp.y, vp.z, vp.w};
#pragma unroll
            for (int e = 0; e < 4; ++e) { const int j = vs_q * 8 + 2 * e; const float lo = bf_lo(vw[e]), hi = bf_hi(vw[e]);
                VTsh[j * VT_LD + vs_s] = (bf16_t)(vw[e] & 0xffff); VTsh[(j + 1) * VT_LD + vs_s] = (bf16_t)(vw[e] >> 16);
                const unsigned sw = cvt_pk_bf16(lo * wsv, hi * wsv);
                VWsh[j * VT_LD + vs_s] = (bf16_t)(sw & 0xffff); VWsh[(j + 1) * VT_LD + vs_s] = (bf16_t)(sw >> 16); }
            if (vs_q == 0) VWsh[32 * VT_LD + vs_s] = (bf16_t)(cvt_pk_bf16(wsv, 0.f) & 0xffff);
        }
        __syncthreads();
        {
            const int t_loc = 16 * wid + li;
            const float g_t = sG[t_loc], b_t = sB[t_loc];
            f32x4 ST[8];
#pragma unroll
            for (int sb = 0; sb < 8; ++sb) { ST[sb] = (f32x4){0.f, 0.f, 0.f, 0.f};
                if (sb <= wid) {
#pragma unroll
                    for (int kk = 0; kk < 8; ++kk) { const bf16x8 kf = *(const LAS bf16x8*)(Ksh + (sb * 16 + li) * KS_LD + kk * 32 + kg * 8);
                        ST[sb] = __builtin_amdgcn_mfma_f32_16x16x32_bf16(kf, qf[kk], ST[sb], 0, 0, 0); }
                    const f32x4 av = *(const LAS f32x4*)(sA + sb * 16 + kg * 4);
#pragma unroll
                    for (int r = 0; r < 4; ++r) { const float wgt = __expf(av[r] - g_t); const bool ok = (sb < wid) || (kg * 4 + r <= li); ST[sb][r] = ok ? ST[sb][r] * wgt : 0.f; }
                } }
            f32x4 nt[3], it[3];
#pragma unroll
            for (int jb = 0; jb < 3; ++jb) { nt[jb] = (f32x4){0.f, 0.f, 0.f, 0.f}; it[jb] = (f32x4){0.f, 0.f, 0.f, 0.f}; }
#pragma unroll
            for (int k2 = 0; k2 < 4; ++k2) if (2 * k2 <= wid) {
                u32x4 pw; pw.x = cvt_pk_bf16(ST[2 * k2][0], ST[2 * k2][1]); pw.y = cvt_pk_bf16(ST[2 * k2][2], ST[2 * k2][3]);
                pw.z = cvt_pk_bf16(ST[2 * k2 + 1][0], ST[2 * k2 + 1][1]); pw.w = cvt_pk_bf16(ST[2 * k2 + 1][2], ST[2 * k2 + 1][3]);
                bf16x8 pf; __builtin_memcpy(&pf, &pw, 16);
#pragma unroll
                for (int jb = 0; jb < 3; ++jb) { const LAS bf16_t* vr = VTsh + (jb * 16 + li) * VT_LD + k2 * 32 + kg * 4;
                    u32x4 vw4; const u32x2 lo = *(const LAS u32x2*)vr, hi = *(const LAS u32x2*)(vr + 16); vw4.x = lo.x; vw4.y = lo.y; vw4.z = hi.x; vw4.w = hi.y;
                    bf16x8 vf; __builtin_memcpy(&vf, &vw4, 16);
                    nt[jb] = __builtin_amdgcn_mfma_f32_16x16x32_bf16(vf, pf, nt[jb], 0, 0, 0); } }
#pragma unroll
            for (int kk = 0; kk < 8; ++kk)
#pragma unroll
                for (int jb = 0; jb < 3; ++jb) { const bf16x8 cf = *(const LAS bf16x8*)(CTsh + (jb * 16 + li) * KS_LD + kk * 32 + kg * 8);
                    it[jb] = __builtin_amdgcn_mfma_f32_16x16x32_bf16(cf, qf[kk], it[jb], 0, 0, 0); }
            const float w_int = __expf(m_prev - g_t);
#pragma unroll
            for (int jb = 0; jb < 3; ++jb) nt[jb] = nt[jb] + it[jb] * w_int;
            const float den = __shfl(nt[2][0], li);
            const float rden = 1.0f / fmaxf(fabsf(den), __expf(-(b_t + g_t)));
#pragma unroll
            for (int jb = 0; jb < 2; ++jb) { u32x2 w; w.x = cvt_pk_bf16(nt[jb][0] * rden, nt[jb][1] * rden); w.y = cvt_pk_bf16(nt[jb][2] * rden, nt[jb][3] * rden);
                *(u32x2*)(H + (size_t)(tok0 + t_loc) * DM + h * 256 + j0 + jb * 16 + kg * 4) = w; }
        }
        __syncthreads();
        {
            const float decay = __expf(m_prev - g_last);
#pragma unroll
            for (int db = 0; db < 2; ++db)
#pragma unroll
                for (int jb = 0; jb < 3; ++jb) Cacc[db][jb] = Cacc[db][jb] * decay;
#pragma unroll
            for (int k2 = 0; k2 < 4; ++k2)
#pragma unroll
                for (int jb = 0; jb < 3; ++jb) { const bf16x8 vf = *(const LAS bf16x8*)(VWsh + (jb * 16 + li) * VT_LD + k2 * 32 + kg * 8);
#pragma unroll
                    for (int db = 0; db < 2; ++db) Cacc[db][jb] = __builtin_amdgcn_mfma_f32_16x16x32_bf16(ktf[db][k2], vf, Cacc[db][jb], 0, 0, 0); }
#pragma unroll
            for (int db = 0; db < 2; ++db)
#pragma unroll
                for (int jb = 0; jb < 3; ++jb) { u32x2 w; w.x = cvt_pk_bf16(Cacc[db][jb][0], Cacc[db][jb][1]); w.y = cvt_pk_bf16(Cacc[db][jb][2], Cacc[db][jb][3]);
                    *(LAS u32x2*)(CTsh + (jb * 16 + li) * KS_LD + (2 * wid + db) * 16 + kg * 4) = w; }
            m_prev = b_last + g_last;
        }
    }
#pragma unroll
    for (int db = 0; db < 2; ++db) { const int d0 = (2 * wid + db) * 16 + kg * 4;
#pragma unroll
        for (int jb = 0; jb < 2; ++jb)
#pragma unroll
            for (int r = 0; r < 4; ++r) p.out[O_CP + ((size_t)(bh * 256 + d0 + r)) * 256 + j0 + jb * 16 + li] = Cacc[db][jb][r];
        if (vs == 0 && li == 0) {
#pragma unroll
            for (int r = 0; r < 4; ++r) p.out[O_NP + (size_t)bh * 256 + d0 + r] = Cacc[db][2][r]; } }
    if (vs == 0 && tid == 0) p.out[O_MP + bh] = m_prev;
    __syncthreads();
}

__device__ __forceinline__ void mlstm_sample_item(const Params& p, LAS unsigned char* lds, int item) {
    const int tid = threadIdx.x, bs = item >> 2, h = item & 3, tok0 = NPROMPT + bs * 4;
    LAS float* sq = (LAS float*)lds; LAS float* sk = sq + 1024; LAS float* sv = sk + 1024; LAS float* sn0 = sv + 1024; LAS float* sdot = sn0 + 256; LAS float* sc = sdot + 32; LAS float* sred = sc + 64;
    const bf16_t* Z = (const bf16_t*)(p.ws + WS_Z); const float* G = (const float*)(p.ws + WS_G); bf16_t* H = (bf16_t*)(p.ws + WS_H);
    for (int e = tid; e < 3072; e += 512) { const int which = e >> 10, idx = e & 1023, t = idx >> 8, d = idx & 255;
        sq[e] = bf2f(Z[(size_t)(tok0 + t) * ZC + Z_Q + which * 1024 + h * 256 + d]); }
    if (tid < 256) sn0[tid] = p.sn[(size_t)item * 256 + tid];
    __syncthreads();
    {
        const int id = tid >> 4, part = tid & 15;
        if (id < 20) { const LAS float* va = id < 16 ? sq + (id >> 2) * 256 : sq + (id - 16) * 256; const LAS float* vb = id < 16 ? sk + (id & 3) * 256 : sn0;
            float s = 0.f;
#pragma unroll
            for (int e = 0; e < 16; ++e) s += va[part * 16 + e] * vb[part * 16 + e];
            s += __shfl_xor(s, 8); s += __shfl_xor(s, 4); s += __shfl_xor(s, 2); s += __shfl_xor(s, 1);
            if (part == 0) sdot[id] = s; }
    }
    __syncthreads();
    if (tid == 0) {
        const float m0 = p.sm[item];
        float li_[4], lf_[4], bb[4], aa[4], gg[4];
#pragma unroll
        for (int s = 0; s < 4; ++s) { li_[s] = G[(size_t)(tok0 + s) * 8 + h]; lf_[s] = G[(size_t)(tok0 + s) * 8 + 4 + h]; }
        float cum = 0.f, pm = m0;
#pragma unroll
        for (int s = 0; s < 4; ++s) { cum += lf_[s]; bb[s] = cum; aa[s] = li_[s] - cum; pm = fmaxf(pm, aa[s]); gg[s] = pm; }
#pragma unroll
        for (int t = 0; t < 4; ++t) { const float wi = __expf(m0 - gg[t]); float den = wi * sdot[16 + t];
#pragma unroll
            for (int s = 0; s < 4; ++s) { const float S = s <= t ? sdot[t * 4 + s] * __expf(aa[s] - gg[t]) : 0.f; sc[16 + t * 4 + s] = S; den += S; }
            sc[t] = wi; sc[12 + t] = 1.0f / fmaxf(fabsf(den), __expf(-(bb[t] + gg[t]))); }
#pragma unroll
        for (int s = 0; s < 4; ++s) sc[4 + s] = __expf(aa[s] - gg[3]);
        sc[8] = __expf(m0 - gg[3]); sc[9] = bb[3] + gg[3];
    }
    __syncthreads();
    const float decay = sc[8]; const float ws0 = sc[4], ws1 = sc[5], ws2 = sc[6], ws3 = sc[7];
    const int c4 = tid & 63, rw = tid >> 6, col = c4 * 4;
    const f32x4 v0 = *(const LAS f32x4*)(sv + col), v1 = *(const LAS f32x4*)(sv + 256 + col), v2 = *(const LAS f32x4*)(sv + 512 + col), v3 = *(const LAS f32x4*)(sv + 768 + col);
    f32x4 a0 = {0.f, 0.f, 0.f, 0.f}, a1 = a0, a2 = a0, a3 = a0;
    const float* C0 = p.sC + (size_t)item * 65536; float* C1 = p.out + O_CS + (size_t)item * 65536;
#pragma unroll 8
    for (int r = 0; r < 32; ++r) { const int d = rw * 32 + r;
        const f32x4 cv = *(const f32x4*)(C0 + (size_t)d * 256 + col);
        a0 += cv * sq[d]; a1 += cv * sq[256 + d]; a2 += cv * sq[512 + d]; a3 += cv * sq[768 + d];
        const f32x4 cn = cv * decay + v0 * (ws0 * sk[d]) + v1 * (ws1 * sk[256 + d]) + v2 * (ws2 * sk[512 + d]) + v3 * (ws3 * sk[768 + d]);
        *(f32x4*)(C1 + (size_t)d * 256 + col) = cn; }
    *(LAS f32x4*)(sred + (rw * 4 + 0) * 256 + col) = a0; *(LAS f32x4*)(sred + (rw * 4 + 1) * 256 + col) = a1; *(LAS f32x4*)(sred + (rw * 4 + 2) * 256 + col) = a2; *(LAS f32x4*)(sred + (rw * 4 + 3) * 256 + col) = a3;
    __syncthreads();
#pragma unroll
    for (int e = 0; e < 2; ++e) { const int o = tid + 512 * e, t = o >> 8, cx = o & 255;
        float inter = 0.f;
#pragma unroll
        for (int w = 0; w < 8; ++w) inter += sred[(w * 4 + t) * 256 + cx];
        float num = sc[t] * inter;
#pragma unroll
        for (int s = 0; s < 4; ++s) num += sc[16 + t * 4 + s] * sv[s * 256 + cx];
        H[(size_t)(tok0 + t) * DM + h * 256 + cx] = (bf16_t)(cvt_pk_bf16(num * sc[12 + t], 0.f) & 0xffff); }
    if (tid < 256) p.out[O_NS + (size_t)item * 256 + tid] = decay * sn0[tid] + ws0 * sk[tid] + ws1 * sk[256 + tid] + ws2 * sk[512 + tid] + ws3 * sk[768 + tid];
    if (tid == 0) p.out[O_MS + item] = sc[9];
    __syncthreads();
}

__device__ __forceinline__ void conv_items(const Params& p) {
    const bf16_t* Z = (const bf16_t*)(p.ws + WS_Z); bf16_t* AC = (bf16_t*)(p.ws + WS_AC);
    const int gt = blockIdx.x * 512 + threadIdx.x, NG = gridDim.x * 512;
    for (int unit = gt; unit < NTOK * 128; unit += NG) {
        const int r = unit >> 7, ch = (unit & 127) * 8;
        const u32x4 uw = *(const u32x4*)(Z + (size_t)r * ZC + Z_U + ch), bw = *(const u32x4*)(Z + (size_t)r * ZC + Z_BG + ch);
        float u0[8], u1[8], u2[8], bg[8];
        const unsigned uu[4] = {uw.x, uw.y, uw.z, uw.w}, bb[4] = {bw.x, bw.y, bw.z, bw.w};
#pragma unroll
        for (int e = 0; e < 4; ++e) { u2[2 * e] = bf_lo(uu[e]); u2[2 * e + 1] = bf_hi(uu[e]); bg[2 * e] = bf_lo(bb[e]); bg[2 * e + 1] = bf_hi(bb[e]); }
        const bool prompt = r < NPROMPT; const int t = prompt ? (r & 2047) : ((r - NPROMPT) & 3); const int bs = (r - NPROMPT) >> 2;
        if (t >= 1) { const u32x4 w = *(const u32x4*)(Z + (size_t)(r - 1) * ZC + Z_U + ch); const unsigned q[4] = {w.x, w.y, w.z, w.w};
#pragma unroll
            for (int e = 0; e < 4; ++e) { u1[2 * e] = bf_lo(q[e]); u1[2 * e + 1] = bf_hi(q[e]); } }
        else if (prompt) {
#pragma unroll
            for (int e = 0; e < 8; ++e) u1[e] = 0.f; }
        else { const float* sp = p.sconv + ((size_t)bs * 2 + 1) * DM + ch;
#pragma unroll
            for (int e = 0; e < 8; ++e) u1[e] = sp[e]; }
        if (t >= 2) { const u32x4 w = *(const u32x4*)(Z + (size_t)(r - 2) * ZC + Z_U + ch); const unsigned q[4] = {w.x, w.y, w.z, w.w};
#pragma unroll
            for (int e = 0; e < 4; ++e) { u0[2 * e] = bf_lo(q[e]); u0[2 * e + 1] = bf_hi(q[e]); } }
        else if (prompt) {
#pragma unroll
            for (int e = 0; e < 8; ++e) u0[e] = 0.f; }
        else { const float* sp = p.sconv + ((size_t)bs * 2 + t) * DM + ch;
#pragma unroll
            for (int e = 0; e < 8; ++e) u0[e] = sp[e]; }
        float o[8];
#pragma unroll
        for (int e = 0; e < 8; ++e) o[e] = bg[e] * (p.conv_w[ch + e] * u0[e] + p.conv_w[DM + ch + e] * u1[e] + p.conv_w[2 * DM + ch + e] * u2[e]);
        u32x4 w; w.x = cvt_pk_bf16(o[0], o[1]); w.y = cvt_pk_bf16(o[2], o[3]); w.z = cvt_pk_bf16(o[4], o[5]); w.w = cvt_pk_bf16(o[6], o[7]);
        *(u32x4*)(AC + (size_t)r * DM + ch) = w;
        float* so = nullptr;
        if (prompt) { if (t >= SEQ - 2) so = p.out + O_CONVP + ((size_t)(r >> 11) * 2 + (t - (SEQ - 2))) * DM + ch; }
        else if (t >= 2) so = p.out + O_CONVS + ((size_t)bs * 2 + (t - 2)) * DM + ch;
        if (so) {
#pragma unroll
            for (int e = 0; e < 8; ++e) so[e] = u2[e]; }
    }
}

__device__ __forceinline__ void hn_items(const Params& p) {
    const bf16_t* Z = (const bf16_t*)(p.ws + WS_Z); const bf16_t* H = (const bf16_t*)(p.ws + WS_H); bf16_t* HN = (bf16_t*)(p.ws + WS_HN);
    const int lane = threadIdx.x & 63, gw = blockIdx.x * 8 + (threadIdx.x >> 6), NGW = gridDim.x * 8, c0 = lane * 16;
    f32x4 mg[4];
#pragma unroll
    for (int j = 0; j < 4; ++j) mg[j] = *(const f32x4*)(p.mh_g + c0 + 4 * j);
    for (int r = gw; r < NTOK; r += NGW) {
        const u32x4 h0 = *(const u32x4*)(H + (size_t)r * DM + c0), h1 = *(const u32x4*)(H + (size_t)r * DM + c0 + 8);
        const u32x4 o0 = *(const u32x4*)(Z + (size_t)r * ZC + Z_O + c0), o1 = *(const u32x4*)(Z + (size_t)r * ZC + Z_O + c0 + 8);
        const unsigned hw[8] = {h0.x, h0.y, h0.z, h0.w, h1.x, h1.y, h1.z, h1.w}, ow[8] = {o0.x, o0.y, o0.z, o0.w, o1.x, o1.y, o1.z, o1.w};
        float v[16]; float s = 0.f;
#pragma unroll
        for (int e = 0; e < 8; ++e) { v[2 * e] = bf_lo(hw[e]); v[2 * e + 1] = bf_hi(hw[e]); s += v[2 * e] + v[2 * e + 1]; }
        s += __shfl_xor(s, 1); s += __shfl_xor(s, 2); s += __shfl_xor(s, 4); s += __shfl_xor(s, 8);
        const float mean = s * (1.0f / 256.0f); float q = 0.f;
#pragma unroll
        for (int e = 0; e < 16; ++e) { v[e] -= mean; q += v[e] * v[e]; }
        q += __shfl_xor(q, 1); q += __shfl_xor(q, 2); q += __shfl_xor(q, 4); q += __shfl_xor(q, 8);
        const float rstd = 1.0f / sqrtf(q * (1.0f / 256.0f) + LN_EPS);
        unsigned ww[8];
#pragma unroll
        for (int e = 0; e < 8; ++e) { const float g0 = mg[(2 * e) >> 2][(2 * e) & 3], g1 = mg[(2 * e + 1) >> 2][(2 * e + 1) & 3];
            ww[e] = cvt_pk_bf16(v[2 * e] * rstd * g0 * bf_lo(ow[e]), v[2 * e + 1] * rstd * g1 * bf_hi(ow[e])); }
        u32x4 w0, w1; w0.x = ww[0]; w0.y = ww[1]; w0.z = ww[2]; w0.w = ww[3]; w1.x = ww[4]; w1.y = ww[5]; w1.z = ww[6]; w1.w = ww[7];
        *(u32x4*)(HN + (size_t)r * DM + c0) = w0; *(u32x4*)(HN + (size_t)r * DM + c0 + 8) = w1;
    }
}

template <bool OUT_F32>
__device__ __forceinline__ void ln_rows(const float* R, const float* gam, const float* bet, void* out) {
    const int lane = threadIdx.x & 63, gw = blockIdx.x * 8 + (threadIdx.x >> 6), NGW = gridDim.x * 8;
    f32x4 gv[4], bv[4];
#pragma unroll
    for (int j = 0; j < 4; ++j) { gv[j] = *(const f32x4*)(gam + j * 256 + lane * 4); bv[j] = *(const f32x4*)(bet + j * 256 + lane * 4); }
    for (int r = gw; r < NTOK; r += NGW) {
        f32x4 v[4]; float s = 0.f;
#pragma unroll
        for (int j = 0; j < 4; ++j) { v[j] = *(const f32x4*)(R + (size_t)r * DM + j * 256 + lane * 4); s += (v[j][0] + v[j][1]) + (v[j][2] + v[j][3]); }
        const float mean = wave_sum(s) * (1.0f / DM); float q = 0.f;
#pragma unroll
        for (int j = 0; j < 4; ++j) { v[j] = v[j] - mean; q += (v[j][0] * v[j][0] + v[j][1] * v[j][1]) + (v[j][2] * v[j][2] + v[j][3] * v[j][3]); }
        const float rstd = 1.0f / sqrtf(wave_sum(q) * (1.0f / DM) + LN_EPS);
#pragma unroll
        for (int j = 0; j < 4; ++j) { const f32x4 y = v[j] * rstd * gv[j] + bv[j];
            if (OUT_F32) *(f32x4*)((float*)out + (size_t)r * DM + j * 256 + lane * 4) = y;
            else { u32x2 w; w.x = cvt_pk_bf16(y[0], y[1]); w.y = cvt_pk_bf16(y[2], y[3]); *(u32x2*)((bf16_t*)out + (size_t)r * DM + j * 256 + lane * 4) = w; } }
    }
}

__global__ void __launch_bounds__(512, 2) mega(Params p) {
    extern __shared__ __attribute__((aligned(16))) unsigned char shm_raw[];
    LAS unsigned char* lds = (LAS unsigned char*)shm_raw;
    const int G = gridDim.x, c = blockIdx.x;
    unsigned char* ws = p.ws;
    volatile LAS unsigned* xst = (volatile LAS unsigned*)(lds + 131072);
    if (threadIdx.x == 0) { xst[0] = 0u; xst[1] = 0u; }
    __syncthreads();
    const XcdBarrier xb = xcd_barrier_post((unsigned*)(ws + WS_BAR), xst);
    if (p.ph_hi > 64) cg::this_grid().sync();
#if MK_MULTI
#define PH_SYNC(k)
#else
#define PH_SYNC(k) do { if (p.ph_lo <= (k) && (k) + 1 < p.ph_hi) xcd_barrier(xb); } while (0)
#endif
#define PH_ON(k) (((PHMASK >> (k)) & 1) && p.ph_lo <= (k) && (k) < p.ph_hi)
#ifndef REPMASK
#define REPMASK 0
#endif
    if (PH_ON(0)) phase0(p, lds);
    PH_SYNC(0);
    if (PH_ON(1)) { pg8::StaticOrder S; S.init(NTOK, NZ, G, c); pg8::Gemm g{(const bf16_t*)(ws + WS_XB), (const bf16_t*)(ws + WS_WIN), NTOK, NZ, DM};
        EpiZ E{(bf16_t*)(ws + WS_Z), (bf16_t*)(ws + WS_KT)}; pg8::gemm_phase(lds, g, S, E); }
    PH_SYNC(1);
    if (PH_ON(2)) {
        for (int it = c; it < 256; it += G) { const int xcd = it & 7, idx = it >> 3; mlstm_prompt_item(p, lds, xcd * 4 + (idx >> 3), idx & 7); }
        for (int it = c; it < 512; it += G) mlstm_sample_item(p, lds, it);
        conv_items(p);
    }
    PH_SYNC(2);
    if (PH_ON(3)) { hn_items(p);
        pg8::StaticOrder S; S.init(NTOK, DM, G, c); pg8::Gemm g{(const bf16_t*)(ws + WS_AC), (const bf16_t*)(ws + WS_WC), NTOK, DM, DM};
        EpiGate E{(bf16_t*)(ws + WS_XB), nullptr, (const bf16_t*)(ws + WS_Z), Z_GC, 0}; pg8::gemm_phase(lds, g, S, E); }
    PH_SYNC(3);
    if (PH_ON(4)) { pg8::StaticOrder S; S.init(NTOK, DM, G, c); pg8::Gemm g{(const bf16_t*)(ws + WS_HN), (const bf16_t*)(ws + WS_WM), NTOK, DM, DM};
        EpiGate E{(bf16_t*)(ws + WS_AC), (const bf16_t*)(ws + WS_XB), (const bf16_t*)(ws + WS_Z), Z_GM, 1}; pg8::gemm_phase(lds, g, S, E); }
    PH_SYNC(4);
    if (PH_ON(5)) { pg8::StaticOrder S; S.init(NTOK, DM, G, c); pg8::Gemm g{(const bf16_t*)(ws + WS_AC), (const bf16_t*)(ws + WS_WO), NTOK, DM, DM};
        EpiResX E{(float*)(ws + WS_R), p.xp, p.xs}; pg8::gemm_phase(lds, g, S, E); }
    PH_SYNC(5);
    if (PH_ON(6)) ln_rows<false>((const float*)(ws + WS_R), p.ln1g, p.ln1b, ws + WS_H);
    PH_SYNC(6);
    if (PH_ON(7)) { pg8::StaticOrder S; S.init(NTOK, DFF, G, c); pg8::Gemm g{(const bf16_t*)(ws + WS_H), (const bf16_t*)(ws + WS_W1), NTOK, DFF, DM};
        EpiHid E{(bf16_t*)(ws + WS_HID)}; pg8::gemm_phase(lds, g, S, E); }
    PH_SYNC(7);
    if (PH_ON(8)) { pg8::StaticOrder S; S.init(NTOK, DM, G, c); pg8::Gemm g{(const bf16_t*)(ws + WS_HID), (const bf16_t*)(ws + WS_W2), NTOK, DM, DFF};
        EpiResB E{(float*)(ws + WS_R), (const bf16_t*)(ws + WS_H)}; pg8::gemm_phase(lds, g, S, E); }
    PH_SYNC(8);
    if (PH_ON(9)) ln_rows<true>((const float*)(ws + WS_R), p.ln2g, p.ln2b, p.out + O_Y);
}

extern "C" void kernel_launch(void* const* d_in, const int* in_sizes, int n_in, void* d_out, int out_size, void* d_ws, size_t ws_size, hipStream_t stream) {
    static int grid = 0;
    if (grid == 0) {
        if (n_in != 19 || ws_size < WS_END) { fprintf(stderr, "kernel_launch: unexpected inputs (n_in %d, ws %zu, need %zu)\n", n_in, ws_size, (size_t)WS_END); grid = -1; return; }
        int dev = 0, cus = 0, per_cu = 0;
        hipGetDevice(&dev); hipDeviceGetAttribute(&cus, hipDeviceAttributeMultiprocessorCount, dev);
        hipFuncSetAttribute((const void*)mega, hipFuncAttributeMaxDynamicSharedMemorySize, LDS_BYTES);
        hipOccupancyMaxActiveBlocksPerMultiprocessor(&per_cu, (const void*)mega, 512, LDS_BYTES);
        if (per_cu < 1 || cus < 1) { fprintf(stderr, "kernel_launch: occupancy query says %d blocks/CU on %d CUs\n", per_cu, cus); grid = -1; return; }
        grid = cus;
    }
    if (grid < 0) return;
    Params p{};
    const float** f = (const float**)&p;
    for (int i = 0; i < 19; ++i) f[i] = (const float*)d_in[i];
    p.out = (float*)d_out; p.ws = (unsigned char*)d_ws;
#if MK_MULTI
    for (int ph = 0; ph < 10; ++ph) for (int rep = 0; rep < ((REPMASK >> ph) & 1) + 1; ++rep) { p.ph_lo = ph; p.ph_hi = ph + 1; hipLaunchKernelGGL(mega, dim3(grid), dim3(512), LDS_BYTES, stream, p); }
#else
    p.ph_lo = 0; p.ph_hi = 10;
    if (hipMemsetAsync((char*)d_ws + WS_BAR, 0, 16384, stream) != hipSuccess) { fprintf(stderr, "memset failed\n"); return; }
    void* args[] = {&p};
    hipError_t e = hipLaunchCooperativeKernel((const void*)mega, dim3(grid), dim3(512), args, LDS_BYTES, stream);
    if (e != hipSuccess) fprintf(stderr, "cooperative launch failed: %s (grid %d)\n", hipGetErrorString(e), grid);
#endif
}
```

```cpp
#include <hip/hip_runtime.h>
#include <hip/hip_cooperative_groups.h>
#include <cstdio>
namespace cg = cooperative_groups;

#ifndef PHMASK
#define PHMASK 1023
#endif
#ifndef MK_MULTI
#define MK_MULTI 0
#endif

#define LAS __attribute__((address_space(3)))
typedef unsigned short bf16_t;
typedef short bf16x8 __attribute__((ext_vector_type(8)));
typedef float f32x4 __attribute__((ext_vector_type(4)));
typedef float f32x2 __attribute__((ext_vector_type(2)));
typedef unsigned u32x4 __attribute__((ext_vector_type(4)));
typedef unsigned u32x2 __attribute__((ext_vector_type(2)));

constexpr int DM = 1024, NPROMPT = 8 * 2048, NSAMPLE = 128 * 4, NTOK = NPROMPT + NSAMPLE;
constexpr int SEQ = 2048, NH = 4, DH = 256, DFF = 4096, DIN = 9224, NZ = 9216, ZC = 5120;
constexpr float ALPHA = 1.189207115002721f;
constexpr float LN_EPS = 1e-5f;
constexpr int Z_BG = 0, Z_U = 1024, Z_O = 2048, Z_GC = 3072, Z_GM = 4096;
constexpr int HM_SAMPLE0 = 32 * 2048;
constexpr size_t O_Y = 0, O_CONVP = 17301504, O_CONVS = 17317888, O_CP = 17580032, O_CS = 19677184, O_NP = 53231616, O_NS = 53239808, O_MP = 53370880, O_MS = 53370912;
constexpr size_t SZ_ACT = (size_t)NTOK * DM * 2;
constexpr size_t WS_XB = 0;
constexpr size_t WS_WIN = WS_XB + SZ_ACT;
constexpr size_t WS_WC = WS_WIN + (size_t)NZ * DM * 2;
constexpr size_t WS_WM = WS_WC + (size_t)DM * DM * 2;
constexpr size_t WS_WO = WS_WM + (size_t)DM * DM * 2;
constexpr size_t WS_W1 = WS_WO + (size_t)DM * DM * 2;
constexpr size_t WS_W2 = WS_W1 + (size_t)DFF * DM * 2;
constexpr size_t WS_G = WS_W2 + (size_t)DFF * DM * 2;
constexpr size_t WS_Z = WS_G + (size_t)NTOK * 8 * 4;
constexpr size_t WS_HID = WS_Z;
constexpr size_t WS_R = WS_Z + (size_t)NTOK * DFF * 2;
constexpr size_t WS_QKV = WS_Z + (size_t)NTOK * ZC * 2;
constexpr size_t WS_KT = WS_QKV + 3 * SZ_ACT;
constexpr size_t WS_H = WS_KT + (size_t)32 * 256 * 2048 * 2;
constexpr size_t WS_AC = WS_H + SZ_ACT;
constexpr size_t WS_HN = WS_AC + SZ_ACT;
constexpr size_t WS_BAR = WS_HN + SZ_ACT;
constexpr size_t WS_END = WS_BAR + 16384;
constexpr int LDS_BYTES = 131072 + 16;

struct Params {
    const float *xp, *xs, *sconv, *sC, *sn, *sm, *w_in, *b_gate, *conv_w, *w_co, *mh_g, *w_mo, *w_o, *ln1g, *ln1b, *w_ff1, *w_ff2, *ln2g, *ln2b;
    float* out; unsigned char* ws; int ph_lo, ph_hi;
};

__device__ __forceinline__ unsigned cvt_pk_bf16(float lo, float hi) { unsigned r; asm volatile("v_cvt_pk_bf16_f32 %0, %1, %2" : "=v"(r) : "v"(lo), "v"(hi)); return r; }
__device__ __forceinline__ float bf_lo(unsigned w) { return __uint_as_float(w << 16); }
__device__ __forceinline__ float bf_hi(unsigned w) { return __uint_as_float(w & 0xffff0000u); }
__device__ __forceinline__ float bf2f(bf16_t b) { return __uint_as_float(((unsigned)b) << 16); }
__device__ __forceinline__ float sigmoidf_(float x) { return 1.0f / (1.0f + __expf(-x)); }
__device__ __forceinline__ float wave_sum(float v) {
#pragma unroll
    for (int o = 1; o < 64; o <<= 1) v += __shfl_xor(v, o);
    return v;
}
__device__ __forceinline__ const float* xrow(const Params& p, int r) { return r < NPROMPT ? p.xp + (size_t)r * DM : p.xs + (size_t)(r - NPROMPT) * DM; }
#define LDS_WAIT() asm volatile("s_waitcnt lgkmcnt(0)" ::: "memory")

#define XB_TMO      128
#define XB_XCNT(j)  (256  + 64 * (j))
#define XB_XSUB(j)  (1280 + 64 * (j))
#define XB_XGEN(j)  (2304 + 64 * (j))
#define XB_TOP      3328
#define XB_TOPGEN   3392
#define XCD_BAR_WORDS 3456
#define XB_SPIN_CAP (1u << 22)
__device__ __forceinline__ unsigned xb_ld(unsigned* p)              { return __hip_atomic_load(p, __ATOMIC_RELAXED, __HIP_MEMORY_SCOPE_AGENT); }
__device__ __forceinline__ unsigned xb_add(unsigned* p, unsigned v) { return __hip_atomic_fetch_add(p, v, __ATOMIC_RELAXED, __HIP_MEMORY_SCOPE_AGENT); }
__device__ __forceinline__ unsigned xb_xcc_id() { return (unsigned)__builtin_amdgcn_s_getreg((3 << 11) | 20) & 0xFu; }
#define XB_SPIN(cond, bar) do { unsigned _sp = 0; while (cond) { __builtin_amdgcn_s_sleep(1); \
    if ((++_sp & 255u) == 0u) { if (xb_ld(&(bar)[XB_TMO])) break; if (_sp > XB_SPIN_CAP) { atomicAdd(&(bar)[XB_TMO], 1u); break; } } } } while (0)
struct XcdBarrier { unsigned* bar; unsigned x; volatile LAS unsigned* st; };
__device__ __forceinline__ XcdBarrier xcd_barrier_post(unsigned* bar, volatile LAS unsigned* st) {
    XcdBarrier b; b.bar = bar; b.x = xb_xcc_id(); b.st = st;
    if (threadIdx.x == 0) (void)xb_add(&bar[XB_XCNT(b.x)], 1u);
    return b;
}
__device__ __forceinline__ void xcd_barrier_complete(unsigned* bar, unsigned x, unsigned& nloc, unsigned& nx) {
    const unsigned G = gridDim.x * gridDim.y * gridDim.z;
    unsigned sum, cnt, mine, sp = 0u;
    for (;;) {
        sum = 0u; cnt = 0u; mine = 0u;
#pragma unroll
        for (unsigned j = 0; j < 16; ++j) { const unsigned c = xb_ld(&bar[XB_XCNT(j)]); sum += c; cnt += (c > 0u) ? 1u : 0u; mine = (j == x) ? c : mine; }
        if (sum == G) break;
        __builtin_amdgcn_s_sleep(1);
        if ((++sp & 255u) == 0u) { if (xb_ld(&bar[XB_TMO])) break; if (sp > XB_SPIN_CAP) { atomicAdd(&bar[XB_TMO], 1u); break; } }
    }
    nloc = mine > 0u ? mine : 1u; nx = cnt > 0u ? cnt : 1u;
}
__device__ __forceinline__ void xcd_barrier(const XcdBarrier& b) {
    asm volatile("s_waitcnt vmcnt(0)" ::: "memory");
    __syncthreads();
    if (threadIdx.x == 0) {
        unsigned* bar = b.bar;
        __builtin_amdgcn_s_waitcnt(0);
        unsigned nloc = b.st[0], nx = b.st[1];
        if (nloc == 0u) { xcd_barrier_complete(bar, b.x, nloc, nx); b.st[0] = nloc; b.st[1] = nx; }
        const unsigned old = xb_add(&bar[XB_XSUB(b.x)], 1u);
        const unsigned gen = old / nloc;
        if (old + 1u == (gen + 1u) * nloc) {
            __builtin_amdgcn_fence(__ATOMIC_RELEASE, "agent");
            asm volatile("s_waitcnt vmcnt(0)" ::: "memory");
            const unsigned og = xb_add(&bar[XB_TOP], 1u);
            const unsigned tg = og / nx;
            if (og + 1u == (tg + 1u) * nx) xb_add(&bar[XB_TOPGEN], 1u);
            else XB_SPIN(xb_ld(&bar[XB_TOPGEN]) == tg, bar);
            __builtin_amdgcn_fence(__ATOMIC_ACQUIRE, "agent");
            xb_add(&bar[XB_XGEN(b.x)], 1u);
            asm volatile("s_waitcnt vmcnt(0)" ::: "memory");
        } else {
            XB_SPIN(xb_ld(&bar[XB_XGEN(b.x)]) == gen, bar);
            __builtin_amdgcn_fence(__ATOMIC_ACQUIRE, "agent");
            asm volatile("s_waitcnt vmcnt(0)" ::: "memory");
        }
    }
    __syncthreads();
}

namespace pg8 {
constexpr int BM = 256, BK = 64, HALF = 128, HTB = HALF * BK * 2, NXCD = 8, WGM = 8;
__host__ __device__ __forceinline__ int lds_byte(int r, int c) { const int st = (r >> 4) * 2 + (c >> 5), rr = r & 15, cc = c & 31, ob = rr * 64 + cc * 2; return st * 1024 + (ob ^ (((ob >> 9) & 1) << 5)); }
__host__ __device__ __forceinline__ void stage_rc(int b, int& R, int& C) { const int st = b / 1024, sb = b % 1024, swz = sb ^ (((sb >> 9) & 1) << 5); R = (st >> 1) * 16 + swz / 64; C = (st & 1) * 32 + (swz % 64) / 2; }
__host__ __device__ __forceinline__ int perm32(int rho) { const int n = rho >> 4, i = rho & 15; return 8 * (i >> 2) + 4 * n + (i & 3); }
struct Unit { int pm, pn; };
struct Gemm { const bf16_t* A; const bf16_t* Bt; int M, N, K; };
struct StaticOrder {
    int nM, nN, nwg, G, c;
    __device__ void init(int M, int N, int G_, int c_) { nM = M / BM; nN = N / BM; nwg = nM * nN; G = G_; c = c_; }
    __device__ bool next(int i, Unit& u) const {
        const long L = (long)i * G + c; if (L >= nwg) return false;
        int wgid = (int)L; { const int q = nwg / NXCD, r = nwg % NXCD, xcd = wgid % NXCD, off = wgid / NXCD; wgid = (xcd < r ? xcd * (q + 1) : r * (q + 1) + (xcd - r) * q) + off; }
        const int nig = WGM * nN, gid = wgid / nig, fm = gid * WGM, gsz = (nM - fm) < WGM ? (nM - fm) : WGM;
        u.pm = fm + ((wgid % nig) % gsz); u.pn = (wgid % nig) / gsz; return true;
    }
};

template <class Epi>
__device__ __forceinline__ void gemm_phase(LAS unsigned char* lds, const Gemm g, const StaticOrder& S, const Epi& E) {
    const int tid = threadIdx.x, wid = __builtin_amdgcn_readfirstlane(tid >> 6), lane = tid & 63, wr = wid >> 2, wc = wid & 3, fr = lane & 15, fq = lane >> 4;
    const int K = g.K, nt = K / BK;
    unsigned voffA[2], voffB[2];
#pragma unroll
    for (int i = 0; i < 2; ++i) { int R, C; stage_rc(tid * 16 + i * 8192, R, C); const int Rb = (R & ~31) + perm32(R & 31);
        voffA[i] = (unsigned)(R * K + C) * 2u; voffB[i] = (unsigned)(Rb * K + C) * 2u; }
    const size_t kstep = (size_t)(BK * 2);
    const size_t hstep = (size_t)HALF * K * 2;
    const size_t tstep = 2 * hstep;
    const unsigned ldsw = (unsigned)wid * 1024u;
    const int aoff = lds_byte(wr * 64 + fr, fq * 8), boff = lds_byte(wc * 32 + fr, fq * 8);
#define PG8_SA(b, h) (((b) * 2 + (h)) * HTB)
#define PG8_SB(b, h) ((4 + (b) * 2 + (h)) * HTB)
#define PG8_STAGE(bufoff, gbase, voff) do { _Pragma("unroll") for (int _i = 0; _i < 2; ++_i) \
        __builtin_amdgcn_global_load_lds((const unsigned*)((const char*)(gbase) + (voff)[_i]), (LAS unsigned*)(lds + (bufoff) + ldsw + _i * 8192), 16, 0, 0); } while (0)
#define PG8_LDA(dst, b, h) do { _Pragma("unroll") for (int m = 0; m < 4; ++m) _Pragma("unroll") for (int k = 0; k < 2; ++k) dst[m][k] = *(const LAS bf16x8*)(lds + PG8_SA(b, h) + aoff + m * 2048 + k * 1024); } while (0)
#define PG8_LDB(dst, b, h) do { _Pragma("unroll") for (int n = 0; n < 2; ++n) _Pragma("unroll") for (int k = 0; k < 2; ++k) dst[n][k] = *(const LAS bf16x8*)(lds + PG8_SB(b, h) + boff + n * 2048 + k * 1024); } while (0)
#define PG8_MMA(ai, bj, At, Bt) do { __builtin_amdgcn_s_setprio(1); _Pragma("unroll") for (int m = 0; m < 4; ++m) _Pragma("unroll") for (int n = 0; n < 2; ++n) _Pragma("unroll") for (int k = 0; k < 2; ++k) \
        acc[ai][bj][m][n] = __builtin_amdgcn_mfma_f32_16x16x32_bf16(Bt[n][k], At[m][k], acc[ai][bj][m][n], 0, 0, 0); __builtin_amdgcn_s_setprio(0); } while (0)
#define PG8_WAIT_V(n) asm volatile("s_waitcnt vmcnt(" #n ")" ::: "memory")
#define PG8_WAIT_L(n) asm volatile("s_waitcnt lgkmcnt(" #n ")" ::: "memory")
#define PG8_BAR __builtin_amdgcn_s_barrier()
#define PG8_SCHED __builtin_amdgcn_sched_barrier(0)
    Unit cur, nxt; int ui = 0;
    if (!S.next(0, cur)) return;
    f32x4 acc[2][2][4][2];
#pragma unroll
    for (int a = 0; a < 2; ++a)
#pragma unroll
        for (int b = 0; b < 2; ++b)
#pragma unroll
            for (int m = 0; m < 4; ++m)
#pragma unroll
                for (int n = 0; n < 2; ++n) acc[a][b][m][n] = (f32x4){0.f, 0.f, 0.f, 0.f};
    bf16x8 At[4][2], B0[2][2], B1[2][2];
    const char* cA = (const char*)g.A + (size_t)cur.pm * tstep; const char* cB = (const char*)g.Bt + (size_t)cur.pn * tstep;
    PG8_STAGE(PG8_SB(0, 0), cB, voffB); PG8_STAGE(PG8_SA(0, 0), cA, voffA); PG8_STAGE(PG8_SB(0, 1), cB + hstep, voffB); PG8_STAGE(PG8_SA(0, 1), cA + hstep, voffA);
    if (wr == 1) PG8_BAR;
    PG8_WAIT_V(4); PG8_BAR;
    PG8_STAGE(PG8_SB(1, 0), cB + kstep, voffB); PG8_STAGE(PG8_SA(1, 0), cA + kstep, voffA); PG8_STAGE(PG8_SB(1, 1), cB + hstep + kstep, voffB);
    PG8_WAIT_V(6); PG8_BAR;
    for (;;) {
        const bool has_next = S.next(ui + 1, nxt);
        const char* nA = has_next ? (const char*)g.A + (size_t)nxt.pm * tstep : cA; const char* nB = has_next ? (const char*)g.Bt + (size_t)nxt.pn * tstep : cB;
        for (int t = 0; t < nt; t += 2) {
            const bool last = (t == nt - 2);
            const char* a1 = cA + (size_t)(t + 1) * kstep;
            const char* a2 = last ? nA : cA + (size_t)(t + 2) * kstep; const char* b2 = last ? nB : cB + (size_t)(t + 2) * kstep;
            const char* a3 = a2 + kstep; const char* b3 = b2 + kstep;
            PG8_LDB(B0, 0, 0); PG8_SCHED; PG8_LDA(At, 0, 0); PG8_STAGE(PG8_SA(1, 1), a1 + hstep, voffA);
            PG8_WAIT_L(8); PG8_BAR; PG8_WAIT_L(0); PG8_MMA(0, 0, At, B0); PG8_BAR; PG8_SCHED;
            PG8_LDB(B1, 0, 1); PG8_STAGE(PG8_SB(0, 0), b2, voffB);
            PG8_BAR; PG8_WAIT_L(0); PG8_MMA(0, 1, At, B1); PG8_BAR;
            PG8_LDA(At, 0, 1); PG8_STAGE(PG8_SA(0, 0), a2, voffA);
            PG8_BAR; PG8_WAIT_L(0); PG8_MMA(1, 0, At, B0); PG8_BAR; PG8_SCHED;
            PG8_STAGE(PG8_SB(0, 1), b2 + hstep, voffB);
            PG8_WAIT_V(6); PG8_BAR; PG8_MMA(1, 1, At, B1); PG8_BAR;
            PG8_LDB(B0, 1, 0); PG8_SCHED; PG8_LDA(At, 1, 0); PG8_STAGE(PG8_SA(0, 1), a2 + hstep, voffA);
            PG8_WAIT_L(8); PG8_BAR; PG8_WAIT_L(0); PG8_MMA(0, 0, At, B0); PG8_BAR; PG8_SCHED;
            PG8_LDB(B1, 1, 1); PG8_STAGE(PG8_SB(1, 0), b3, voffB);
            PG8_BAR; PG8_WAIT_L(0); PG8_MMA(0, 1, At, B1); PG8_BAR;
            PG8_LDA(At, 1, 1); PG8_STAGE(PG8_SA(1, 0), a3, voffA);
            PG8_BAR; PG8_WAIT_L(0); PG8_MMA(1, 0, At, B0); PG8_BAR; PG8_SCHED;
            PG8_STAGE(PG8_SB(1, 1), b3 + hstep, voffB);
            PG8_WAIT_V(6); PG8_BAR; PG8_MMA(1, 1, At, B1); PG8_BAR;
        }
        E(acc, cur, wr, wc, fr, fq);
        if (!has_next) break;
#pragma unroll
        for (int a = 0; a < 2; ++a)
#pragma unroll
            for (int b = 0; b < 2; ++b)
#pragma unroll
                for (int m = 0; m < 4; ++m)
#pragma unroll
                    for (int n = 0; n < 2; ++n) acc[a][b][m][n] = (f32x4){0.f, 0.f, 0.f, 0.f};
        cur = nxt; cA = nA; cB = nB; ++ui;
    }
    PG8_WAIT_V(0);
    if (wr == 0) PG8_BAR;
    PG8_BAR;
#undef PG8_SA
#undef PG8_SB
#undef PG8_STAGE
#undef PG8_LDA
#undef PG8_LDB
#undef PG8_MMA
#undef PG8_WAIT_V
#undef PG8_WAIT_L
#undef PG8_BAR
#undef PG8_SCHED
}
}
using pg8::Unit;

#define EPI_LOOP_BEGIN \
    _Pragma("unroll") for (int ai = 0; ai < 2; ++ai) _Pragma("unroll") for (int m = 0; m < 4; ++m) { const int row = u.pm * 256 + ai * 128 + wr * 64 + m * 16 + fr; \
    _Pragma("unroll") for (int bj = 0; bj < 2; ++bj) { const int lc = bj * 128 + wc * 32 + 8 * fq; const f32x4 v0 = acc[ai][bj][m][0], v1 = acc[ai][bj][m][1];
#define EPI_LOOP_END } }

struct EpiZ {
    bf16_t* Z; bf16_t* QKV; bf16_t* KT;
    __device__ __forceinline__ void operator()(const f32x4 (&acc)[2][2][4][2], const Unit& u, int wr, int wc, int fr, int fq) const {
        const int pn = u.pn;
        if (pn >= 4 && pn < 12) {
#pragma unroll
            for (int ai = 0; ai < 2; ++ai)
#pragma unroll
                for (int m = 0; m < 4; ++m) { const int row = u.pm * 256 + ai * 128 + wr * 64 + m * 16 + fr;
                    const f32x4 a0 = acc[ai][0][m][0] * acc[ai][1][m][0], a1 = acc[ai][0][m][1] * acc[ai][1][m][1];
                    u32x4 w; w.x = cvt_pk_bf16(a0[0], a0[1]); w.y = cvt_pk_bf16(a0[2], a0[3]); w.z = cvt_pk_bf16(a1[0], a1[1]); w.w = cvt_pk_bf16(a1[2], a1[3]);
                    *(u32x4*)(Z + (size_t)row * ZC + Z_U + (pn - 4) * 128 + wc * 32 + 8 * fq) = w; }
            return;
        }
        if (pn >= 12 && pn < 24) {
            const int grp = (pn - 12) >> 2, hh = (pn - 12) & 3;
            bf16_t* dst = QKV + (size_t)grp * NTOK * DM;
            EPI_LOOP_BEGIN
                const size_t rr = row < NPROMPT ? (size_t)((row >> 11) * 4 + hh) * SEQ + (row & 2047) : (size_t)HM_SAMPLE0 + (size_t)(((row - NPROMPT) >> 2) * 4 + hh) * 4 + ((row - NPROMPT) & 3);
                u32x4 w; w.x = cvt_pk_bf16(v0[0], v0[1]); w.y = cvt_pk_bf16(v0[2], v0[3]); w.z = cvt_pk_bf16(v1[0], v1[1]); w.w = cvt_pk_bf16(v1[2], v1[3]);
                *(u32x4*)(dst + rr * 256 + lc) = w;
                if (grp == 1 && row < NPROMPT) {
                    bf16_t* kt = KT + ((size_t)(((row >> 11) * 4 + hh) * 256 + lc)) * SEQ + (row & 2047);
                    kt[0 * SEQ] = (bf16_t)(w.x & 0xffff); kt[1 * SEQ] = (bf16_t)(w.x >> 16); kt[2 * SEQ] = (bf16_t)(w.y & 0xffff); kt[3 * SEQ] = (bf16_t)(w.y >> 16);
                    kt[4 * SEQ] = (bf16_t)(w.z & 0xffff); kt[5 * SEQ] = (bf16_t)(w.z >> 16); kt[6 * SEQ] = (bf16_t)(w.w & 0xffff); kt[7 * SEQ] = (bf16_t)(w.w >> 16);
                }
            EPI_LOOP_END
            return;
        }
        const int zc0 = pn < 4 ? pn * 256 : Z_O + (pn - 24) * 256;
        const bool sg = pn >= 24;
        EPI_LOOP_BEGIN
            f32x4 a0 = v0, a1 = v1;
            if (sg) {
#pragma unroll
                for (int j = 0; j < 4; ++j) { a0[j] = sigmoidf_(a0[j]); a1[j] = sigmoidf_(a1[j]); }
            }
            u32x4 w; w.x = cvt_pk_bf16(a0[0], a0[1]); w.y = cvt_pk_bf16(a0[2], a0[3]); w.z = cvt_pk_bf16(a1[0], a1[1]); w.w = cvt_pk_bf16(a1[2], a1[3]);
            *(u32x4*)(Z + (size_t)row * ZC + zc0 + lc) = w;
        EPI_LOOP_END
    }
};
struct EpiGate {
    bf16_t* O; const bf16_t* T; const bf16_t* Z; int gcol; int add;
    __device__ __forceinline__ void operator()(const f32x4 (&acc)[2][2][4][2], const Unit& u, int wr, int wc, int fr, int fq) const {
        EPI_LOOP_BEGIN
            const int col = u.pn * 256 + lc;
            const u32x4 gw = *(const u32x4*)(Z + (size_t)row * ZC + gcol + col);
            f32x4 a0, a1;
            a0[0] = bf_lo(gw.x) * v0[0]; a0[1] = bf_hi(gw.x) * v0[1]; a0[2] = bf_lo(gw.y) * v0[2]; a0[3] = bf_hi(gw.y) * v0[3];
            a1[0] = bf_lo(gw.z) * v1[0]; a1[1] = bf_hi(gw.z) * v1[1]; a1[2] = bf_lo(gw.w) * v1[2]; a1[3] = bf_hi(gw.w) * v1[3];
            if (add) { const u32x4 tw = *(const u32x4*)(T + (size_t)row * DM + col);
                a0[0] += bf_lo(tw.x); a0[1] += bf_hi(tw.x); a0[2] += bf_lo(tw.y); a0[3] += bf_hi(tw.y); a1[0] += bf_lo(tw.z); a1[1] += bf_hi(tw.z); a1[2] += bf_lo(tw.w); a1[3] += bf_hi(tw.w); }
            u32x4 w; w.x = cvt_pk_bf16(a0[0], a0[1]); w.y = cvt_pk_bf16(a0[2], a0[3]); w.z = cvt_pk_bf16(a1[0], a1[1]); w.w = cvt_pk_bf16(a1[2], a1[3]);
            *(u32x4*)(O + (size_t)row * DM + col) = w;
        EPI_LOOP_END
    }
};
struct EpiResX {
    float* R; const float* xp; const float* xs;
    __device__ __forceinline__ void operator()(const f32x4 (&acc)[2][2][4][2], const Unit& u, int wr, int wc, int fr, int fq) const {
        EPI_LOOP_BEGIN
            const int col = u.pn * 256 + lc;
            const float* xr = (row < NPROMPT ? xp + (size_t)row * DM : xs + (size_t)(row - NPROMPT) * DM) + col;
            const f32x4 x0 = *(const f32x4*)xr, x1 = *(const f32x4*)(xr + 4);
            *(f32x4*)(R + (size_t)row * DM + col) = x0 * ALPHA + v0; *(f32x4*)(R + (size_t)row * DM + col + 4) = x1 * ALPHA + v1;
        EPI_LOOP_END
    }
};
struct EpiResB {
    float* R; const bf16_t* X1;
    __device__ __forceinline__ void operator()(const f32x4 (&acc)[2][2][4][2], const Unit& u, int wr, int wc, int fr, int fq) const {
        EPI_LOOP_BEGIN
            const int col = u.pn * 256 + lc;
            const u32x4 xw = *(const u32x4*)(X1 + (size_t)row * DM + col);
            f32x4 a0, a1;
            a0[0] = bf_lo(xw.x) * ALPHA + v0[0]; a0[1] = bf_hi(xw.x) * ALPHA + v0[1]; a0[2] = bf_lo(xw.y) * ALPHA + v0[2]; a0[3] = bf_hi(xw.y) * ALPHA + v0[3];
            a1[0] = bf_lo(xw.z) * ALPHA + v1[0]; a1[1] = bf_hi(xw.z) * ALPHA + v1[1]; a1[2] = bf_lo(xw.w) * ALPHA + v1[2]; a1[3] = bf_hi(xw.w) * ALPHA + v1[3];
            *(f32x4*)(R + (size_t)row * DM + col) = a0; *(f32x4*)(R + (size_t)row * DM + col + 4) = a1;
        EPI_LOOP_END
    }
};
struct EpiHid {
    bf16_t* Hd;
    __device__ __forceinline__ void operator()(const f32x4 (&acc)[2][2][4][2], const Unit& u, int wr, int wc, int fr, int fq) const {
        EPI_LOOP_BEGIN
            const int col = u.pn * 256 + lc;
            f32x4 a0, a1;
#pragma unroll
            for (int j = 0; j < 4; ++j) { const float r0 = fmaxf(v0[j], 0.f), r1 = fmaxf(v1[j], 0.f); a0[j] = r0 * r0; a1[j] = r1 * r1; }
            u32x4 w; w.x = cvt_pk_bf16(a0[0], a0[1]); w.y = cvt_pk_bf16(a0[2], a0[3]); w.z = cvt_pk_bf16(a1[0], a1[1]); w.w = cvt_pk_bf16(a1[2], a1[3]);
            *(u32x4*)(Hd + (size_t)row * DFF + col) = w;
        EPI_LOOP_END
    }
};

__device__ __forceinline__ void transpose_item(const float* W, int ldw, int K, int src0, bf16_t* WT, int dst0, int kb, float scale, LAS float* scr, int lane) {
    const int k0 = kb * 64;
#pragma unroll 8
    for (int i = 0; i < 32; ++i) { const int kk = 2 * i + (lane >> 5); scr[kk * 33 + (lane & 31)] = W[(size_t)(k0 + kk) * ldw + src0 + (lane & 31)]; }
    LDS_WAIT();
    const int c = lane & 7;
#pragma unroll
    for (int j = 0; j < 4; ++j) { const int n = (lane >> 3) + 8 * j; const LAS float* s = scr + (8 * c) * 33 + n;
        u32x4 o; o.x = cvt_pk_bf16(s[0 * 33] * scale, s[1 * 33] * scale); o.y = cvt_pk_bf16(s[2 * 33] * scale, s[3 * 33] * scale);
        o.z = cvt_pk_bf16(s[4 * 33] * scale, s[5 * 33] * scale); o.w = cvt_pk_bf16(s[6 * 33] * scale, s[7 * 33] * scale);
        *(u32x4*)(WT + (size_t)(dst0 + n) * K + k0 + 8 * c) = o; }
    LDS_WAIT();
}
__device__ __forceinline__ void phase0(const Params& p, LAS unsigned char* lds) {
    const int tid = threadIdx.x, wid = tid >> 6, lane = tid & 63;
    const int gw = blockIdx.x * 8 + wid, NGW = gridDim.x * 8;
    LAS float* scr = (LAS float*)(lds + wid * 8704);
    LAS float* wg = (LAS float*)(lds + 73728);
    for (int e = tid; e < 2048; e += 512) { const int k = e >> 1, hf = e & 1; *(LAS f32x4*)(wg + k * 8 + hf * 4) = *(const f32x4*)(p.w_in + (size_t)k * DIN + 7168 + hf * 4); }
    __syncthreads();
    bf16_t* WIN = (bf16_t*)(p.ws + WS_WIN);
    constexpr int I_IN = 72 * 4 * 16, I_SQ = 32 * 16, I_F1 = 128 * 16, I_F2 = 32 * 64;
    constexpr int NITEMS = I_IN + 3 * I_SQ + I_F1 + I_F2;
    for (int it = gw; it < NITEMS; it += NGW) {
        int r = it;
        if (r < I_IN) { const int kb = r & 15, nb = r >> 4, g = nb >> 2, sub = nb & 3;
            int src; if (g < 8) src = g * 128; else if (g < 24) { const int pr = (g - 8) >> 1, hf = (g - 8) & 1; src = (hf ? 2048 : 1024) + pr * 128; } else if (g < 56) src = 3072 + (g - 24) * 128; else src = 7176 + (g - 56) * 128;
            const float sc = (g >= 32 && g < 40) ? 0.0625f : 1.0f;
            transpose_item(p.w_in, DIN, DM, src + sub * 32, WIN, g * 128 + sub * 32, kb, sc, scr, lane); continue; }
        r -= I_IN;
        if (r < 3 * I_SQ) { const int w = r / I_SQ, q = r % I_SQ, kb = q & 15, nb = q >> 4;
            const float* W = w == 0 ? p.w_co : (w == 1 ? p.w_mo : p.w_o); bf16_t* WT = (bf16_t*)(p.ws + (w == 0 ? WS_WC : (w == 1 ? WS_WM : WS_WO)));
            transpose_item(W, DM, DM, nb * 32, WT, nb * 32, kb, 1.0f, scr, lane); continue; }
        r -= 3 * I_SQ;
        if (r < I_F1) { const int kb = r & 15, nb = r >> 4; transpose_item(p.w_ff1, DFF, DM, nb * 32, (bf16_t*)(p.ws + WS_W1), nb * 32, kb, 1.0f, scr, lane); continue; }
        r -= I_F1;
        { const int kb = r & 63, nb = r >> 6; transpose_item(p.w_ff2, DM, DFF, nb * 32, (bf16_t*)(p.ws + WS_W2), nb * 32, kb, 1.0f, scr, lane); }
    }
    bf16_t* XB = (bf16_t*)(p.ws + WS_XB); float* G = (float*)(p.ws + WS_G);
    for (int r = gw; r < NTOK; r += NGW) {
        const float* xr = xrow(p, r);
        float g8[8];
#pragma unroll
        for (int j = 0; j < 8; ++j) g8[j] = 0.f;
#pragma unroll
        for (int j = 0; j < 4; ++j) { const int k = j * 256 + lane * 4; const f32x4 v = *(const f32x4*)(xr + k);
            u32x2 w; w.x = cvt_pk_bf16(v[0], v[1]); w.y = cvt_pk_bf16(v[2], v[3]); *(u32x2*)(XB + (size_t)r * DM + k) = w;
#pragma unroll
            for (int e = 0; e < 4; ++e) { const f32x4 wa = *(const LAS f32x4*)(wg + (k + e) * 8), wb = *(const LAS f32x4*)(wg + (k + e) * 8 + 4);
#pragma unroll
                for (int q = 0; q < 4; ++q) { g8[q] += v[e] * wa[q]; g8[4 + q] += v[e] * wb[q]; } } }
#pragma unroll
        for (int j = 0; j < 8; ++j) g8[j] = wave_sum(g8[j]);
        if (lane < 4) { G[(size_t)r * 8 + lane] = g8[0] * (lane == 0) + g8[1] * (lane == 1) + g8[2] * (lane == 2) + g8[3] * (lane == 3) + p.b_gate[lane]; }
        else if (lane < 8) { const float f = g8[4] * (lane == 4) + g8[5] * (lane == 5) + g8[6] * (lane == 6) + g8[7] * (lane == 7) + p.b_gate[lane];
            G[(size_t)r * 8 + lane] = fminf(f, 0.f) - log1pf(__expf(-fabsf(f))); }
    }
    __syncthreads();
}

constexpr int KS_LD = 264, VT_LD = 136;
constexpr int L_KSH = 0, L_CT = 128 * KS_LD * 2, L_VT = L_CT + 48 * KS_LD * 2, L_VW = L_VT + 48 * VT_LD * 2, L_SC = L_VW + 48 * VT_LD * 2;
__device__ __forceinline__ void mlstm_prompt_item(const Params& p, LAS unsigned char* lds, int bh, int vs) {
    const int tid = threadIdx.x, wid = __builtin_amdgcn_readfirstlane(tid >> 6), lane = tid & 63, li = lane & 15, kg = lane >> 4;
    const int b = bh >> 2, h = bh & 3, j0 = vs * 32;
    LAS bf16_t* Ksh = (LAS bf16_t*)(lds + L_KSH); LAS bf16_t* CTsh = (LAS bf16_t*)(lds + L_CT); LAS bf16_t* VTsh = (LAS bf16_t*)(lds + L_VT); LAS bf16_t* VWsh = (LAS bf16_t*)(lds + L_VW);
    LAS float* sA = (LAS float*)(lds + L_SC); LAS float* sG = sA + 128; LAS float* sB = sG + 128;
    const bf16_t* QH = (const bf16_t*)(p.ws + WS_QKV) + (size_t)bh * SEQ * 256; const bf16_t* KH = QH + (size_t)NTOK * DM; const bf16_t* VH = KH + (size_t)NTOK * DM;
    const bf16_t* KT = (const bf16_t*)(p.ws + WS_KT) + (size_t)bh * 256 * SEQ; const float* G = (const float*)(p.ws + WS_G) + (size_t)b * SEQ * 8; bf16_t* H = (bf16_t*)(p.ws + WS_H);
    for (int e = tid; e < 48 * KS_LD / 2; e += 512) ((LAS unsigned*)CTsh)[e] = 0u;
    for (int e = tid; e < 16 * VT_LD; e += 512) { const int rr = e / VT_LD; VTsh[32 * VT_LD + e] = rr == 0 ? (bf16_t)0x3F80 : (bf16_t)0; VWsh[32 * VT_LD + e] = 0; }
    f32x4 Cacc[2][3];
#pragma unroll
    for (int db = 0; db < 2; ++db)
#pragma unroll
        for (int jb = 0; jb < 3; ++jb) Cacc[db][jb] = (f32x4){0.f, 0.f, 0.f, 0.f};
    float m_prev = 0.f;
    const int vs_s = tid >> 2, vs_q = tid & 3;
    u32x4 kp[8]; u32x4 vp; bf16x8 qf[8]; float gi0 = 0.f, gf0 = 0.f, gi1 = 0.f, gf1 = 0.f;
#pragma unroll
    for (int i = 0; i < 8; ++i) kp[i] = *(const u32x4*)(KH + (size_t)(i * 512 + tid) * 8);
    vp = *(const u32x4*)(VH + (size_t)vs_s * 256 + j0 + vs_q * 8);
#pragma unroll
    for (int kk = 0; kk < 8; ++kk) qf[kk] = *(const bf16x8*)(QH + (size_t)(16 * wid + li) * 256 + kk * 32 + kg * 8);
    if (wid == 0) { gi0 = G[(size_t)lane * 8 + h]; gf0 = G[(size_t)lane * 8 + 4 + h]; gi1 = G[(size_t)(64 + lane) * 8 + h]; gf1 = G[(size_t)(64 + lane) * 8 + 4 + h]; }
    for (int c = 0; c < 16; ++c) {
        const int t0 = c * 128, tn = (c < 15 ? c + 1 : c) * 128;
        if (wid == 0) {
            float b0 = gf0, b1 = gf1;
#pragma unroll
            for (int o = 1; o < 64; o <<= 1) { const float x0 = __shfl_up(b0, o), x1 = __shfl_up(b1, o); if (lane >= o) { b0 += x0; b1 += x1; } }
            b1 += __shfl(b0, 63);
            const float a0 = gi0 - b0, a1 = gi1 - b1;
            float p0 = a0, p1 = a1;
#pragma unroll
            for (int o = 1; o < 64; o <<= 1) { const float x0 = __shfl_up(p0, o), x1 = __shfl_up(p1, o); if (lane >= o) { p0 = fmaxf(p0, x0); p1 = fmaxf(p1, x1); } }
            p1 = fmaxf(p1, __shfl(p0, 63));
            sA[lane] = a0; sA[64 + lane] = a1; sG[lane] = fmaxf(m_prev, p0); sG[64 + lane] = fmaxf(m_prev, p1); sB[lane] = b0; sB[64 + lane] = b1;
            gi0 = G[(size_t)(tn + lane) * 8 + h]; gf0 = G[(size_t)(tn + lane) * 8 + 4 + h]; gi1 = G[(size_t)(tn + 64 + lane) * 8 + h]; gf1 = G[(size_t)(tn + 64 + lane) * 8 + 4 + h];
        }
        __syncthreads();
        const float g_last = sG[127], b_last = sB[127];
#pragma unroll
        for (int i = 0; i < 8; ++i) { const int pc = i * 512 + tid, row = pc >> 5, c8 = pc & 31; *(LAS u32x4*)(Ksh + row * KS_LD + c8 * 8) = kp[i]; }
        {
            const float wsv = __expf(sA[vs_s] - g_last);
            const unsigned vw[4] = {vp.x, vp.y, vp.z, vp.w};
#pragma unroll
            for (int e = 0; e < 4; ++e) { const int j = vs_q * 8 + 2 * e; const float lo = bf_lo(vw[e]), hi = bf_hi(vw[e]);
                VTsh[j * VT_LD + vs_s] = (bf16_t)(vw[e] & 0xffff); VTsh[(j + 1) * VT_LD + vs_s] = (bf16_t)(vw[e] >> 16);
                const unsigned sw = cvt_pk_bf16(lo * wsv, hi * wsv);
                VWsh[j * VT_LD + vs_s] = (bf16_t)(sw & 0xffff); VWsh[(j + 1) * VT_LD + vs_s] = (bf16_t)(sw >> 16); }
            if (vs_q == 0) VWsh[32 * VT_LD + vs_s] = (bf16_t)(cvt_pk_bf16(wsv, 0.f) & 0xffff);
        }
#pragma unroll
        for (int i = 0; i < 8; ++i) kp[i] = *(const u32x4*)(KH + (size_t)tn * 256 + (size_t)(i * 512 + tid) * 8);
        vp = *(const u32x4*)(VH + (size_t)(tn + vs_s) * 256 + j0 + vs_q * 8);
        __syncthreads();
        bf16x8 ktf[2][4];
#pragma unroll
        for (int db = 0; db < 2; ++db)
#pragma unroll
            for (int k2 = 0; k2 < 4; ++k2) ktf[db][k2] = *(const bf16x8*)(KT + (size_t)((2 * wid + db) * 16 + li) * SEQ + t0 + k2 * 32 + kg * 8);
        {
            const int t_loc = 16 * wid + li;
            const float g_t = sG[t_loc], b_t = sB[t_loc];
            f32x4 ST[8];
#pragma unroll
            for (int sb = 0; sb < 8; ++sb) { ST[sb] = (f32x4){0.f, 0.f, 0.f, 0.f};
                if (sb <= wid) {
#pragma unroll
                    for (int kk = 0; kk < 8; ++kk) { const bf16x8 kf = *(const LAS bf16x8*)(Ksh + (sb * 16 + li) * KS_LD + kk * 32 + kg * 8);
                        ST[sb] = __builtin_amdgcn_mfma_f32_16x16x32_bf16(kf, qf[kk], ST[sb], 0, 0, 0); }
                    const f32x4 av = *(const LAS f32x4*)(sA + sb * 16 + kg * 4);
#pragma unroll
                    for (int r = 0; r < 4; ++r) { const float wgt = __expf(av[r] - g_t); const bool ok = (sb < wid) || (kg * 4 + r <= li); ST[sb][r] = ok ? ST[sb][r] * wgt : 0.f; }
                } }
            f32x4 nt[3], it[3];
#pragma unroll
            for (int jb = 0; jb < 3; ++jb) { nt[jb] = (f32x4){0.f, 0.f, 0.f, 0.f}; it[jb] = (f32x4){0.f, 0.f, 0.f, 0.f}; }
#pragma unroll
            for (int k2 = 0; k2 < 4; ++k2) if (2 * k2 <= wid) {
                u32x4 pw; pw.x = cvt_pk_bf16(ST[2 * k2][0], ST[2 * k2][1]); pw.y = cvt_pk_bf16(ST[2 * k2][2], ST[2 * k2][3]);
                pw.z = cvt_pk_bf16(ST[2 * k2 + 1][0], ST[2 * k2 + 1][1]); pw.w = cvt_pk_bf16(ST[2 * k2 + 1][2], ST[2 * k2 + 1][3]);
                bf16x8 pf; __builtin_memcpy(&pf, &pw, 16);
#pragma unroll
                for (int jb = 0; jb < 3; ++jb) { const LAS bf16_t* vr = VTsh + (jb * 16 + li) * VT_LD + k2 * 32 + kg * 4;
                    u32x4 vw4; const u32x2 lo = *(const LAS u32x2*)vr, hi = *(const LAS u32x2*)(vr + 16); vw4.x = lo.x; vw4.y = lo.y; vw4.z = hi.x; vw4.w = hi.y;
                    bf16x8 vf; __builtin_memcpy(&vf, &vw4, 16);
                    nt[jb] = __builtin_amdgcn_mfma_f32_16x16x32_bf16(vf, pf, nt[jb], 0, 0, 0); } }
#pragma unroll
            for (int kk = 0; kk < 8; ++kk)
#pragma unroll
                for (int jb = 0; jb < 3; ++jb) { const bf16x8 cf = *(const LAS bf16x8*)(CTsh + (jb * 16 + li) * KS_LD + kk * 32 + kg * 8);
                    it[jb] = __builtin_amdgcn_mfma_f32_16x16x32_bf16(cf, qf[kk], it[jb], 0, 0, 0); }
#pragma unroll
            for (int kk = 0; kk < 8; ++kk) qf[kk] = *(const bf16x8*)(QH + (size_t)(tn + 16 * wid + li) * 256 + kk * 32 + kg * 8);
            const float w_int = __expf(m_prev - g_t);
#pragma unroll
            for (int jb = 0; jb < 3; ++jb) nt[jb] = nt[jb] + it[jb] * w_int;
            const float den = __shfl(nt[2][0], li);
            const float rden = 1.0f / fmaxf(fabsf(den), __expf(-(b_t + g_t)));
#pragma unroll
            for (int jb = 0; jb < 2; ++jb) { u32x2 w; w.x = cvt_pk_bf16(nt[jb][0] * rden, nt[jb][1] * rden); w.y = cvt_pk_bf16(nt[jb][2] * rden, nt[jb][3] * rden);
                *(u32x2*)(H + (size_t)(b * SEQ + t0 + t_loc) * DM + h * 256 + j0 + jb * 16 + kg * 4) = w; }
        }
        __syncthreads();
        {
            const float decay = __expf(m_prev - g_last);
#pragma unroll
            for (int db = 0; db < 2; ++db)
#pragma unroll
                for (int jb = 0; jb < 3; ++jb) Cacc[db][jb] = Cacc[db][jb] * decay;
#pragma unroll
            for (int k2 = 0; k2 < 4; ++k2)
#pragma unroll
                for (int jb = 0; jb < 3; ++jb) { const bf16x8 vf = *(const LAS bf16x8*)(VWsh + (jb * 16 + li) * VT_LD + k2 * 32 + kg * 8);
#pragma unroll
                    for (int db = 0; db < 2; ++db) Cacc[db][jb] = __builtin_amdgcn_mfma_f32_16x16x32_bf16(ktf[db][k2], vf, Cacc[db][jb], 0, 0, 0); }
#pragma unroll
            for (int db = 0; db < 2; ++db)
#pragma unroll
                for (int jb = 0; jb < 3; ++jb) { u32x2 w; w.x = cvt_pk_bf16(Cacc[db][jb][0], Cacc[db][jb][1]); w.y = cvt_pk_bf16(Cacc[db][jb][2], Cacc[db][jb][3]);
                    *(LAS u32x2*)(CTsh + (jb * 16 + li) * KS_LD + (2 * wid + db) * 16 + kg * 4) = w; }
            m_prev = b_last + g_last;
        }
    }
#pragma unroll
    for (int db = 0; db < 2; ++db) { const int d0 = (2 * wid + db) * 16 + kg * 4;
#pragma unroll
        for (int jb = 0; jb < 2; ++jb)
#pragma unroll
            for (int r = 0; r < 4; ++r) p.out[O_CP + ((size_t)(bh * 256 + d0 + r)) * 256 + j0 + jb * 16 + li] = Cacc[db][jb][r];
        if (vs == 0 && li == 0) {
#pragma unroll
            for (int r = 0; r < 4; ++r) p.out[O_NP + (size_t)bh * 256 + d0 + r] = Cacc[db][2][r]; } }
    if (vs == 0 && tid == 0) p.out[O_MP + bh] = m_prev;
    __syncthreads();
}

__device__ __forceinline__ void mlstm_sample_item(const Params& p, LAS unsigned char* lds, int item) {
    const int tid = threadIdx.x, bs = item >> 2, h = item & 3, tok0 = NPROMPT + bs * 4;
    LAS float* sq = (LAS float*)lds; LAS float* sk = sq + 1024; LAS float* sv = sk + 1024; LAS float* sn0 = sv + 1024; LAS float* sdot = sn0 + 256; LAS float* sc = sdot + 32; LAS float* sred = sc + 64;
    const bf16_t* QS = (const bf16_t*)(p.ws + WS_QKV) + ((size_t)HM_SAMPLE0 + (size_t)item * 4) * 256;
    const float* G = (const float*)(p.ws + WS_G); bf16_t* H = (bf16_t*)(p.ws + WS_H);
    const int c4 = tid & 63, rw = tid >> 6, col = c4 * 4;
    const float* C0 = p.sC + (size_t)item * 65536 + (size_t)(rw * 32) * 256 + col; float* C1 = p.out + O_CS + (size_t)item * 65536 + (size_t)(rw * 32) * 256 + col;
    f32x4 cv[8];
#pragma unroll
    for (int j = 0; j < 8; ++j) cv[j] = __builtin_nontemporal_load((const f32x4*)(C0 + j * 256));
    for (int e = tid; e < 3072; e += 512) { const int which = e >> 10, idx = e & 1023; sq[e] = bf2f(QS[(size_t)which * NTOK * DM + idx]); }
    if (tid < 256) sn0[tid] = p.sn[(size_t)item * 256 + tid];
    __syncthreads();
    {
        const int id = tid >> 4, part = tid & 15;
        if (id < 20) { const LAS float* va = id < 16 ? sq + (id >> 2) * 256 : sq + (id - 16) * 256; const LAS float* vb = id < 16 ? sk + (id & 3) * 256 : sn0;
            float s = 0.f;
#pragma unroll
            for (int e = 0; e < 16; ++e) s += va[part * 16 + e] * vb[part * 16 + e];
            s += __shfl_xor(s, 8); s += __shfl_xor(s, 4); s += __shfl_xor(s, 2); s += __shfl_xor(s, 1);
            if (part == 0) sdot[id] = s; }
    }
    __syncthreads();
    if (tid == 0) {
        const float m0 = p.sm[item];
        float li_[4], lf_[4], bb[4], aa[4], gg[4];
#pragma unroll
        for (int s = 0; s < 4; ++s) { li_[s] = G[(size_t)(tok0 + s) * 8 + h]; lf_[s] = G[(size_t)(tok0 + s) * 8 + 4 + h]; }
        float cum = 0.f, pm = m0;
#pragma unroll
        for (int s = 0; s < 4; ++s) { cum += lf_[s]; bb[s] = cum; aa[s] = li_[s] - cum; pm = fmaxf(pm, aa[s]); gg[s] = pm; }
#pragma unroll
        for (int t = 0; t < 4; ++t) { const float wi = __expf(m0 - gg[t]); float den = wi * sdot[16 + t];
#pragma unroll
            for (int s = 0; s < 4; ++s) { const float S = s <= t ? sdot[t * 4 + s] * __expf(aa[s] - gg[t]) : 0.f; sc[16 + t * 4 + s] = S; den += S; }
            sc[t] = wi; sc[12 + t] = 1.0f / fmaxf(fabsf(den), __expf(-(bb[t] + gg[t]))); }
#pragma unroll
        for (int s = 0; s < 4; ++s) sc[4 + s] = __expf(aa[s] - gg[3]);
        sc[8] = __expf(m0 - gg[3]); sc[9] = bb[3] + gg[3];
    }
    __syncthreads();
    const float decay = sc[8]; const float ws0 = sc[4], ws1 = sc[5], ws2 = sc[6], ws3 = sc[7];
    const f32x4 v0 = *(const LAS f32x4*)(sv + col), v1 = *(const LAS f32x4*)(sv + 256 + col), v2 = *(const LAS f32x4*)(sv + 512 + col), v3 = *(const LAS f32x4*)(sv + 768 + col);
    f32x4 a0 = {0.f, 0.f, 0.f, 0.f}, a1 = a0, a2 = a0, a3 = a0;
#pragma unroll
    for (int rb = 0; rb < 4; ++rb) {
        f32x4 cn[8];
        if (rb < 3) {
#pragma unroll
            for (int j = 0; j < 8; ++j) cn[j] = __builtin_nontemporal_load((const f32x4*)(C0 + ((rb + 1) * 8 + j) * 256));
        }
#pragma unroll
        for (int j = 0; j < 8; ++j) { const int d = rw * 32 + rb * 8 + j; const f32x4 x = cv[j];
            a0 += x * sq[d]; a1 += x * sq[256 + d]; a2 += x * sq[512 + d]; a3 += x * sq[768 + d];
            const f32x4 y = x * decay + v0 * (ws0 * sk[d]) + v1 * (ws1 * sk[256 + d]) + v2 * (ws2 * sk[512 + d]) + v3 * (ws3 * sk[768 + d]);
            __builtin_nontemporal_store(y, (f32x4*)(C1 + (rb * 8 + j) * 256)); }
        if (rb < 3) {
#pragma unroll
            for (int j = 0; j < 8; ++j) cv[j] = cn[j];
        }
    }
    *(LAS f32x4*)(sred + (rw * 4 + 0) * 256 + col) = a0; *(LAS f32x4*)(sred + (rw * 4 + 1) * 256 + col) = a1; *(LAS f32x4*)(sred + (rw * 4 + 2) * 256 + col) = a2; *(LAS f32x4*)(sred + (rw * 4 + 3) * 256 + col) = a3;
    __syncthreads();
#pragma unroll
    for (int e = 0; e < 2; ++e) { const int o = tid + 512 * e, t = o >> 8, cx = o & 255;
        float inter = 0.f;
#pragma unroll
        for (int w = 0; w < 8; ++w) inter += sred[(w * 4 + t) * 256 + cx];
        float num = sc[t] * inter;
#pragma unroll
        for (int s = 0; s < 4; ++s) num += sc[16 + t * 4 + s] * sv[s * 256 + cx];
        H[(size_t)(tok0 + t) * DM + h * 256 + cx] = (bf16_t)(cvt_pk_bf16(num * sc[12 + t], 0.f) & 0xffff); }
    if (tid < 256) p.out[O_NS + (size_t)item * 256 + tid] = decay * sn0[tid] + ws0 * sk[tid] + ws1 * sk[256 + tid] + ws2 * sk[512 + tid] + ws3 * sk[768 + tid];
    if (tid == 0) p.out[O_MS + item] = sc[9];
    __syncthreads();
}

__device__ __forceinline__ void conv_unit(const Params& p, const bf16_t* Z, bf16_t* AC, int r, int ch, const float (&cw)[24], u32x4 uw, u32x4 bw, u32x4 w1, u32x4 w2) {
    float u0[8], u1[8], u2[8], bg[8];
    const unsigned uu[4] = {uw.x, uw.y, uw.z, uw.w}, bb[4] = {bw.x, bw.y, bw.z, bw.w}, q1[4] = {w1.x, w1.y, w1.z, w1.w}, q2[4] = {w2.x, w2.y, w2.z, w2.w};
#pragma unroll
    for (int e = 0; e < 4; ++e) { u2[2 * e] = bf_lo(uu[e]); u2[2 * e + 1] = bf_hi(uu[e]); bg[2 * e] = bf_lo(bb[e]); bg[2 * e + 1] = bf_hi(bb[e]);
        u1[2 * e] = bf_lo(q1[e]); u1[2 * e + 1] = bf_hi(q1[e]); u0[2 * e] = bf_lo(q2[e]); u0[2 * e + 1] = bf_hi(q2[e]); }
    const bool prompt = r < NPROMPT; const int t = prompt ? (r & 2047) : ((r - NPROMPT) & 3); const int bs = (r - NPROMPT) >> 2;
    if (t < 1) { if (prompt) {
#pragma unroll
            for (int e = 0; e < 8; ++e) u1[e] = 0.f; }
        else { const float* sp = p.sconv + ((size_t)bs * 2 + 1) * DM + ch;
#pragma unroll
            for (int e = 0; e < 8; ++e) u1[e] = sp[e]; } }
    if (t < 2) { if (prompt) {
#pragma unroll
            for (int e = 0; e < 8; ++e) u0[e] = 0.f; }
        else { const float* sp = p.sconv + ((size_t)bs * 2 + t) * DM + ch;
#pragma unroll
            for (int e = 0; e < 8; ++e) u0[e] = sp[e]; } }
    float o[8];
#pragma unroll
    for (int e = 0; e < 8; ++e) o[e] = bg[e] * (cw[e] * u0[e] + cw[8 + e] * u1[e] + cw[16 + e] * u2[e]);
    u32x4 w; w.x = cvt_pk_bf16(o[0], o[1]); w.y = cvt_pk_bf16(o[2], o[3]); w.z = cvt_pk_bf16(o[4], o[5]); w.w = cvt_pk_bf16(o[6], o[7]);
    *(u32x4*)(AC + (size_t)r * DM + ch) = w;
    float* so = nullptr;
    if (prompt) { if (t >= SEQ - 2) so = p.out + O_CONVP + ((size_t)(r >> 11) * 2 + (t - (SEQ - 2))) * DM + ch; }
    else if (t >= 2) so = p.out + O_CONVS + ((size_t)bs * 2 + (t - 2)) * DM + ch;
    if (so) {
#pragma unroll
        for (int e = 0; e < 8; ++e) so[e] = u2[e]; }
}
__device__ __forceinline__ void conv_items(const Params& p) {
    const bf16_t* Z = (const bf16_t*)(p.ws + WS_Z); bf16_t* AC = (bf16_t*)(p.ws + WS_AC);
    const int gt = blockIdx.x * 512 + threadIdx.x, NG = gridDim.x * 512;
    const int ch = (gt & 127) * 8, r0 = gt >> 7, rstep = NG >> 7;
    float cw[24];
#pragma unroll
    for (int e = 0; e < 8; ++e) { cw[e] = p.conv_w[ch + e]; cw[8 + e] = p.conv_w[DM + ch + e]; cw[16 + e] = p.conv_w[2 * DM + ch + e]; }
    for (int rb = r0; rb < NTOK; rb += 4 * rstep) {
        u32x4 uw[4], bw[4], w1[4], w2[4];
#pragma unroll
        for (int j = 0; j < 4; ++j) { const int r = rb + j * rstep; if (r < NTOK) { const int r1 = r >= 1 ? r - 1 : r, r2 = r >= 2 ? r - 2 : r;
            uw[j] = *(const u32x4*)(Z + (size_t)r * ZC + Z_U + ch); bw[j] = *(const u32x4*)(Z + (size_t)r * ZC + Z_BG + ch);
            w1[j] = *(const u32x4*)(Z + (size_t)r1 * ZC + Z_U + ch); w2[j] = *(const u32x4*)(Z + (size_t)r2 * ZC + Z_U + ch); } }
#pragma unroll
        for (int j = 0; j < 4; ++j) { const int r = rb + j * rstep; if (r < NTOK) conv_unit(p, Z, AC, r, ch, cw, uw[j], bw[j], w1[j], w2[j]); }
    }
}

__device__ __forceinline__ void hn_items(const Params& p) {
    const bf16_t* Z = (const bf16_t*)(p.ws + WS_Z); const bf16_t* H = (const bf16_t*)(p.ws + WS_H); bf16_t* HN = (bf16_t*)(p.ws + WS_HN);
    const int lane = threadIdx.x & 63, gw = blockIdx.x * 8 + (threadIdx.x >> 6), NGW = gridDim.x * 8, c0 = lane * 16;
    f32x4 mg[4];
#pragma unroll
    for (int j = 0; j < 4; ++j) mg[j] = *(const f32x4*)(p.mh_g + c0 + 4 * j);
    for (int r = gw; r < NTOK; r += NGW) {
        const u32x4 h0 = *(const u32x4*)(H + (size_t)r * DM + c0), h1 = *(const u32x4*)(H + (size_t)r * DM + c0 + 8);
        const u32x4 o0 = *(const u32x4*)(Z + (size_t)r * ZC + Z_O + c0), o1 = *(const u32x4*)(Z + (size_t)r * ZC + Z_O + c0 + 8);
        const unsigned hw[8] = {h0.x, h0.y, h0.z, h0.w, h1.x, h1.y, h1.z, h1.w}, ow[8] = {o0.x, o0.y, o0.z, o0.w, o1.x, o1.y, o1.z, o1.w};
        float v[16]; float s = 0.f;
#pragma unroll
        for (int e = 0; e < 8; ++e) { v[2 * e] = bf_lo(hw[e]); v[2 * e + 1] = bf_hi(hw[e]); s += v[2 * e] + v[2 * e + 1]; }
        s += __shfl_xor(s, 1); s += __shfl_xor(s, 2); s += __shfl_xor(s, 4); s += __shfl_xor(s, 8);
        const float mean = s * (1.0f / 256.0f); float q = 0.f;
#pragma unroll
        for (int e = 0; e < 16; ++e) { v[e] -= mean; q += v[e] * v[e]; }
        q += __shfl_xor(q, 1); q += __shfl_xor(q, 2); q += __shfl_xor(q, 4); q += __shfl_xor(q, 8);
        const float rstd = 1.0f / sqrtf(q * (1.0f / 256.0f) + LN_EPS);
        unsigned ww[8];
#pragma unroll
        for (int e = 0; e < 8; ++e) { const float g0 = mg[(2 * e) >> 2][(2 * e) & 3], g1 = mg[(2 * e + 1) >> 2][(2 * e + 1) & 3];
            ww[e] = cvt_pk_bf16(v[2 * e] * rstd * g0 * bf_lo(ow[e]), v[2 * e + 1] * rstd * g1 * bf_hi(ow[e])); }
        u32x4 w0, w1; w0.x = ww[0]; w0.y = ww[1]; w0.z = ww[2]; w0.w = ww[3]; w1.x = ww[4]; w1.y = ww[5]; w1.z = ww[6]; w1.w = ww[7];
        *(u32x4*)(HN + (size_t)r * DM + c0) = w0; *(u32x4*)(HN + (size_t)r * DM + c0 + 8) = w1;
    }
}

template <bool OUT_F32>
__device__ __forceinline__ void ln_rows(const float* R, const float* gam, const float* bet, void* out) {
    const int lane = threadIdx.x & 63, gw = blockIdx.x * 8 + (threadIdx.x >> 6), NGW = gridDim.x * 8;
    f32x4 gv[4], bv[4];
#pragma unroll
    for (int j = 0; j < 4; ++j) { gv[j] = *(const f32x4*)(gam + j * 256 + lane * 4); bv[j] = *(const f32x4*)(bet + j * 256 + lane * 4); }
    for (int r = gw; r < NTOK; r += NGW) {
        f32x4 v[4]; float s = 0.f;
#pragma unroll
        for (int j = 0; j < 4; ++j) { v[j] = *(const f32x4*)(R + (size_t)r * DM + j * 256 + lane * 4); s += (v[j][0] + v[j][1]) + (v[j][2] + v[j][3]); }
        const float mean = wave_sum(s) * (1.0f / DM); float q = 0.f;
#pragma unroll
        for (int j = 0; j < 4; ++j) { v[j] = v[j] - mean; q += (v[j][0] * v[j][0] + v[j][1] * v[j][1]) + (v[j][2] * v[j][2] + v[j][3] * v[j][3]); }
        const float rstd = 1.0f / sqrtf(wave_sum(q) * (1.0f / DM) + LN_EPS);
#pragma unroll
        for (int j = 0; j < 4; ++j) { const f32x4 y = v[j] * rstd * gv[j] + bv[j];
            if (OUT_F32) *(f32x4*)((float*)out + (size_t)r * DM + j * 256 + lane * 4) = y;
            else { u32x2 w; w.x = cvt_pk_bf16(y[0], y[1]); w.y = cvt_pk_bf16(y[2], y[3]); *(u32x2*)((bf16_t*)out + (size_t)r * DM + j * 256 + lane * 4) = w; } }
    }
}

__global__ void __launch_bounds__(512, 2) mega(Params p) {
    extern __shared__ __attribute__((aligned(16))) unsigned char shm_raw[];
    LAS unsigned char* lds = (LAS unsigned char*)shm_raw;
    const int G = gridDim.x, c = blockIdx.x;
    unsigned char* ws = p.ws;
    volatile LAS unsigned* xst = (volatile LAS unsigned*)(lds + 131072);
    if (threadIdx.x == 0) { xst[0] = 0u; xst[1] = 0u; }
    __syncthreads();
    const XcdBarrier xb = xcd_barrier_post((unsigned*)(ws + WS_BAR), xst);
    if (p.ph_hi > 64) cg::this_grid().sync();
#if MK_MULTI
#define PH_SYNC(k)
#else
#define PH_SYNC(k) do { if (p.ph_lo <= (k) && (k) + 1 < p.ph_hi) xcd_barrier(xb); } while (0)
#endif
#define PH_ON(k) (((PHMASK >> (k)) & 1) && p.ph_lo <= (k) && (k) < p.ph_hi)
#ifndef REPMASK
#define REPMASK 0
#endif
    if (PH_ON(0)) phase0(p, lds);
    PH_SYNC(0);
    if (PH_ON(1)) { pg8::StaticOrder S; S.init(NTOK, NZ, G, c); pg8::Gemm g{(const bf16_t*)(ws + WS_XB), (const bf16_t*)(ws + WS_WIN), NTOK, NZ, DM};
        EpiZ E{(bf16_t*)(ws + WS_Z), (bf16_t*)(ws + WS_QKV), (bf16_t*)(ws + WS_KT)}; pg8::gemm_phase(lds, g, S, E); }
    PH_SYNC(1);
    if (PH_ON(2)) {
        for (int it = c; it < 256; it += G) { const int xcd = it & 7, idx = it >> 3; mlstm_prompt_item(p, lds, xcd * 4 + (idx >> 3), idx & 7); }
        for (int it = c; it < 512; it += G) mlstm_sample_item(p, lds, it);
        conv_items(p);
    }
    PH_SYNC(2);
    if (PH_ON(3)) { hn_items(p);
        pg8::StaticOrder S; S.init(NTOK, DM, G, c); pg8::Gemm g{(const bf16_t*)(ws + WS_AC), (const bf16_t*)(ws + WS_WC), NTOK, DM, DM};
        EpiGate E{(bf16_t*)(ws + WS_XB), nullptr, (const bf16_t*)(ws + WS_Z), Z_GC, 0}; pg8::gemm_phase(lds, g, S, E); }
    PH_SYNC(3);
    if (PH_ON(4)) { pg8::StaticOrder S; S.init(NTOK, DM, G, c); pg8::Gemm g{(const bf16_t*)(ws + WS_HN), (const bf16_t*)(ws + WS_WM), NTOK, DM, DM};
        EpiGate E{(bf16_t*)(ws + WS_AC), (const bf16_t*)(ws + WS_XB), (const bf16_t*)(ws + WS_Z), Z_GM, 1}; pg8::gemm_phase(lds, g, S, E); }
    PH_SYNC(4);
    if (PH_ON(5)) { pg8::StaticOrder S; S.init(NTOK, DM, G, c); pg8::Gemm g{(const bf16_t*)(ws + WS_AC), (const bf16_t*)(ws + WS_WO), NTOK, DM, DM};
        EpiResX E{(float*)(ws + WS_R), p.xp, p.xs}; pg8::gemm_phase(lds, g, S, E); }
    PH_SYNC(5);
    if (PH_ON(6)) ln_rows<false>((const float*)(ws + WS_R), p.ln1g, p.ln1b, ws + WS_H);
    PH_SYNC(6);
    if (PH_ON(7)) { pg8::StaticOrder S; S.init(NTOK, DFF, G, c); pg8::Gemm g{(const bf16_t*)(ws + WS_H), (const bf16_t*)(ws + WS_W1), NTOK, DFF, DM};
        EpiHid E{(bf16_t*)(ws + WS_HID)}; pg8::gemm_phase(lds, g, S, E); }
    PH_SYNC(7);
    if (PH_ON(8)) { pg8::StaticOrder S; S.init(NTOK, DM, G, c); pg8::Gemm g{(const bf16_t*)(ws + WS_HID), (const bf16_t*)(ws + WS_W2), NTOK, DM, DFF};
        EpiResB E{(float*)(ws + WS_R), (const bf16_t*)(ws + WS_H)}; pg8::gemm_phase(lds, g, S, E); }
    PH_SYNC(8);
    if (PH_ON(9)) ln_rows<true>((const float*)(ws + WS_R), p.ln2g, p.ln2b, p.out + O_Y);
#if MK_MULTI
    if (p.ph_lo == 11) { for (int it = c; it < 512; it += G) mlstm_sample_item(p, lds, it); }
    if (p.ph_lo == 12) conv_items(p);
#endif
}

extern "C" void kernel_launch(void* const* d_in, const int* in_sizes, int n_in, void* d_out, int out_size, void* d_ws, size_t ws_size, hipStream_t stream) {
    static int grid = 0;
    if (grid == 0) {
        if (n_in != 19 || ws_size < WS_END) { fprintf(stderr, "kernel_launch: unexpected inputs (n_in %d, ws %zu, need %zu)\n", n_in, ws_size, (size_t)WS_END); grid = -1; return; }
        int dev = 0, cus = 0, per_cu = 0;
        hipGetDevice(&dev); hipDeviceGetAttribute(&cus, hipDeviceAttributeMultiprocessorCount, dev);
        hipFuncSetAttribute((const void*)mega, hipFuncAttributeMaxDynamicSharedMemorySize, LDS_BYTES);
        hipOccupancyMaxActiveBlocksPerMultiprocessor(&per_cu, (const void*)mega, 512, LDS_BYTES);
        if (per_cu < 1 || cus < 1) { fprintf(stderr, "kernel_launch: occupancy query says %d blocks/CU on %d CUs\n", per_cu, cus); grid = -1; return; }
        grid = cus;
    }
    if (grid < 0) return;
    Params p{};
    const float** f = (const float**)&p;
    for (int i = 0; i < 19; ++i) f[i] = (const float*)d_in[i];
    p.out = (float*)d_out; p.ws = (unsigned char*)d_ws;
#if MK_MULTI
    for (int ph = 0; ph < 10; ++ph) for (int rep = 0; rep < ((REPMASK >> ph) & 1) + 1; ++rep) { p.ph_lo = ph; p.ph_hi = ph + 1; hipLaunchKernelGGL(mega, dim3(grid), dim3(512), LDS_BYTES, stream, p); }
#ifdef EXTRA_PH
    { p.ph_lo = EXTRA_PH; p.ph_hi = EXTRA_PH + 1; hipLaunchKernelGGL(mega, dim3(grid), dim3(512), LDS_BYTES, stream, p); }
#endif
#else
    p.ph_lo = 0; p.ph_hi = 10;
    if (hipMemsetAsync((char*)d_ws + WS_BAR, 0, 16384, stream) != hipSuccess) { fprintf(stderr, "memset failed\n"); return; }
    void* args[] = {&p};
    hipError_t e = hipLaunchCooperativeKernel((const void*)mega, dim3(grid), dim3(512), args, LDS_BYTES, stream);
    if (e != hipSuccess) fprintf(stderr, "cooperative launch failed: %s (grid %d)\n", hipGetErrorString(e), grid);
#endif
}
```

```cpp
#include <hip/hip_runtime.h>
#include <hip/hip_cooperative_groups.h>
#include <cstdio>
namespace cg = cooperative_groups;

#ifndef PHMASK
#define PHMASK 1023
#endif
#ifndef MK_MULTI
#define MK_MULTI 0
#endif

#define LAS __attribute__((address_space(3)))
typedef unsigned short bf16_t;
typedef short bf16x8 __attribute__((ext_vector_type(8)));
typedef float f32x4 __attribute__((ext_vector_type(4)));
typedef float f32x2 __attribute__((ext_vector_type(2)));
typedef unsigned u32x4 __attribute__((ext_vector_type(4)));
typedef unsigned u32x2 __attribute__((ext_vector_type(2)));

constexpr int DM = 1024, NPROMPT = 8 * 2048, NSAMPLE = 128 * 4, NTOK = NPROMPT + NSAMPLE;
constexpr int SEQ = 2048, NH = 4, DH = 256, DFF = 4096, DIN = 9224, NZ = 9216, ZC = 5120;
constexpr float ALPHA = 1.189207115002721f;
constexpr float LN_EPS = 1e-5f;
constexpr int Z_BG = 0, Z_U = 1024, Z_O = 2048, Z_GC = 3072, Z_GM = 4096;
constexpr int HM_SAMPLE0 = 32 * 2048;
constexpr size_t O_Y = 0, O_CONVP = 17301504, O_CONVS = 17317888, O_CP = 17580032, O_CS = 19677184, O_NP = 53231616, O_NS = 53239808, O_MP = 53370880, O_MS = 53370912;
constexpr size_t SZ_ACT = (size_t)NTOK * DM * 2;
constexpr size_t WS_XB = 0;
constexpr size_t WS_WIN = WS_XB + SZ_ACT;
constexpr size_t WS_WC = WS_WIN + (size_t)NZ * DM * 2;
constexpr size_t WS_WM = WS_WC + (size_t)DM * DM * 2;
constexpr size_t WS_WO = WS_WM + (size_t)DM * DM * 2;
constexpr size_t WS_W1 = WS_WO + (size_t)DM * DM * 2;
constexpr size_t WS_W2 = WS_W1 + (size_t)DFF * DM * 2;
constexpr size_t WS_G = WS_W2 + (size_t)DFF * DM * 2;
constexpr size_t WS_Z = WS_G + (size_t)NTOK * 8 * 4;
constexpr size_t WS_HID = WS_Z;
constexpr size_t WS_R = WS_Z + (size_t)NTOK * DFF * 2;
constexpr size_t WS_QKV = WS_Z + (size_t)NTOK * ZC * 2;
constexpr size_t WS_KT = WS_QKV + 3 * SZ_ACT;
constexpr size_t WS_H = WS_KT + (size_t)32 * 256 * 2048 * 2;
constexpr size_t WS_AC = WS_H + SZ_ACT;
constexpr size_t WS_HN = WS_AC + SZ_ACT;
constexpr size_t WS_BAR = WS_HN + SZ_ACT;
constexpr size_t WS_END = WS_BAR + 16384;
constexpr int LDS_BYTES = 131072 + 16;

struct Params {
    const float *xp, *xs, *sconv, *sC, *sn, *sm, *w_in, *b_gate, *conv_w, *w_co, *mh_g, *w_mo, *w_o, *ln1g, *ln1b, *w_ff1, *w_ff2, *ln2g, *ln2b;
    float* out; unsigned char* ws; int ph_lo, ph_hi;
};

__device__ __forceinline__ unsigned cvt_pk_bf16(float lo, float hi) { unsigned r; asm volatile("v_cvt_pk_bf16_f32 %0, %1, %2" : "=v"(r) : "v"(lo), "v"(hi)); return r; }
__device__ __forceinline__ float bf_lo(unsigned w) { return __uint_as_float(w << 16); }
__device__ __forceinline__ float bf_hi(unsigned w) { return __uint_as_float(w & 0xffff0000u); }
__device__ __forceinline__ float bf2f(bf16_t b) { return __uint_as_float(((unsigned)b) << 16); }
__device__ __forceinline__ float sigmoidf_(float x) { return 1.0f / (1.0f + __expf(-x)); }
__device__ __forceinline__ float wave_sum(float v) {
#pragma unroll
    for (int o = 1; o < 64; o <<= 1) v += __shfl_xor(v, o);
    return v;
}
__device__ __forceinline__ const float* xrow(const Params& p, int r) { return r < NPROMPT ? p.xp + (size_t)r * DM : p.xs + (size_t)(r - NPROMPT) * DM; }
#define LDS_WAIT() asm volatile("s_waitcnt lgkmcnt(0)" ::: "memory")

#define XB_TMO      128
#define XB_XCNT(j)  (256  + 64 * (j))
#define XB_XSUB(j)  (1280 + 64 * (j))
#define XB_XGEN(j)  (2304 + 64 * (j))
#define XB_TOP      3328
#define XB_TOPGEN   3392
#define XCD_BAR_WORDS 3456
#define XB_SPIN_CAP (1u << 22)
__device__ __forceinline__ unsigned xb_ld(unsigned* p)              { return __hip_atomic_load(p, __ATOMIC_RELAXED, __HIP_MEMORY_SCOPE_AGENT); }
__device__ __forceinline__ unsigned xb_add(unsigned* p, unsigned v) { return __hip_atomic_fetch_add(p, v, __ATOMIC_RELAXED, __HIP_MEMORY_SCOPE_AGENT); }
__device__ __forceinline__ unsigned xb_xcc_id() { return (unsigned)__builtin_amdgcn_s_getreg((3 << 11) | 20) & 0xFu; }
#define XB_SPIN(cond, bar) do { unsigned _sp = 0; while (cond) { __builtin_amdgcn_s_sleep(1); \
    if ((++_sp & 255u) == 0u) { if (xb_ld(&(bar)[XB_TMO])) break; if (_sp > XB_SPIN_CAP) { atomicAdd(&(bar)[XB_TMO], 1u); break; } } } } while (0)
struct XcdBarrier { unsigned* bar; unsigned x; volatile LAS unsigned* st; };
__device__ __forceinline__ XcdBarrier xcd_barrier_post(unsigned* bar, volatile LAS unsigned* st) {
    XcdBarrier b; b.bar = bar; b.x = xb_xcc_id(); b.st = st;
    if (threadIdx.x == 0) (void)xb_add(&bar[XB_XCNT(b.x)], 1u);
    return b;
}
__device__ __forceinline__ void xcd_barrier_complete(unsigned* bar, unsigned x, unsigned& nloc, unsigned& nx) {
    const unsigned G = gridDim.x * gridDim.y * gridDim.z;
    unsigned sum, cnt, mine, sp = 0u;
    for (;;) {
        sum = 0u; cnt = 0u; mine = 0u;
#pragma unroll
        for (unsigned j = 0; j < 16; ++j) { const unsigned c = xb_ld(&bar[XB_XCNT(j)]); sum += c; cnt += (c > 0u) ? 1u : 0u; mine = (j == x) ? c : mine; }
        if (sum == G) break;
        __builtin_amdgcn_s_sleep(1);
        if ((++sp & 255u) == 0u) { if (xb_ld(&bar[XB_TMO])) break; if (sp > XB_SPIN_CAP) { atomicAdd(&bar[XB_TMO], 1u); break; } }
    }
    nloc = mine > 0u ? mine : 1u; nx = cnt > 0u ? cnt : 1u;
}
__device__ __forceinline__ void xcd_barrier(const XcdBarrier& b) {
    asm volatile("s_waitcnt vmcnt(0)" ::: "memory");
    __syncthreads();
    if (threadIdx.x == 0) {
        unsigned* bar = b.bar;
        __builtin_amdgcn_s_waitcnt(0);
        unsigned nloc = b.st[0], nx = b.st[1];
        if (nloc == 0u) { xcd_barrier_complete(bar, b.x, nloc, nx); b.st[0] = nloc; b.st[1] = nx; }
        const unsigned old = xb_add(&bar[XB_XSUB(b.x)], 1u);
        const unsigned gen = old / nloc;
        if (old + 1u == (gen + 1u) * nloc) {
            __builtin_amdgcn_fence(__ATOMIC_RELEASE, "agent");
            asm volatile("s_waitcnt vmcnt(0)" ::: "memory");
            const unsigned og = xb_add(&bar[XB_TOP], 1u);
            const unsigned tg = og / nx;
            if (og + 1u == (tg + 1u) * nx) xb_add(&bar[XB_TOPGEN], 1u);
            else XB_SPIN(xb_ld(&bar[XB_TOPGEN]) == tg, bar);
            __builtin_amdgcn_fence(__ATOMIC_ACQUIRE, "agent");
            xb_add(&bar[XB_XGEN(b.x)], 1u);
            asm volatile("s_waitcnt vmcnt(0)" ::: "memory");
        } else {
            XB_SPIN(xb_ld(&bar[XB_XGEN(b.x)]) == gen, bar);
            __builtin_amdgcn_fence(__ATOMIC_ACQUIRE, "agent");
            asm volatile("s_waitcnt vmcnt(0)" ::: "memory");
        }
    }
    __syncthreads();
}

namespace pg8 {
constexpr int BM = 256, BK = 64, HALF = 128, HTB = HALF * BK * 2, NXCD = 8, WGM = 8;
__host__ __device__ __forceinline__ int lds_byte(int r, int c) { const int st = (r >> 4) * 2 + (c >> 5), rr = r & 15, cc = c & 31, ob = rr * 64 + cc * 2; return st * 1024 + (ob ^ (((ob >> 9) & 1) << 5)); }
__host__ __device__ __forceinline__ void stage_rc(int b, int& R, int& C) { const int st = b / 1024, sb = b % 1024, swz = sb ^ (((sb >> 9) & 1) << 5); R = (st >> 1) * 16 + swz / 64; C = (st & 1) * 32 + (swz % 64) / 2; }
__host__ __device__ __forceinline__ int perm32(int rho) { const int n = rho >> 4, i = rho & 15; return 8 * (i >> 2) + 4 * n + (i & 3); }
struct Unit { int pm, pn, k0, nt, ks; };
struct Gemm { const bf16_t* A; const bf16_t* Bt; int M, N, K; };
struct StaticOrder {
    int nM, nN, nwg, G, c, kt;
    __device__ void init(int M, int N, int K, int G_, int c_) { nM = M / BM; nN = N / BM; nwg = nM * nN; G = G_; c = c_; kt = K / BK; }
    __device__ bool next(int i, Unit& u) const {
        const long L = (long)i * G + c; if (L >= nwg) return false;
        int wgid = (int)L; { const int q = nwg / NXCD, r = nwg % NXCD, xcd = wgid % NXCD, off = wgid / NXCD; wgid = (xcd < r ? xcd * (q + 1) : r * (q + 1) + (xcd - r) * q) + off; }
        const int nig = WGM * nN, gid = wgid / nig, fm = gid * WGM, gsz = (nM - fm) < WGM ? (nM - fm) : WGM;
        u.pm = fm + ((wgid % nig) % gsz); u.pn = (wgid % nig) / gsz; u.k0 = 0; u.nt = kt; u.ks = -1; return true;
    }
};
struct SplitOrder {
    StaticOrder so; int NS, ntk;
    __device__ void init(int K, int NS_, int G_, int c_) { so.init(NPROMPT, DM, K, G_, c_); NS = NS_; ntk = K / (BK * NS_); }
    __device__ bool next(int i, Unit& u) const {
        const long L = (long)i * so.G + so.c;
        if (L < so.nwg) return so.next(i, u);
        const int e = (int)(L - so.nwg); if (e >= 8 * NS) return false;
        const int tile = e / NS, ks = e % NS; u.pm = 64 + (tile >> 2); u.pn = tile & 3; u.k0 = ks * ntk * BK; u.nt = ntk; u.ks = ks; return true;
    }
};

template <class Epi, class Sched>
__device__ __forceinline__ void gemm_phase(LAS unsigned char* lds, const Gemm g, const Sched& S, const Epi& E) {
    const int tid = threadIdx.x, wid = __builtin_amdgcn_readfirstlane(tid >> 6), lane = tid & 63, wr = wid >> 2, wc = wid & 3, fr = lane & 15, fq = lane >> 4;
    const int K = g.K;
    unsigned voffA[2], voffB[2];
#pragma unroll
    for (int i = 0; i < 2; ++i) { int R, C; stage_rc(tid * 16 + i * 8192, R, C); const int Rb = (R & ~31) + perm32(R & 31);
        voffA[i] = (unsigned)(R * K + C) * 2u; voffB[i] = (unsigned)(Rb * K + C) * 2u; }
    const size_t kstep = (size_t)(BK * 2);
    const size_t hstep = (size_t)HALF * K * 2;
    const size_t tstep = 2 * hstep;
    const unsigned ldsw = (unsigned)wid * 1024u;
    const int aoff = lds_byte(wr * 64 + fr, fq * 8), boff = lds_byte(wc * 32 + fr, fq * 8);
#define PG8_SA(b, h) (((b) * 2 + (h)) * HTB)
#define PG8_SB(b, h) ((4 + (b) * 2 + (h)) * HTB)
#define PG8_STAGE(bufoff, gbase, voff) do { _Pragma("unroll") for (int _i = 0; _i < 2; ++_i) \
        __builtin_amdgcn_global_load_lds((const unsigned*)((const char*)(gbase) + (voff)[_i]), (LAS unsigned*)(lds + (bufoff) + ldsw + _i * 8192), 16, 0, 0); } while (0)
#define PG8_LDA(dst, b, h) do { _Pragma("unroll") for (int m = 0; m < 4; ++m) _Pragma("unroll") for (int k = 0; k < 2; ++k) dst[m][k] = *(const LAS bf16x8*)(lds + PG8_SA(b, h) + aoff + m * 2048 + k * 1024); } while (0)
#define PG8_LDB(dst, b, h) do { _Pragma("unroll") for (int n = 0; n < 2; ++n) _Pragma("unroll") for (int k = 0; k < 2; ++k) dst[n][k] = *(const LAS bf16x8*)(lds + PG8_SB(b, h) + boff + n * 2048 + k * 1024); } while (0)
#define PG8_MMA(ai, bj, At, Bt) do { __builtin_amdgcn_s_setprio(1); _Pragma("unroll") for (int m = 0; m < 4; ++m) _Pragma("unroll") for (int n = 0; n < 2; ++n) _Pragma("unroll") for (int k = 0; k < 2; ++k) \
        acc[ai][bj][m][n] = __builtin_amdgcn_mfma_f32_16x16x32_bf16(Bt[n][k], At[m][k], acc[ai][bj][m][n], 0, 0, 0); __builtin_amdgcn_s_setprio(0); } while (0)
#define PG8_WAIT_V(n) asm volatile("s_waitcnt vmcnt(" #n ")" ::: "memory")
#define PG8_WAIT_L(n) asm volatile("s_waitcnt lgkmcnt(" #n ")" ::: "memory")
#define PG8_BAR __builtin_amdgcn_s_barrier()
#define PG8_SCHED __builtin_amdgcn_sched_barrier(0)
    Unit cur, nxt; int ui = 0;
    if (!S.next(0, cur)) return;
    f32x4 acc[2][2][4][2];
#pragma unroll
    for (int a = 0; a < 2; ++a)
#pragma unroll
        for (int b = 0; b < 2; ++b)
#pragma unroll
            for (int m = 0; m < 4; ++m)
#pragma unroll
                for (int n = 0; n < 2; ++n) acc[a][b][m][n] = (f32x4){0.f, 0.f, 0.f, 0.f};
    bf16x8 At[4][2], B0[2][2], B1[2][2];
    const char* cA = (const char*)g.A + (size_t)cur.pm * tstep + (size_t)cur.k0 * 2; const char* cB = (const char*)g.Bt + (size_t)cur.pn * tstep + (size_t)cur.k0 * 2;
    PG8_STAGE(PG8_SB(0, 0), cB, voffB); PG8_STAGE(PG8_SA(0, 0), cA, voffA); PG8_STAGE(PG8_SB(0, 1), cB + hstep, voffB); PG8_STAGE(PG8_SA(0, 1), cA + hstep, voffA);
    if (wr == 1) PG8_BAR;
    PG8_WAIT_V(4); PG8_BAR;
    PG8_STAGE(PG8_SB(1, 0), cB + kstep, voffB); PG8_STAGE(PG8_SA(1, 0), cA + kstep, voffA); PG8_STAGE(PG8_SB(1, 1), cB + hstep + kstep, voffB);
    PG8_WAIT_V(6); PG8_BAR;
    for (;;) {
        const bool has_next = S.next(ui + 1, nxt);
        const char* nA = has_next ? (const char*)g.A + (size_t)nxt.pm * tstep + (size_t)nxt.k0 * 2 : cA; const char* nB = has_next ? (const char*)g.Bt + (size_t)nxt.pn * tstep + (size_t)nxt.k0 * 2 : cB;
        const int nt = cur.nt;
        for (int t = 0; t < nt; t += 2) {
            const bool last = (t == nt - 2);
            const char* a1 = cA + (size_t)(t + 1) * kstep;
            const char* a2 = last ? nA : cA + (size_t)(t + 2) * kstep; const char* b2 = last ? nB : cB + (size_t)(t + 2) * kstep;
            const char* a3 = a2 + kstep; const char* b3 = b2 + kstep;
            PG8_LDB(B0, 0, 0); PG8_SCHED; PG8_LDA(At, 0, 0); PG8_STAGE(PG8_SA(1, 1), a1 + hstep, voffA);
            PG8_WAIT_L(8); PG8_BAR; PG8_WAIT_L(0); PG8_MMA(0, 0, At, B0); PG8_BAR; PG8_SCHED;
            PG8_LDB(B1, 0, 1); PG8_STAGE(PG8_SB(0, 0), b2, voffB);
            PG8_BAR; PG8_WAIT_L(0); PG8_MMA(0, 1, At, B1); PG8_BAR;
            PG8_LDA(At, 0, 1); PG8_STAGE(PG8_SA(0, 0), a2, voffA);
            PG8_BAR; PG8_WAIT_L(0); PG8_MMA(1, 0, At, B0); PG8_BAR; PG8_SCHED;
            PG8_STAGE(PG8_SB(0, 1), b2 + hstep, voffB);
            PG8_WAIT_V(6); PG8_BAR; PG8_MMA(1, 1, At, B1); PG8_BAR;
            PG8_LDB(B0, 1, 0); PG8_SCHED; PG8_LDA(At, 1, 0); PG8_STAGE(PG8_SA(0, 1), a2 + hstep, voffA);
            PG8_WAIT_L(8); PG8_BAR; PG8_WAIT_L(0); PG8_MMA(0, 0, At, B0); PG8_BAR; PG8_SCHED;
            PG8_LDB(B1, 1, 1); PG8_STAGE(PG8_SB(1, 0), b3, voffB);
            PG8_BAR; PG8_WAIT_L(0); PG8_MMA(0, 1, At, B1); PG8_BAR;
            PG8_LDA(At, 1, 1); PG8_STAGE(PG8_SA(1, 0), a3, voffA);
            PG8_BAR; PG8_WAIT_L(0); PG8_MMA(1, 0, At, B0); PG8_BAR; PG8_SCHED;
            PG8_STAGE(PG8_SB(1, 1), b3 + hstep, voffB);
            PG8_WAIT_V(6); PG8_BAR; PG8_MMA(1, 1, At, B1); PG8_BAR;
        }
        E(acc, cur, wr, wc, fr, fq);
        if (!has_next) break;
#pragma unroll
        for (int a = 0; a < 2; ++a)
#pragma unroll
            for (int b = 0; b < 2; ++b)
#pragma unroll
                for (int m = 0; m < 4; ++m)
#pragma unroll
                    for (int n = 0; n < 2; ++n) acc[a][b][m][n] = (f32x4){0.f, 0.f, 0.f, 0.f};
        cur = nxt; cA = nA; cB = nB; ++ui;
    }
    PG8_WAIT_V(0);
    if (wr == 0) PG8_BAR;
    PG8_BAR;
#undef PG8_SA
#undef PG8_SB
#undef PG8_STAGE
#undef PG8_LDA
#undef PG8_LDB
#undef PG8_MMA
#undef PG8_WAIT_V
#undef PG8_WAIT_L
#undef PG8_BAR
#undef PG8_SCHED
}
}
using pg8::Unit;

#define EPI_LOOP_BEGIN \
    _Pragma("unroll") for (int ai = 0; ai < 2; ++ai) _Pragma("unroll") for (int m = 0; m < 4; ++m) { const int row = u.pm * 256 + ai * 128 + wr * 64 + m * 16 + fr; \
    _Pragma("unroll") for (int bj = 0; bj < 2; ++bj) { const int lc = bj * 128 + wc * 32 + 8 * fq; const f32x4 v0 = acc[ai][bj][m][0], v1 = acc[ai][bj][m][1];
#define EPI_LOOP_END } }

struct EpiZ {
    bf16_t* Z; bf16_t* QKV; bf16_t* KT;
    __device__ __forceinline__ void operator()(const f32x4 (&acc)[2][2][4][2], const Unit& u, int wr, int wc, int fr, int fq) const {
        const int pn = u.pn;
        if (pn >= 4 && pn < 12) {
#pragma unroll
            for (int ai = 0; ai < 2; ++ai)
#pragma unroll
                for (int m = 0; m < 4; ++m) { const int row = u.pm * 256 + ai * 128 + wr * 64 + m * 16 + fr;
                    const f32x4 a0 = acc[ai][0][m][0] * acc[ai][1][m][0], a1 = acc[ai][0][m][1] * acc[ai][1][m][1];
                    u32x4 w; w.x = cvt_pk_bf16(a0[0], a0[1]); w.y = cvt_pk_bf16(a0[2], a0[3]); w.z = cvt_pk_bf16(a1[0], a1[1]); w.w = cvt_pk_bf16(a1[2], a1[3]);
                    *(u32x4*)(Z + (size_t)row * ZC + Z_U + (pn - 4) * 128 + wc * 32 + 8 * fq) = w; }
            return;
        }
        if (pn >= 12 && pn < 24) {
            const int grp = (pn - 12) >> 2, hh = (pn - 12) & 3;
            bf16_t* dst = QKV + (size_t)grp * NTOK * DM;
            EPI_LOOP_BEGIN
                const size_t rr = row < NPROMPT ? (size_t)((row >> 11) * 4 + hh) * SEQ + (row & 2047) : (size_t)HM_SAMPLE0 + (size_t)(((row - NPROMPT) >> 2) * 4 + hh) * 4 + ((row - NPROMPT) & 3);
                u32x4 w; w.x = cvt_pk_bf16(v0[0], v0[1]); w.y = cvt_pk_bf16(v0[2], v0[3]); w.z = cvt_pk_bf16(v1[0], v1[1]); w.w = cvt_pk_bf16(v1[2], v1[3]);
                *(u32x4*)(dst + rr * 256 + lc) = w;
                if (grp == 1 && row < NPROMPT) {
                    bf16_t* kt = KT + ((size_t)(((row >> 11) * 4 + hh) * 256 + lc)) * SEQ + (row & 2047);
                    kt[0 * SEQ] = (bf16_t)(w.x & 0xffff); kt[1 * SEQ] = (bf16_t)(w.x >> 16); kt[2 * SEQ] = (bf16_t)(w.y & 0xffff); kt[3 * SEQ] = (bf16_t)(w.y >> 16);
                    kt[4 * SEQ] = (bf16_t)(w.z & 0xffff); kt[5 * SEQ] = (bf16_t)(w.z >> 16); kt[6 * SEQ] = (bf16_t)(w.w & 0xffff); kt[7 * SEQ] = (bf16_t)(w.w >> 16);
                }
            EPI_LOOP_END
            return;
        }
        const int zc0 = pn < 4 ? pn * 256 : Z_O + (pn - 24) * 256;
        const bool sg = pn >= 24;
        EPI_LOOP_BEGIN
            f32x4 a0 = v0, a1 = v1;
            if (sg) {
#pragma unroll
                for (int j = 0; j < 4; ++j) { a0[j] = sigmoidf_(a0[j]); a1[j] = sigmoidf_(a1[j]); }
            }
            u32x4 w; w.x = cvt_pk_bf16(a0[0], a0[1]); w.y = cvt_pk_bf16(a0[2], a0[3]); w.z = cvt_pk_bf16(a1[0], a1[1]); w.w = cvt_pk_bf16(a1[2], a1[3]);
            *(u32x4*)(Z + (size_t)row * ZC + zc0 + lc) = w;
        EPI_LOOP_END
    }
};
struct EpiGate {
    bf16_t* O; const bf16_t* T; const bf16_t* Z; int gcol; int add;
    __device__ __forceinline__ void operator()(const f32x4 (&acc)[2][2][4][2], const Unit& u, int wr, int wc, int fr, int fq) const {
        EPI_LOOP_BEGIN
            const int col = u.pn * 256 + lc;
            const u32x4 gw = *(const u32x4*)(Z + (size_t)row * ZC + gcol + col);
            f32x4 a0, a1;
            a0[0] = bf_lo(gw.x) * v0[0]; a0[1] = bf_hi(gw.x) * v0[1]; a0[2] = bf_lo(gw.y) * v0[2]; a0[3] = bf_hi(gw.y) * v0[3];
            a1[0] = bf_lo(gw.z) * v1[0]; a1[1] = bf_hi(gw.z) * v1[1]; a1[2] = bf_lo(gw.w) * v1[2]; a1[3] = bf_hi(gw.w) * v1[3];
            if (add) { const u32x4 tw = *(const u32x4*)(T + (size_t)row * DM + col);
                a0[0] += bf_lo(tw.x); a0[1] += bf_hi(tw.x); a0[2] += bf_lo(tw.y); a0[3] += bf_hi(tw.y); a1[0] += bf_lo(tw.z); a1[1] += bf_hi(tw.z); a1[2] += bf_lo(tw.w); a1[3] += bf_hi(tw.w); }
            u32x4 w; w.x = cvt_pk_bf16(a0[0], a0[1]); w.y = cvt_pk_bf16(a0[2], a0[3]); w.z = cvt_pk_bf16(a1[0], a1[1]); w.w = cvt_pk_bf16(a1[2], a1[3]);
            *(u32x4*)(O + (size_t)row * DM + col) = w;
        EPI_LOOP_END
    }
};
#define EPI_SLAB_PATH \
        if (u.ks >= 0) { float* sl = SL + (size_t)u.ks * NSAMPLE * DM; \
            EPI_LOOP_BEGIN \
                float* dp = sl + (size_t)(row - NPROMPT) * DM + u.pn * 256 + lc; *(f32x4*)dp = v0; *(f32x4*)(dp + 4) = v1; \
            EPI_LOOP_END \
            return; }
struct EpiResX {
    float* R; const float* xp; const float* xs; float* SL;
    __device__ __forceinline__ void operator()(const f32x4 (&acc)[2][2][4][2], const Unit& u, int wr, int wc, int fr, int fq) const {
        EPI_SLAB_PATH
        EPI_LOOP_BEGIN
            const int col = u.pn * 256 + lc;
            const float* xr = (row < NPROMPT ? xp + (size_t)row * DM : xs + (size_t)(row - NPROMPT) * DM) + col;
            const f32x4 x0 = *(const f32x4*)xr, x1 = *(const f32x4*)(xr + 4);
            *(f32x4*)(R + (size_t)row * DM + col) = x0 * ALPHA + v0; *(f32x4*)(R + (size_t)row * DM + col + 4) = x1 * ALPHA + v1;
        EPI_LOOP_END
    }
};
struct EpiResB {
    float* R; const bf16_t* X1; float* SL;
    __device__ __forceinline__ void operator()(const f32x4 (&acc)[2][2][4][2], const Unit& u, int wr, int wc, int fr, int fq) const {
        EPI_SLAB_PATH
        EPI_LOOP_BEGIN
            const int col = u.pn * 256 + lc;
            const u32x4 xw = *(const u32x4*)(X1 + (size_t)row * DM + col);
            f32x4 a0, a1;
            a0[0] = bf_lo(xw.x) * ALPHA + v0[0]; a0[1] = bf_hi(xw.x) * ALPHA + v0[1]; a0[2] = bf_lo(xw.y) * ALPHA + v0[2]; a0[3] = bf_hi(xw.y) * ALPHA + v0[3];
            a1[0] = bf_lo(xw.z) * ALPHA + v1[0]; a1[1] = bf_hi(xw.z) * ALPHA + v1[1]; a1[2] = bf_lo(xw.w) * ALPHA + v1[2]; a1[3] = bf_hi(xw.w) * ALPHA + v1[3];
            *(f32x4*)(R + (size_t)row * DM + col) = a0; *(f32x4*)(R + (size_t)row * DM + col + 4) = a1;
        EPI_LOOP_END
    }
};
struct EpiHid {
    bf16_t* Hd;
    __device__ __forceinline__ void operator()(const f32x4 (&acc)[2][2][4][2], const Unit& u, int wr, int wc, int fr, int fq) const {
        EPI_LOOP_BEGIN
            const int col = u.pn * 256 + lc;
            f32x4 a0, a1;
#pragma unroll
            for (int j = 0; j < 4; ++j) { const float r0 = fmaxf(v0[j], 0.f), r1 = fmaxf(v1[j], 0.f); a0[j] = r0 * r0; a1[j] = r1 * r1; }
            u32x4 w; w.x = cvt_pk_bf16(a0[0], a0[1]); w.y = cvt_pk_bf16(a0[2], a0[3]); w.z = cvt_pk_bf16(a1[0], a1[1]); w.w = cvt_pk_bf16(a1[2], a1[3]);
            *(u32x4*)(Hd + (size_t)row * DFF + col) = w;
        EPI_LOOP_END
    }
};

__device__ __forceinline__ void transpose_item(const float* W, int ldw, int K, int src0, bf16_t* WT, int dst0, int kb, float scale, LAS float* scr, int lane) {
    const int k0 = kb * 64;
#pragma unroll 8
    for (int i = 0; i < 32; ++i) { const int kk = 2 * i + (lane >> 5); scr[kk * 33 + (lane & 31)] = W[(size_t)(k0 + kk) * ldw + src0 + (lane & 31)]; }
    LDS_WAIT();
    const int c = lane & 7;
#pragma unroll
    for (int j = 0; j < 4; ++j) { const int n = (lane >> 3) + 8 * j; const LAS float* s = scr + (8 * c) * 33 + n;
        u32x4 o; o.x = cvt_pk_bf16(s[0 * 33] * scale, s[1 * 33] * scale); o.y = cvt_pk_bf16(s[2 * 33] * scale, s[3 * 33] * scale);
        o.z = cvt_pk_bf16(s[4 * 33] * scale, s[5 * 33] * scale); o.w = cvt_pk_bf16(s[6 * 33] * scale, s[7 * 33] * scale);
        *(u32x4*)(WT + (size_t)(dst0 + n) * K + k0 + 8 * c) = o; }
    LDS_WAIT();
}
__device__ __forceinline__ void phase0(const Params& p, LAS unsigned char* lds) {
    const int tid = threadIdx.x, wid = tid >> 6, lane = tid & 63;
    const int gw = blockIdx.x * 8 + wid, NGW = gridDim.x * 8;
    LAS float* scr = (LAS float*)(lds + wid * 8704);
    LAS float* wg = (LAS float*)(lds + 73728);
    for (int e = tid; e < 2048; e += 512) { const int k = e >> 1, hf = e & 1; *(LAS f32x4*)(wg + k * 8 + hf * 4) = *(const f32x4*)(p.w_in + (size_t)k * DIN + 7168 + hf * 4); }
    __syncthreads();
    bf16_t* WIN = (bf16_t*)(p.ws + WS_WIN);
    constexpr int I_IN = 72 * 4 * 16, I_SQ = 32 * 16, I_F1 = 128 * 16, I_F2 = 32 * 64;
    constexpr int NITEMS = I_IN + 3 * I_SQ + I_F1 + I_F2;
    for (int it = gw; it < NITEMS; it += NGW) {
        int r = it;
        if (r < I_IN) { const int kb = r & 15, nb = r >> 4, g = nb >> 2, sub = nb & 3;
            int src; if (g < 8) src = g * 128; else if (g < 24) { const int pr = (g - 8) >> 1, hf = (g - 8) & 1; src = (hf ? 2048 : 1024) + pr * 128; } else if (g < 56) src = 3072 + (g - 24) * 128; else src = 7176 + (g - 56) * 128;
            const float sc = (g >= 32 && g < 40) ? 0.0625f : 1.0f;
            transpose_item(p.w_in, DIN, DM, src + sub * 32, WIN, g * 128 + sub * 32, kb, sc, scr, lane); continue; }
        r -= I_IN;
        if (r < 3 * I_SQ) { const int w = r / I_SQ, q = r % I_SQ, kb = q & 15, nb = q >> 4;
            const float* W = w == 0 ? p.w_co : (w == 1 ? p.w_mo : p.w_o); bf16_t* WT = (bf16_t*)(p.ws + (w == 0 ? WS_WC : (w == 1 ? WS_WM : WS_WO)));
            transpose_item(W, DM, DM, nb * 32, WT, nb * 32, kb, 1.0f, scr, lane); continue; }
        r -= 3 * I_SQ;
        if (r < I_F1) { const int kb = r & 15, nb = r >> 4; transpose_item(p.w_ff1, DFF, DM, nb * 32, (bf16_t*)(p.ws + WS_W1), nb * 32, kb, 1.0f, scr, lane); continue; }
        r -= I_F1;
        { const int kb = r & 63, nb = r >> 6; transpose_item(p.w_ff2, DM, DFF, nb * 32, (bf16_t*)(p.ws + WS_W2), nb * 32, kb, 1.0f, scr, lane); }
    }
    bf16_t* XB = (bf16_t*)(p.ws + WS_XB); float* G = (float*)(p.ws + WS_G);
    for (int r = gw; r < NTOK; r += NGW) {
        const float* xr = xrow(p, r);
        float g8[8];
#pragma unroll
        for (int j = 0; j < 8; ++j) g8[j] = 0.f;
#pragma unroll
        for (int j = 0; j < 4; ++j) { const int k = j * 256 + lane * 4; const f32x4 v = *(const f32x4*)(xr + k);
            u32x2 w; w.x = cvt_pk_bf16(v[0], v[1]); w.y = cvt_pk_bf16(v[2], v[3]); *(u32x2*)(XB + (size_t)r * DM + k) = w;
#pragma unroll
            for (int e = 0; e < 4; ++e) { const f32x4 wa = *(const LAS f32x4*)(wg + (k + e) * 8), wb = *(const LAS f32x4*)(wg + (k + e) * 8 + 4);
#pragma unroll
                for (int q = 0; q < 4; ++q) { g8[q] += v[e] * wa[q]; g8[4 + q] += v[e] * wb[q]; } } }
#pragma unroll
        for (int j = 0; j < 8; ++j) g8[j] = wave_sum(g8[j]);
        if (lane < 4) { G[(size_t)r * 8 + lane] = g8[0] * (lane == 0) + g8[1] * (lane == 1) + g8[2] * (lane == 2) + g8[3] * (lane == 3) + p.b_gate[lane]; }
        else if (lane < 8) { const float f = g8[4] * (lane == 4) + g8[5] * (lane == 5) + g8[6] * (lane == 6) + g8[7] * (lane == 7) + p.b_gate[lane];
            G[(size_t)r * 8 + lane] = fminf(f, 0.f) - log1pf(__expf(-fabsf(f))); }
    }
    __syncthreads();
}

constexpr int KS_LD = 264, VT_LD = 136;
constexpr int L_KSH = 0, L_CT = 128 * KS_LD * 2, L_VT = L_CT + 48 * KS_LD * 2, L_VW = L_VT + 48 * VT_LD * 2, L_SC = L_VW + 48 * VT_LD * 2;
__device__ __forceinline__ void mlstm_prompt_item(const Params& p, LAS unsigned char* lds, int bh, int vs) {
    const int tid = threadIdx.x, wid = __builtin_amdgcn_readfirstlane(tid >> 6), lane = tid & 63, li = lane & 15, kg = lane >> 4;
    const int b = bh >> 2, h = bh & 3, j0 = vs * 32;
    LAS bf16_t* Ksh = (LAS bf16_t*)(lds + L_KSH); LAS bf16_t* CTsh = (LAS bf16_t*)(lds + L_CT); LAS bf16_t* VTsh = (LAS bf16_t*)(lds + L_VT); LAS bf16_t* VWsh = (LAS bf16_t*)(lds + L_VW);
    LAS float* sA = (LAS float*)(lds + L_SC); LAS float* sG = sA + 128; LAS float* sB = sG + 128;
    const bf16_t* QH = (const bf16_t*)(p.ws + WS_QKV) + (size_t)bh * SEQ * 256; const bf16_t* KH = QH + (size_t)NTOK * DM; const bf16_t* VH = KH + (size_t)NTOK * DM;
    const bf16_t* KT = (const bf16_t*)(p.ws + WS_KT) + (size_t)bh * 256 * SEQ; const float* G = (const float*)(p.ws + WS_G) + (size_t)b * SEQ * 8; bf16_t* H = (bf16_t*)(p.ws + WS_H);
    for (int e = tid; e < 48 * KS_LD / 2; e += 512) ((LAS unsigned*)CTsh)[e] = 0u;
    for (int e = tid; e < 16 * VT_LD; e += 512) { const int rr = e / VT_LD; VTsh[32 * VT_LD + e] = rr == 0 ? (bf16_t)0x3F80 : (bf16_t)0; VWsh[32 * VT_LD + e] = 0; }
    f32x4 Cacc[2][3];
#pragma unroll
    for (int db = 0; db < 2; ++db)
#pragma unroll
        for (int jb = 0; jb < 3; ++jb) Cacc[db][jb] = (f32x4){0.f, 0.f, 0.f, 0.f};
    float m_prev = 0.f;
    const int vs_s = tid >> 2, vs_q = tid & 3;
    u32x4 kp[8]; u32x4 vp; bf16x8 qf[8]; float gi0 = 0.f, gf0 = 0.f, gi1 = 0.f, gf1 = 0.f;
#pragma unroll
    for (int i = 0; i < 8; ++i) kp[i] = *(const u32x4*)(KH + (size_t)(i * 512 + tid) * 8);
    vp = *(const u32x4*)(VH + (size_t)vs_s * 256 + j0 + vs_q * 8);
#pragma unroll
    for (int kk = 0; kk < 8; ++kk) qf[kk] = *(const bf16x8*)(QH + (size_t)(16 * wid + li) * 256 + kk * 32 + kg * 8);
    if (wid == 0) { gi0 = G[(size_t)lane * 8 + h]; gf0 = G[(size_t)lane * 8 + 4 + h]; gi1 = G[(size_t)(64 + lane) * 8 + h]; gf1 = G[(size_t)(64 + lane) * 8 + 4 + h]; }
    for (int c = 0; c < 16; ++c) {
        const int t0 = c * 128, tn = (c < 15 ? c + 1 : c) * 128;
        if (wid == 0) {
            float b0 = gf0, b1 = gf1;
#pragma unroll
            for (int o = 1; o < 64; o <<= 1) { const float x0 = __shfl_up(b0, o), x1 = __shfl_up(b1, o); if (lane >= o) { b0 += x0; b1 += x1; } }
            b1 += __shfl(b0, 63);
            const float a0 = gi0 - b0, a1 = gi1 - b1;
            float p0 = a0, p1 = a1;
#pragma unroll
            for (int o = 1; o < 64; o <<= 1) { const float x0 = __shfl_up(p0, o), x1 = __shfl_up(p1, o); if (lane >= o) { p0 = fmaxf(p0, x0); p1 = fmaxf(p1, x1); } }
            p1 = fmaxf(p1, __shfl(p0, 63));
            sA[lane] = a0; sA[64 + lane] = a1; sG[lane] = fmaxf(m_prev, p0); sG[64 + lane] = fmaxf(m_prev, p1); sB[lane] = b0; sB[64 + lane] = b1;
            gi0 = G[(size_t)(tn + lane) * 8 + h]; gf0 = G[(size_t)(tn + lane) * 8 + 4 + h]; gi1 = G[(size_t)(tn + 64 + lane) * 8 + h]; gf1 = G[(size_t)(tn + 64 + lane) * 8 + 4 + h];
        }
        __syncthreads();
        const float g_last = sG[127], b_last = sB[127];
#pragma unroll
        for (int i = 0; i < 8; ++i) { const int pc = i * 512 + tid, row = pc >> 5, c8 = pc & 31; *(LAS u32x4*)(Ksh + row * KS_LD + c8 * 8) = kp[i]; }
        {
            const float wsv = __expf(sA[vs_s] - g_last);
            const unsigned vw[4] = {vp.x, vp.y, vp.z, vp.w};
#pragma unroll
            for (int e = 0; e < 4; ++e) { const int j = vs_q * 8 + 2 * e; const float lo = bf_lo(vw[e]), hi = bf_hi(vw[e]);
                VTsh[j * VT_LD + vs_s] = (bf16_t)(vw[e] & 0xffff); VTsh[(j + 1) * VT_LD + vs_s] = (bf16_t)(vw[e] >> 16);
                const unsigned sw = cvt_pk_bf16(lo * wsv, hi * wsv);
                VWsh[j * VT_LD + vs_s] = (bf16_t)(sw & 0xffff); VWsh[(j + 1) * VT_LD + vs_s] = (bf16_t)(sw >> 16); }
            if (vs_q == 0) VWsh[32 * VT_LD + vs_s] = (bf16_t)(cvt_pk_bf16(wsv, 0.f) & 0xffff);
        }
        __syncthreads();
        bf16x8 ktf[2][4];
#pragma unroll
        for (int db = 0; db < 2; ++db)
#pragma unroll
            for (int k2 = 0; k2 < 4; ++k2) ktf[db][k2] = *(const bf16x8*)(KT + (size_t)((2 * wid + db) * 16 + li) * SEQ + t0 + k2 * 32 + kg * 8);
        {
            const int t_loc = 16 * wid + li;
            const float g_t = sG[t_loc], b_t = sB[t_loc];
            f32x4 ST[8];
#pragma unroll
            for (int sb = 0; sb < 8; ++sb) ST[sb] = (f32x4){0.f, 0.f, 0.f, 0.f};
#pragma unroll
            for (int kk = 0; kk < 8; ++kk) {
                bf16x8 kf[8];
#pragma unroll
                for (int sb = 0; sb < 8; ++sb) kf[sb] = *(const LAS bf16x8*)(Ksh + (sb * 16 + li) * KS_LD + kk * 32 + kg * 8);
#pragma unroll
                for (int sb = 0; sb < 8; ++sb) ST[sb] = __builtin_amdgcn_mfma_f32_16x16x32_bf16(kf[sb], qf[kk], ST[sb], 0, 0, 0);
            }
#pragma unroll
            for (int sb = 0; sb < 8; ++sb) { const f32x4 av = *(const LAS f32x4*)(sA + sb * 16 + kg * 4);
#pragma unroll
                for (int r = 0; r < 4; ++r) { const float wgt = __expf(av[r] - g_t); const bool ok = (sb * 16 + kg * 4 + r) <= t_loc; ST[sb][r] = ok ? ST[sb][r] * wgt : 0.f; } }
#pragma unroll
            for (int i = 0; i < 8; ++i) kp[i] = *(const u32x4*)(KH + (size_t)tn * 256 + (size_t)(i * 512 + tid) * 8);
            vp = *(const u32x4*)(VH + (size_t)(tn + vs_s) * 256 + j0 + vs_q * 8);
            f32x4 nt[3], it[3];
#pragma unroll
            for (int jb = 0; jb < 3; ++jb) { nt[jb] = (f32x4){0.f, 0.f, 0.f, 0.f}; it[jb] = (f32x4){0.f, 0.f, 0.f, 0.f}; }
#pragma unroll
            for (int k2 = 0; k2 < 4; ++k2) {
                u32x4 pw; pw.x = cvt_pk_bf16(ST[2 * k2][0], ST[2 * k2][1]); pw.y = cvt_pk_bf16(ST[2 * k2][2], ST[2 * k2][3]);
                pw.z = cvt_pk_bf16(ST[2 * k2 + 1][0], ST[2 * k2 + 1][1]); pw.w = cvt_pk_bf16(ST[2 * k2 + 1][2], ST[2 * k2 + 1][3]);
                bf16x8 pf; __builtin_memcpy(&pf, &pw, 16);
#pragma unroll
                for (int jb = 0; jb < 3; ++jb) { const LAS bf16_t* vr = VTsh + (jb * 16 + li) * VT_LD + k2 * 32 + kg * 4;
                    u32x4 vw4; const u32x2 lo = *(const LAS u32x2*)vr, hi = *(const LAS u32x2*)(vr + 16); vw4.x = lo.x; vw4.y = lo.y; vw4.z = hi.x; vw4.w = hi.y;
                    bf16x8 vf; __builtin_memcpy(&vf, &vw4, 16);
                    nt[jb] = __builtin_amdgcn_mfma_f32_16x16x32_bf16(vf, pf, nt[jb], 0, 0, 0); } }
#pragma unroll
            for (int kk = 0; kk < 8; ++kk)
#pragma unroll
                for (int jb = 0; jb < 3; ++jb) { const bf16x8 cf = *(const LAS bf16x8*)(CTsh + (jb * 16 + li) * KS_LD + kk * 32 + kg * 8);
                    it[jb] = __builtin_amdgcn_mfma_f32_16x16x32_bf16(cf, qf[kk], it[jb], 0, 0, 0); }
#pragma unroll
            for (int kk = 0; kk < 8; ++kk) qf[kk] = *(const bf16x8*)(QH + (size_t)(tn + 16 * wid + li) * 256 + kk * 32 + kg * 8);
            const float w_int = __expf(m_prev - g_t);
#pragma unroll
            for (int jb = 0; jb < 3; ++jb) nt[jb] = nt[jb] + it[jb] * w_int;
            const float den = __shfl(nt[2][0], li);
            const float rden = 1.0f / fmaxf(fabsf(den), __expf(-(b_t + g_t)));
#pragma unroll
            for (int jb = 0; jb < 2; ++jb) { u32x2 w; w.x = cvt_pk_bf16(nt[jb][0] * rden, nt[jb][1] * rden); w.y = cvt_pk_bf16(nt[jb][2] * rden, nt[jb][3] * rden);
                *(u32x2*)(H + (size_t)(b * SEQ + t0 + t_loc) * DM + h * 256 + j0 + jb * 16 + kg * 4) = w; }
        }
        __syncthreads();
        {
            const float decay = __expf(m_prev - g_last);
#pragma unroll
            for (int db = 0; db < 2; ++db)
#pragma unroll
                for (int jb = 0; jb < 3; ++jb) Cacc[db][jb] = Cacc[db][jb] * decay;
#pragma unroll
            for (int k2 = 0; k2 < 4; ++k2)
#pragma unroll
                for (int jb = 0; jb < 3; ++jb) { const bf16x8 vf = *(const LAS bf16x8*)(VWsh + (jb * 16 + li) * VT_LD + k2 * 32 + kg * 8);
#pragma unroll
                    for (int db = 0; db < 2; ++db) Cacc[db][jb] = __builtin_amdgcn_mfma_f32_16x16x32_bf16(ktf[db][k2], vf, Cacc[db][jb], 0, 0, 0); }
#pragma unroll
            for (int db = 0; db < 2; ++db)
#pragma unroll
                for (int jb = 0; jb < 3; ++jb) { u32x2 w; w.x = cvt_pk_bf16(Cacc[db][jb][0], Cacc[db][jb][1]); w.y = cvt_pk_bf16(Cacc[db][jb][2], Cacc[db][jb][3]);
                    *(LAS u32x2*)(CTsh + (jb * 16 + li) * KS_LD + (2 * wid + db) * 16 + kg * 4) = w; }
            m_prev = b_last + g_last;
        }
    }
#pragma unroll
    for (int db = 0; db < 2; ++db) { const int d0 = (2 * wid + db) * 16 + kg * 4;
#pragma unroll
        for (int jb = 0; jb < 2; ++jb)
#pragma unroll
            for (int r = 0; r < 4; ++r) p.out[O_CP + ((size_t)(bh * 256 + d0 + r)) * 256 + j0 + jb * 16 + li] = Cacc[db][jb][r];
        if (vs == 0 && li == 0) {
#pragma unroll
            for (int r = 0; r < 4; ++r) p.out[O_NP + (size_t)bh * 256 + d0 + r] = Cacc[db][2][r]; } }
    if (vs == 0 && tid == 0) p.out[O_MP + bh] = m_prev;
    __syncthreads();
}

__device__ __forceinline__ void mlstm_sample_item(const Params& p, LAS unsigned char* lds, int item) {
    const int tid = threadIdx.x, bs = item >> 2, h = item & 3, tok0 = NPROMPT + bs * 4;
    LAS float* sq = (LAS float*)lds; LAS float* sk = sq + 1024; LAS float* sv = sk + 1024; LAS float* sn0 = sv + 1024; LAS float* sdot = sn0 + 256; LAS float* sc = sdot + 32; LAS float* sred = sc + 64;
    const bf16_t* QS = (const bf16_t*)(p.ws + WS_QKV) + ((size_t)HM_SAMPLE0 + (size_t)item * 4) * 256;
    const float* G = (const float*)(p.ws + WS_G); bf16_t* H = (bf16_t*)(p.ws + WS_H);
    const int c4 = tid & 63, rw = tid >> 6, col = c4 * 4;
    const float* C0 = p.sC + (size_t)item * 65536 + (size_t)(rw * 32) * 256 + col; float* C1 = p.out + O_CS + (size_t)item * 65536 + (size_t)(rw * 32) * 256 + col;
    f32x4 cv[8];
#pragma unroll
    for (int j = 0; j < 8; ++j) cv[j] = __builtin_nontemporal_load((const f32x4*)(C0 + j * 256));
    for (int e = tid; e < 3072; e += 512) { const int which = e >> 10, idx = e & 1023; sq[e] = bf2f(QS[(size_t)which * NTOK * DM + idx]); }
    if (tid < 256) sn0[tid] = p.sn[(size_t)item * 256 + tid];
    __syncthreads();
    {
        const int id = tid >> 4, part = tid & 15;
        if (id < 20) { const LAS float* va = id < 16 ? sq + (id >> 2) * 256 : sq + (id - 16) * 256; const LAS float* vb = id < 16 ? sk + (id & 3) * 256 : sn0;
            float s = 0.f;
#pragma unroll
            for (int e = 0; e < 16; ++e) s += va[part * 16 + e] * vb[part * 16 + e];
            s += __shfl_xor(s, 8); s += __shfl_xor(s, 4); s += __shfl_xor(s, 2); s += __shfl_xor(s, 1);
            if (part == 0) sdot[id] = s; }
    }
    __syncthreads();
    if (tid == 0) {
        const float m0 = p.sm[item];
        float li_[4], lf_[4], bb[4], aa[4], gg[4];
#pragma unroll
        for (int s = 0; s < 4; ++s) { li_[s] = G[(size_t)(tok0 + s) * 8 + h]; lf_[s] = G[(size_t)(tok0 + s) * 8 + 4 + h]; }
        float cum = 0.f, pm = m0;
#pragma unroll
        for (int s = 0; s < 4; ++s) { cum += lf_[s]; bb[s] = cum; aa[s] = li_[s] - cum; pm = fmaxf(pm, aa[s]); gg[s] = pm; }
#pragma unroll
        for (int t = 0; t < 4; ++t) { const float wi = __expf(m0 - gg[t]); float den = wi * sdot[16 + t];
#pragma unroll
            for (int s = 0; s < 4; ++s) { const float S = s <= t ? sdot[t * 4 + s] * __expf(aa[s] - gg[t]) : 0.f; sc[16 + t * 4 + s] = S; den += S; }
            sc[t] = wi; sc[12 + t] = 1.0f / fmaxf(fabsf(den), __expf(-(bb[t] + gg[t]))); }
#pragma unroll
        for (int s = 0; s < 4; ++s) sc[4 + s] = __expf(aa[s] - gg[3]);
        sc[8] = __expf(m0 - gg[3]); sc[9] = bb[3] + gg[3];
    }
    __syncthreads();
    const float decay = sc[8]; const float ws0 = sc[4], ws1 = sc[5], ws2 = sc[6], ws3 = sc[7];
    const f32x4 v0 = *(const LAS f32x4*)(sv + col), v1 = *(const LAS f32x4*)(sv + 256 + col), v2 = *(const LAS f32x4*)(sv + 512 + col), v3 = *(const LAS f32x4*)(sv + 768 + col);
    f32x4 a0 = {0.f, 0.f, 0.f, 0.f}, a1 = a0, a2 = a0, a3 = a0;
#pragma unroll
    for (int rb = 0; rb < 4; ++rb) {
        f32x4 cn[8];
        if (rb < 3) {
#pragma unroll
            for (int j = 0; j < 8; ++j) cn[j] = __builtin_nontemporal_load((const f32x4*)(C0 + ((rb + 1) * 8 + j) * 256));
        }
#pragma unroll
        for (int j = 0; j < 8; ++j) { const int d = rw * 32 + rb * 8 + j; const f32x4 x = cv[j];
            a0 += x * sq[d]; a1 += x * sq[256 + d]; a2 += x * sq[512 + d]; a3 += x * sq[768 + d];
            const f32x4 y = x * decay + v0 * (ws0 * sk[d]) + v1 * (ws1 * sk[256 + d]) + v2 * (ws2 * sk[512 + d]) + v3 * (ws3 * sk[768 + d]);
            __builtin_nontemporal_store(y, (f32x4*)(C1 + (rb * 8 + j) * 256)); }
        if (rb < 3) {
#pragma unroll
            for (int j = 0; j < 8; ++j) cv[j] = cn[j];
        }
    }
    *(LAS f32x4*)(sred + (rw * 4 + 0) * 256 + col) = a0; *(LAS f32x4*)(sred + (rw * 4 + 1) * 256 + col) = a1; *(LAS f32x4*)(sred + (rw * 4 + 2) * 256 + col) = a2; *(LAS f32x4*)(sred + (rw * 4 + 3) * 256 + col) = a3;
    __syncthreads();
#pragma unroll
    for (int e = 0; e < 2; ++e) { const int o = tid + 512 * e, t = o >> 8, cx = o & 255;
        float inter = 0.f;
#pragma unroll
        for (int w = 0; w < 8; ++w) inter += sred[(w * 4 + t) * 256 + cx];
        float num = sc[t] * inter;
#pragma unroll
        for (int s = 0; s < 4; ++s) num += sc[16 + t * 4 + s] * sv[s * 256 + cx];
        H[(size_t)(tok0 + t) * DM + h * 256 + cx] = (bf16_t)(cvt_pk_bf16(num * sc[12 + t], 0.f) & 0xffff); }
    if (tid < 256) p.out[O_NS + (size_t)item * 256 + tid] = decay * sn0[tid] + ws0 * sk[tid] + ws1 * sk[256 + tid] + ws2 * sk[512 + tid] + ws3 * sk[768 + tid];
    if (tid == 0) p.out[O_MS + item] = sc[9];
    __syncthreads();
}

__device__ __forceinline__ void conv_unit(const Params& p, const bf16_t* Z, bf16_t* AC, int r, int ch, const float (&cw)[24], u32x4 uw, u32x4 bw, u32x4 w1, u32x4 w2) {
    float u0[8], u1[8], u2[8], bg[8];
    const unsigned uu[4] = {uw.x, uw.y, uw.z, uw.w}, bb[4] = {bw.x, bw.y, bw.z, bw.w}, q1[4] = {w1.x, w1.y, w1.z, w1.w}, q2[4] = {w2.x, w2.y, w2.z, w2.w};
#pragma unroll
    for (int e = 0; e < 4; ++e) { u2[2 * e] = bf_lo(uu[e]); u2[2 * e + 1] = bf_hi(uu[e]); bg[2 * e] = bf_lo(bb[e]); bg[2 * e + 1] = bf_hi(bb[e]);
        u1[2 * e] = bf_lo(q1[e]); u1[2 * e + 1] = bf_hi(q1[e]); u0[2 * e] = bf_lo(q2[e]); u0[2 * e + 1] = bf_hi(q2[e]); }
    const bool prompt = r < NPROMPT; const int t = prompt ? (r & 2047) : ((r - NPROMPT) & 3); const int bs = (r - NPROMPT) >> 2;
    if (t < 1) { if (prompt) {
#pragma unroll
            for (int e = 0; e < 8; ++e) u1[e] = 0.f; }
        else { const float* sp = p.sconv + ((size_t)bs * 2 + 1) * DM + ch;
#pragma unroll
            for (int e = 0; e < 8; ++e) u1[e] = sp[e]; } }
    if (t < 2) { if (prompt) {
#pragma unroll
            for (int e = 0; e < 8; ++e) u0[e] = 0.f; }
        else { const float* sp = p.sconv + ((size_t)bs * 2 + t) * DM + ch;
#pragma unroll
            for (int e = 0; e < 8; ++e) u0[e] = sp[e]; } }
    float o[8];
#pragma unroll
    for (int e = 0; e < 8; ++e) o[e] = bg[e] * (cw[e] * u0[e] + cw[8 + e] * u1[e] + cw[16 + e] * u2[e]);
    u32x4 w; w.x = cvt_pk_bf16(o[0], o[1]); w.y = cvt_pk_bf16(o[2], o[3]); w.z = cvt_pk_bf16(o[4], o[5]); w.w = cvt_pk_bf16(o[6], o[7]);
    *(u32x4*)(AC + (size_t)r * DM + ch) = w;
    float* so = nullptr;
    if (prompt) { if (t >= SEQ - 2) so = p.out + O_CONVP + ((size_t)(r >> 11) * 2 + (t - (SEQ - 2))) * DM + ch; }
    else if (t >= 2) so = p.out + O_CONVS + ((size_t)bs * 2 + (t - 2)) * DM + ch;
    if (so) {
#pragma unroll
        for (int e = 0; e < 8; ++e) so[e] = u2[e]; }
}
__device__ __forceinline__ void conv_items(const Params& p) {
    const bf16_t* Z = (const bf16_t*)(p.ws + WS_Z); bf16_t* AC = (bf16_t*)(p.ws + WS_AC);
    const int gt = blockIdx.x * 512 + threadIdx.x, NG = gridDim.x * 512;
    const int ch = (gt & 127) * 8, r0 = gt >> 7, rstep = NG >> 7;
    float cw[24];
#pragma unroll
    for (int e = 0; e < 8; ++e) { cw[e] = p.conv_w[ch + e]; cw[8 + e] = p.conv_w[DM + ch + e]; cw[16 + e] = p.conv_w[2 * DM + ch + e]; }
    for (int rb = r0; rb < NTOK; rb += 4 * rstep) {
        u32x4 uw[4], bw[4], w1[4], w2[4];
#pragma unroll
        for (int j = 0; j < 4; ++j) { const int r = rb + j * rstep; if (r < NTOK) { const int r1 = r >= 1 ? r - 1 : r, r2 = r >= 2 ? r - 2 : r;
            uw[j] = *(const u32x4*)(Z + (size_t)r * ZC + Z_U + ch); bw[j] = *(const u32x4*)(Z + (size_t)r * ZC + Z_BG + ch);
            w1[j] = *(const u32x4*)(Z + (size_t)r1 * ZC + Z_U + ch); w2[j] = *(const u32x4*)(Z + (size_t)r2 * ZC + Z_U + ch); } }
#pragma unroll
        for (int j = 0; j < 4; ++j) { const int r = rb + j * rstep; if (r < NTOK) conv_unit(p, Z, AC, r, ch, cw, uw[j], bw[j], w1[j], w2[j]); }
    }
}

__device__ __forceinline__ void hn_items(const Params& p) {
    const bf16_t* Z = (const bf16_t*)(p.ws + WS_Z); const bf16_t* H = (const bf16_t*)(p.ws + WS_H); bf16_t* HN = (bf16_t*)(p.ws + WS_HN);
    const int lane = threadIdx.x & 63, gw = blockIdx.x * 8 + (threadIdx.x >> 6), NGW = gridDim.x * 8, c0 = lane * 16;
    f32x4 mg[4];
#pragma unroll
    for (int j = 0; j < 4; ++j) mg[j] = *(const f32x4*)(p.mh_g + c0 + 4 * j);
    for (int r = gw; r < NTOK; r += NGW) {
        const u32x4 h0 = *(const u32x4*)(H + (size_t)r * DM + c0), h1 = *(const u32x4*)(H + (size_t)r * DM + c0 + 8);
        const u32x4 o0 = *(const u32x4*)(Z + (size_t)r * ZC + Z_O + c0), o1 = *(const u32x4*)(Z + (size_t)r * ZC + Z_O + c0 + 8);
        const unsigned hw[8] = {h0.x, h0.y, h0.z, h0.w, h1.x, h1.y, h1.z, h1.w}, ow[8] = {o0.x, o0.y, o0.z, o0.w, o1.x, o1.y, o1.z, o1.w};
        float v[16]; float s = 0.f;
#pragma unroll
        for (int e = 0; e < 8; ++e) { v[2 * e] = bf_lo(hw[e]); v[2 * e + 1] = bf_hi(hw[e]); s += v[2 * e] + v[2 * e + 1]; }
        s += __shfl_xor(s, 1); s += __shfl_xor(s, 2); s += __shfl_xor(s, 4); s += __shfl_xor(s, 8);
        const float mean = s * (1.0f / 256.0f); float q = 0.f;
#pragma unroll
        for (int e = 0; e < 16; ++e) { v[e] -= mean; q += v[e] * v[e]; }
        q += __shfl_xor(q, 1); q += __shfl_xor(q, 2); q += __shfl_xor(q, 4); q += __shfl_xor(q, 8);
        const float rstd = 1.0f / sqrtf(q * (1.0f / 256.0f) + LN_EPS);
        unsigned ww[8];
#pragma unroll
        for (int e = 0; e < 8; ++e) { const float g0 = mg[(2 * e) >> 2][(2 * e) & 3], g1 = mg[(2 * e + 1) >> 2][(2 * e + 1) & 3];
            ww[e] = cvt_pk_bf16(v[2 * e] * rstd * g0 * bf_lo(ow[e]), v[2 * e + 1] * rstd * g1 * bf_hi(ow[e])); }
        u32x4 w0, w1; w0.x = ww[0]; w0.y = ww[1]; w0.z = ww[2]; w0.w = ww[3]; w1.x = ww[4]; w1.y = ww[5]; w1.z = ww[6]; w1.w = ww[7];
        *(u32x4*)(HN + (size_t)r * DM + c0) = w0; *(u32x4*)(HN + (size_t)r * DM + c0 + 8) = w1;
    }
}

template <bool OUT_F32>
__device__ __forceinline__ void ln_rows(const float* R, const float* gam, const float* bet, void* out, const float* SL, int NS, const float* xs, const bf16_t* X1) {
    const int lane = threadIdx.x & 63, gw = blockIdx.x * 8 + (threadIdx.x >> 6), NGW = gridDim.x * 8;
    f32x4 gv[4], bv[4];
#pragma unroll
    for (int j = 0; j < 4; ++j) { gv[j] = *(const f32x4*)(gam + j * 256 + lane * 4); bv[j] = *(const f32x4*)(bet + j * 256 + lane * 4); }
    for (int r = gw; r < NTOK; r += NGW) {
        f32x4 v[4]; float s = 0.f;
        if (r < NPROMPT) {
#pragma unroll
            for (int j = 0; j < 4; ++j) v[j] = *(const f32x4*)(R + (size_t)r * DM + j * 256 + lane * 4);
        } else {
            const int rs = r - NPROMPT;
#pragma unroll
            for (int j = 0; j < 4; ++j) { const int cc = j * 256 + lane * 4;
                if (xs) v[j] = *(const f32x4*)(xs + (size_t)rs * DM + cc) * ALPHA;
                else { const u32x2 w = *(const u32x2*)(X1 + (size_t)r * DM + cc); v[j] = (f32x4){bf_lo(w.x), bf_hi(w.x), bf_lo(w.y), bf_hi(w.y)} * ALPHA; }
                for (int k = 0; k < NS; ++k) v[j] += *(const f32x4*)(SL + ((size_t)k * NSAMPLE + rs) * DM + cc); }
        }
#pragma unroll
        for (int j = 0; j < 4; ++j) s += (v[j][0] + v[j][1]) + (v[j][2] + v[j][3]);
        const float mean = wave_sum(s) * (1.0f / DM); float q = 0.f;
#pragma unroll
        for (int j = 0; j < 4; ++j) { v[j] = v[j] - mean; q += (v[j][0] * v[j][0] + v[j][1] * v[j][1]) + (v[j][2] * v[j][2] + v[j][3] * v[j][3]); }
        const float rstd = 1.0f / sqrtf(wave_sum(q) * (1.0f / DM) + LN_EPS);
#pragma unroll
        for (int j = 0; j < 4; ++j) { const f32x4 y = v[j] * rstd * gv[j] + bv[j];
            if (OUT_F32) *(f32x4*)((float*)out + (size_t)r * DM + j * 256 + lane * 4) = y;
            else { u32x2 w; w.x = cvt_pk_bf16(y[0], y[1]); w.y = cvt_pk_bf16(y[2], y[3]); *(u32x2*)((bf16_t*)out + (size_t)r * DM + j * 256 + lane * 4) = w; } }
    }
}

__global__ void __launch_bounds__(512, 2) mega(Params p) {
    extern __shared__ __attribute__((aligned(16))) unsigned char shm_raw[];
    LAS unsigned char* lds = (LAS unsigned char*)shm_raw;
    const int G = gridDim.x, c = blockIdx.x;
    unsigned char* ws = p.ws;
    volatile LAS unsigned* xst = (volatile LAS unsigned*)(lds + 131072);
    if (threadIdx.x == 0) { xst[0] = 0u; xst[1] = 0u; }
    __syncthreads();
    const XcdBarrier xb = xcd_barrier_post((unsigned*)(ws + WS_BAR), xst);
    if (p.ph_hi > 64) cg::this_grid().sync();
#if MK_MULTI
#define PH_SYNC(k)
#else
#define PH_SYNC(k) do { if (p.ph_lo <= (k) && (k) + 1 < p.ph_hi) xcd_barrier(xb); } while (0)
#endif
#define PH_ON(k) (((PHMASK >> (k)) & 1) && p.ph_lo <= (k) && (k) < p.ph_hi)
#ifndef REPMASK
#define REPMASK 0
#endif
    if (PH_ON(0)) phase0(p, lds);
    PH_SYNC(0);
    if (PH_ON(1)) { pg8::StaticOrder S; S.init(NTOK, NZ, DM, G, c); pg8::Gemm g{(const bf16_t*)(ws + WS_XB), (const bf16_t*)(ws + WS_WIN), NTOK, NZ, DM};
        EpiZ E{(bf16_t*)(ws + WS_Z), (bf16_t*)(ws + WS_QKV), (bf16_t*)(ws + WS_KT)}; pg8::gemm_phase(lds, g, S, E); }
    PH_SYNC(1);
    if (PH_ON(2)) {
        for (int it = c; it < 256; it += G) { const int xcd = it & 7, idx = it >> 3; mlstm_prompt_item(p, lds, xcd * 4 + (idx >> 3), idx & 7); }
        for (int it = c; it < 512; it += G) mlstm_sample_item(p, lds, it);
        conv_items(p);
    }
    PH_SYNC(2);
    if (PH_ON(3)) { hn_items(p);
        pg8::StaticOrder S; S.init(NTOK, DM, DM, G, c); pg8::Gemm g{(const bf16_t*)(ws + WS_AC), (const bf16_t*)(ws + WS_WC), NTOK, DM, DM};
        EpiGate E{(bf16_t*)(ws + WS_XB), nullptr, (const bf16_t*)(ws + WS_Z), Z_GC, 0}; pg8::gemm_phase(lds, g, S, E); }
    PH_SYNC(3);
    if (PH_ON(4)) { pg8::StaticOrder S; S.init(NTOK, DM, DM, G, c); pg8::Gemm g{(const bf16_t*)(ws + WS_HN), (const bf16_t*)(ws + WS_WM), NTOK, DM, DM};
        EpiGate E{(bf16_t*)(ws + WS_AC), (const bf16_t*)(ws + WS_XB), (const bf16_t*)(ws + WS_Z), Z_GM, 1}; pg8::gemm_phase(lds, g, S, E); }
    PH_SYNC(4);
    if (PH_ON(5)) { pg8::SplitOrder S; S.init(DM, 4, G, c); pg8::Gemm g{(const bf16_t*)(ws + WS_AC), (const bf16_t*)(ws + WS_WO), NTOK, DM, DM};
        EpiResX E{(float*)(ws + WS_R), p.xp, p.xs, (float*)(ws + WS_KT)}; pg8::gemm_phase(lds, g, S, E); }
    PH_SYNC(5);
    if (PH_ON(6)) ln_rows<false>((const float*)(ws + WS_R), p.ln1g, p.ln1b, ws + WS_H, (const float*)(ws + WS_KT), 4, p.xs, nullptr);
    PH_SYNC(6);
    if (PH_ON(7)) { pg8::StaticOrder S; S.init(NTOK, DFF, DM, G, c); pg8::Gemm g{(const bf16_t*)(ws + WS_H), (const bf16_t*)(ws + WS_W1), NTOK, DFF, DM};
        EpiHid E{(bf16_t*)(ws + WS_HID)}; pg8::gemm_phase(lds, g, S, E); }
    PH_SYNC(7);
    if (PH_ON(8)) { pg8::SplitOrder S; S.init(DFF, 16, G, c); pg8::Gemm g{(const bf16_t*)(ws + WS_HID), (const bf16_t*)(ws + WS_W2), NTOK, DM, DFF};
        EpiResB E{(float*)(ws + WS_R), (const bf16_t*)(ws + WS_H), (float*)(ws + WS_KT)}; pg8::gemm_phase(lds, g, S, E); }
    PH_SYNC(8);
    if (PH_ON(9)) ln_rows<true>((const float*)(ws + WS_R), p.ln2g, p.ln2b, p.out + O_Y, (const float*)(ws + WS_KT), 16, nullptr, (const bf16_t*)(ws + WS_H));
#if MK_MULTI
    if (p.ph_lo == 11) { for (int it = c; it < 512; it += G) mlstm_sample_item(p, lds, it); }
    if (p.ph_lo == 12) conv_items(p);
    if (p.ph_lo == 10) { for (int it = c; it < 256; it += G) { const int xcd = it & 7, idx = it >> 3; mlstm_prompt_item(p, lds, xcd * 4 + (idx >> 3), idx & 7); } }
#endif
}

extern "C" void kernel_launch(void* const* d_in, const int* in_sizes, int n_in, void* d_out, int out_size, void* d_ws, size_t ws_size, hipStream_t stream) {
    static int grid = 0;
    if (grid == 0) {
        if (n_in != 19 || ws_size < WS_END) { fprintf(stderr, "kernel_launch: unexpected inputs (n_in %d, ws %zu, need %zu)\n", n_in, ws_size, (size_t)WS_END); grid = -1; return; }
        int dev = 0, cus = 0, per_cu = 0;
        hipGetDevice(&dev); hipDeviceGetAttribute(&cus, hipDeviceAttributeMultiprocessorCount, dev);
        hipFuncSetAttribute((const void*)mega, hipFuncAttributeMaxDynamicSharedMemorySize, LDS_BYTES);
        hipOccupancyMaxActiveBlocksPerMultiprocessor(&per_cu, (const void*)mega, 512, LDS_BYTES);
        if (per_cu < 1 || cus < 1) { fprintf(stderr, "kernel_launch: occupancy query says %d blocks/CU on %d CUs\n", per_cu, cus); grid = -1; return; }
        grid = cus;
    }
    if (grid < 0) return;
    Params p{};
    const float** f = (const float**)&p;
    for (int i = 0; i < 19; ++i) f[i] = (const float*)d_in[i];
    p.out = (float*)d_out; p.ws = (unsigned char*)d_ws;
#if MK_MULTI
    for (int ph = 0; ph < 10; ++ph) for (int rep = 0; rep < ((REPMASK >> ph) & 1) + 1; ++rep) { p.ph_lo = ph; p.ph_hi = ph + 1; hipLaunchKernelGGL(mega, dim3(grid), dim3(512), LDS_BYTES, stream, p); }
#ifdef EXTRA_PH
    { p.ph_lo = EXTRA_PH; p.ph_hi = EXTRA_PH + 1; hipLaunchKernelGGL(mega, dim3(grid), dim3(512), LDS_BYTES, stream, p); }
#endif
#else
    p.ph_lo = 0; p.ph_hi = 10;
    if (hipMemsetAsync((char*)d_ws + WS_BAR, 0, 16384, stream) != hipSuccess) { fprintf(stderr, "memset failed\n"); return; }
    void* args[] = {&p};
    hipError_t e = hipLaunchCooperativeKernel((const void*)mega, dim3(grid), dim3(512), args, LDS_BYTES, stream);
    if (e != hipSuccess) fprintf(stderr, "cooperative launch failed: %s (grid %d)\n", hipGetErrorString(e), grid);
#endif
}
```

```cpp
#include <hip/hip_runtime.h>
#include <hip/hip_cooperative_groups.h>
#include <cstdio>
namespace cg = cooperative_groups;

#ifndef PHMASK
#define PHMASK 1023
#endif
#ifndef MK_MULTI
#define MK_MULTI 0
#endif

#define LAS __attribute__((address_space(3)))
typedef unsigned short bf16_t;
typedef short bf16x8 __attribute__((ext_vector_type(8)));
typedef float f32x4 __attribute__((ext_vector_type(4)));
typedef float f32x2 __attribute__((ext_vector_type(2)));
typedef unsigned u32x4 __attribute__((ext_vector_type(4)));
typedef unsigned u32x2 __attribute__((ext_vector_type(2)));

constexpr int DM = 1024, NPROMPT = 8 * 2048, NSAMPLE = 128 * 4, NTOK = NPROMPT + NSAMPLE;
constexpr int SEQ = 2048, NH = 4, DH = 256, DFF = 4096, DIN = 9224, NZ = 9216, ZC = 5120;
constexpr float ALPHA = 1.189207115002721f;
constexpr float LN_EPS = 1e-5f;
constexpr int Z_BG = 0, Z_U = 1024, Z_O = 2048, Z_GC = 3072, Z_GM = 4096;
constexpr int HM_SAMPLE0 = 32 * 2048;
constexpr size_t O_Y = 0, O_CONVP = 17301504, O_CONVS = 17317888, O_CP = 17580032, O_CS = 19677184, O_NP = 53231616, O_NS = 53239808, O_MP = 53370880, O_MS = 53370912;
constexpr size_t SZ_ACT = (size_t)NTOK * DM * 2;
constexpr size_t WS_XB = 0;
constexpr size_t WS_WIN = WS_XB + SZ_ACT;
constexpr size_t WS_WC = WS_WIN + (size_t)NZ * DM * 2;
constexpr size_t WS_WM = WS_WC + (size_t)DM * DM * 2;
constexpr size_t WS_WO = WS_WM + (size_t)DM * DM * 2;
constexpr size_t WS_W1 = WS_WO + (size_t)DM * DM * 2;
constexpr size_t WS_W2 = WS_W1 + (size_t)DFF * DM * 2;
constexpr size_t WS_G = WS_W2 + (size_t)DFF * DM * 2;
constexpr size_t WS_Z = WS_G + (size_t)NTOK * 8 * 4;
constexpr size_t WS_HID = WS_Z;
constexpr size_t WS_R = WS_Z + (size_t)NTOK * DFF * 2;
constexpr size_t WS_QKV = WS_Z + (size_t)NTOK * ZC * 2;
constexpr size_t WS_KT = WS_QKV + 3 * SZ_ACT;
constexpr size_t WS_H = WS_KT + (size_t)32 * 256 * 2048 * 2;
constexpr size_t WS_AC = WS_H + SZ_ACT;
constexpr size_t WS_HN = WS_AC + SZ_ACT;
constexpr size_t WS_BAR = WS_HN + SZ_ACT;
constexpr size_t WS_END = WS_BAR + 16384;
constexpr int LDS_BYTES = 131072 + 16;

struct Params {
    const float *xp, *xs, *sconv, *sC, *sn, *sm, *w_in, *b_gate, *conv_w, *w_co, *mh_g, *w_mo, *w_o, *ln1g, *ln1b, *w_ff1, *w_ff2, *ln2g, *ln2b;
    float* out; unsigned char* ws; int ph_lo, ph_hi;
};

__device__ __forceinline__ unsigned cvt_pk_bf16(float lo, float hi) { unsigned r; asm volatile("v_cvt_pk_bf16_f32 %0, %1, %2" : "=v"(r) : "v"(lo), "v"(hi)); return r; }
__device__ __forceinline__ float bf_lo(unsigned w) { return __uint_as_float(w << 16); }
__device__ __forceinline__ float bf_hi(unsigned w) { return __uint_as_float(w & 0xffff0000u); }
__device__ __forceinline__ float bf2f(bf16_t b) { return __uint_as_float(((unsigned)b) << 16); }
__device__ __forceinline__ float sigmoidf_(float x) { return 1.0f / (1.0f + __expf(-x)); }
__device__ __forceinline__ float wave_sum(float v) {
#pragma unroll
    for (int o = 1; o < 64; o <<= 1) v += __shfl_xor(v, o);
    return v;
}
__device__ __forceinline__ const float* xrow(const Params& p, int r) { return r < NPROMPT ? p.xp + (size_t)r * DM : p.xs + (size_t)(r - NPROMPT) * DM; }
#define LDS_WAIT() asm volatile("s_waitcnt lgkmcnt(0)" ::: "memory")

#define XB_TMO      128
#define XB_XCNT(j)  (256  + 64 * (j))
#define XB_XSUB(j)  (1280 + 64 * (j))
#define XB_XGEN(j)  (2304 + 64 * (j))
#define XB_TOP      3328
#define XB_TOPGEN   3392
#define XCD_BAR_WORDS 3456
#define XB_SPIN_CAP (1u << 22)
__device__ __forceinline__ unsigned xb_ld(unsigned* p)              { return __hip_atomic_load(p, __ATOMIC_RELAXED, __HIP_MEMORY_SCOPE_AGENT); }
__device__ __forceinline__ unsigned xb_add(unsigned* p, unsigned v) { return __hip_atomic_fetch_add(p, v, __ATOMIC_RELAXED, __HIP_MEMORY_SCOPE_AGENT); }
__device__ __forceinline__ unsigned xb_xcc_id() { return (unsigned)__builtin_amdgcn_s_getreg((3 << 11) | 20) & 0xFu; }
#define XB_SPIN(cond, bar) do { unsigned _sp = 0; while (cond) { __builtin_amdgcn_s_sleep(1); \
    if ((++_sp & 255u) == 0u) { if (xb_ld(&(bar)[XB_TMO])) break; if (_sp > XB_SPIN_CAP) { atomicAdd(&(bar)[XB_TMO], 1u); break; } } } } while (0)
struct XcdBarrier { unsigned* bar; unsigned x; volatile LAS unsigned* st; };
__device__ __forceinline__ XcdBarrier xcd_barrier_post(unsigned* bar, volatile LAS unsigned* st) {
    XcdBarrier b; b.bar = bar; b.x = xb_xcc_id(); b.st = st;
    if (threadIdx.x == 0) (void)xb_add(&bar[XB_XCNT(b.x)], 1u);
    return b;
}
__device__ __forceinline__ void xcd_barrier_complete(unsigned* bar, unsigned x, unsigned& nloc, unsigned& nx) {
    const unsigned G = gridDim.x * gridDim.y * gridDim.z;
    unsigned sum, cnt, mine, sp = 0u;
    for (;;) {
        sum = 0u; cnt = 0u; mine = 0u;
#pragma unroll
        for (unsigned j = 0; j < 16; ++j) { const unsigned c = xb_ld(&bar[XB_XCNT(j)]); sum += c; cnt += (c > 0u) ? 1u : 0u; mine = (j == x) ? c : mine; }
        if (sum == G) break;
        __builtin_amdgcn_s_sleep(1);
        if ((++sp & 255u) == 0u) { if (xb_ld(&bar[XB_TMO])) break; if (sp > XB_SPIN_CAP) { atomicAdd(&bar[XB_TMO], 1u); break; } }
    }
    nloc = mine > 0u ? mine : 1u; nx = cnt > 0u ? cnt : 1u;
}
__device__ __forceinline__ void xcd_barrier(const XcdBarrier& b) {
    asm volatile("s_waitcnt vmcnt(0)" ::: "memory");
    __syncthreads();
    if (threadIdx.x == 0) {
        unsigned* bar = b.bar;
        __builtin_amdgcn_s_waitcnt(0);
        unsigned nloc = b.st[0], nx = b.st[1];
        if (nloc == 0u) { xcd_barrier_complete(bar, b.x, nloc, nx); b.st[0] = nloc; b.st[1] = nx; }
        const unsigned old = xb_add(&bar[XB_XSUB(b.x)], 1u);
        const unsigned gen = old / nloc;
        if (old + 1u == (gen + 1u) * nloc) {
            __builtin_amdgcn_fence(__ATOMIC_RELEASE, "agent");
            asm volatile("s_waitcnt vmcnt(0)" ::: "memory");
            const unsigned og = xb_add(&bar[XB_TOP], 1u);
            const unsigned tg = og / nx;
            if (og + 1u == (tg + 1u) * nx) xb_add(&bar[XB_TOPGEN], 1u);
            else XB_SPIN(xb_ld(&bar[XB_TOPGEN]) == tg, bar);
            __builtin_amdgcn_fence(__ATOMIC_ACQUIRE, "agent");
            xb_add(&bar[XB_XGEN(b.x)], 1u);
            asm volatile("s_waitcnt vmcnt(0)" ::: "memory");
        } else {
            XB_SPIN(xb_ld(&bar[XB_XGEN(b.x)]) == gen, bar);
            __builtin_amdgcn_fence(__ATOMIC_ACQUIRE, "agent");
            asm volatile("s_waitcnt vmcnt(0)" ::: "memory");
        }
    }
    __syncthreads();
}

namespace pg8 {
constexpr int BM = 256, BK = 64, HALF = 128, HTB = HALF * BK * 2, NXCD = 8, WGM = 8;
__host__ __device__ __forceinline__ int lds_byte(int r, int c) { const int st = (r >> 4) * 2 + (c >> 5), rr = r & 15, cc = c & 31, ob = rr * 64 + cc * 2; return st * 1024 + (ob ^ (((ob >> 9) & 1) << 5)); }
__host__ __device__ __forceinline__ void stage_rc(int b, int& R, int& C) { const int st = b / 1024, sb = b % 1024, swz = sb ^ (((sb >> 9) & 1) << 5); R = (st >> 1) * 16 + swz / 64; C = (st & 1) * 32 + (swz % 64) / 2; }
__host__ __device__ __forceinline__ int perm32(int rho) { const int n = rho >> 4, i = rho & 15; return 8 * (i >> 2) + 4 * n + (i & 3); }
struct Unit { int pm, pn, k0, nt, ks; };
struct Gemm { const bf16_t* A; const bf16_t* Bt; int M, N, K; };
struct StaticOrder {
    int nM, nN, nwg, G, c, kt;
    __device__ void init(int M, int N, int K, int G_, int c_) { nM = M / BM; nN = N / BM; nwg = nM * nN; G = G_; c = c_; kt = K / BK; }
    __device__ bool next(int i, Unit& u) const {
        const long L = (long)i * G + c; if (L >= nwg) return false;
        int wgid = (int)L; { const int q = nwg / NXCD, r = nwg % NXCD, xcd = wgid % NXCD, off = wgid / NXCD; wgid = (xcd < r ? xcd * (q + 1) : r * (q + 1) + (xcd - r) * q) + off; }
        const int nig = WGM * nN, gid = wgid / nig, fm = gid * WGM, gsz = (nM - fm) < WGM ? (nM - fm) : WGM;
        u.pm = fm + ((wgid % nig) % gsz); u.pn = (wgid % nig) / gsz; u.k0 = 0; u.nt = kt; u.ks = -1; return true;
    }
};
struct SplitOrder {
    StaticOrder so; int NS, ntk;
    __device__ void init(int K, int NS_, int G_, int c_) { so.init(NPROMPT, DM, K, G_, c_); NS = NS_; ntk = K / (BK * NS_); }
    __device__ bool next(int i, Unit& u) const {
        const long L = (long)i * so.G + so.c;
        if (L < so.nwg) return so.next(i, u);
        const int e = (int)(L - so.nwg); if (e >= 8 * NS) return false;
        const int tile = e / NS, ks = e % NS; u.pm = 64 + (tile >> 2); u.pn = tile & 3; u.k0 = ks * ntk * BK; u.nt = ntk; u.ks = ks; return true;
    }
};

template <class Epi, class Sched>
__device__ __forceinline__ void gemm_phase(LAS unsigned char* lds, const Gemm g, const Sched& S, const Epi& E) {
    const int tid = threadIdx.x, wid = __builtin_amdgcn_readfirstlane(tid >> 6), lane = tid & 63, wr = wid >> 2, wc = wid & 3, fr = lane & 15, fq = lane >> 4;
    const int K = g.K;
    unsigned voffA[2], voffB[2];
#pragma unroll
    for (int i = 0; i < 2; ++i) { int R, C; stage_rc(tid * 16 + i * 8192, R, C); const int Rb = (R & ~31) + perm32(R & 31);
        voffA[i] = (unsigned)(R * K + C) * 2u; voffB[i] = (unsigned)(Rb * K + C) * 2u; }
    const size_t kstep = (size_t)(BK * 2);
    const size_t hstep = (size_t)HALF * K * 2;
    const size_t tstep = 2 * hstep;
    const unsigned ldsw = (unsigned)wid * 1024u;
    const int aoff = lds_byte(wr * 64 + fr, fq * 8), boff = lds_byte(wc * 32 + fr, fq * 8);
#define PG8_SA(b, h) (((b) * 2 + (h)) * HTB)
#define PG8_SB(b, h) ((4 + (b) * 2 + (h)) * HTB)
#define PG8_STAGE(bufoff, gbase, voff) do { _Pragma("unroll") for (int _i = 0; _i < 2; ++_i) \
        __builtin_amdgcn_global_load_lds((const unsigned*)((const char*)(gbase) + (voff)[_i]), (LAS unsigned*)(lds + (bufoff) + ldsw + _i * 8192), 16, 0, 0); } while (0)
#define PG8_LDA(dst, b, h) do { _Pragma("unroll") for (int m = 0; m < 4; ++m) _Pragma("unroll") for (int k = 0; k < 2; ++k) dst[m][k] = *(const LAS bf16x8*)(lds + PG8_SA(b, h) + aoff + m * 2048 + k * 1024); } while (0)
#define PG8_LDB(dst, b, h) do { _Pragma("unroll") for (int n = 0; n < 2; ++n) _Pragma("unroll") for (int k = 0; k < 2; ++k) dst[n][k] = *(const LAS bf16x8*)(lds + PG8_SB(b, h) + boff + n * 2048 + k * 1024); } while (0)
#define PG8_MMA(ai, bj, At, Bt) do { __builtin_amdgcn_s_setprio(1); _Pragma("unroll") for (int m = 0; m < 4; ++m) _Pragma("unroll") for (int n = 0; n < 2; ++n) _Pragma("unroll") for (int k = 0; k < 2; ++k) \
        acc[ai][bj][m][n] = __builtin_amdgcn_mfma_f32_16x16x32_bf16(Bt[n][k], At[m][k], acc[ai][bj][m][n], 0, 0, 0); __builtin_amdgcn_s_setprio(0); } while (0)
#define PG8_WAIT_V(n) asm volatile("s_waitcnt vmcnt(" #n ")" ::: "memory")
#define PG8_WAIT_L(n) asm volatile("s_waitcnt lgkmcnt(" #n ")" ::: "memory")
#define PG8_BAR __builtin_amdgcn_s_barrier()
#define PG8_SCHED __builtin_amdgcn_sched_barrier(0)
    Unit cur, nxt; int ui = 0;
    if (!S.next(0, cur)) return;
    f32x4 acc[2][2][4][2];
#pragma unroll
    for (int a = 0; a < 2; ++a)
#pragma unroll
        for (int b = 0; b < 2; ++b)
#pragma unroll
            for (int m = 0; m < 4; ++m)
#pragma unroll
                for (int n = 0; n < 2; ++n) acc[a][b][m][n] = (f32x4){0.f, 0.f, 0.f, 0.f};
    bf16x8 At[4][2], B0[2][2], B1[2][2];
    const char* cA = (const char*)g.A + (size_t)cur.pm * tstep + (size_t)cur.k0 * 2; const char* cB = (const char*)g.Bt + (size_t)cur.pn * tstep + (size_t)cur.k0 * 2;
    PG8_STAGE(PG8_SB(0, 0), cB, voffB); PG8_STAGE(PG8_SA(0, 0), cA, voffA); PG8_STAGE(PG8_SB(0, 1), cB + hstep, voffB); PG8_STAGE(PG8_SA(0, 1), cA + hstep, voffA);
    if (wr == 1) PG8_BAR;
    PG8_WAIT_V(4); PG8_BAR;
    PG8_STAGE(PG8_SB(1, 0), cB + kstep, voffB); PG8_STAGE(PG8_SA(1, 0), cA + kstep, voffA); PG8_STAGE(PG8_SB(1, 1), cB + hstep + kstep, voffB);
    PG8_WAIT_V(6); PG8_BAR;
    for (;;) {
        const bool has_next = S.next(ui + 1, nxt);
        const char* nA = has_next ? (const char*)g.A + (size_t)nxt.pm * tstep + (size_t)nxt.k0 * 2 : cA; const char* nB = has_next ? (const char*)g.Bt + (size_t)nxt.pn * tstep + (size_t)nxt.k0 * 2 : cB;
        const int nt = cur.nt;
        for (int t = 0; t < nt; t += 2) {
            const bool last = (t == nt - 2);
            const char* a1 = cA + (size_t)(t + 1) * kstep;
            const char* a2 = last ? nA : cA + (size_t)(t + 2) * kstep; const char* b2 = last ? nB : cB + (size_t)(t + 2) * kstep;
            const char* a3 = a2 + kstep; const char* b3 = b2 + kstep;
            PG8_LDB(B0, 0, 0); PG8_SCHED; PG8_LDA(At, 0, 0); PG8_STAGE(PG8_SA(1, 1), a1 + hstep, voffA);
            PG8_WAIT_L(8); PG8_BAR; PG8_WAIT_L(0); PG8_MMA(0, 0, At, B0); PG8_BAR; PG8_SCHED;
            PG8_LDB(B1, 0, 1); PG8_STAGE(PG8_SB(0, 0), b2, voffB);
            PG8_BAR; PG8_WAIT_L(0); PG8_MMA(0, 1, At, B1); PG8_BAR;
            PG8_LDA(At, 0, 1); PG8_STAGE(PG8_SA(0, 0), a2, voffA);
            PG8_BAR; PG8_WAIT_L(0); PG8_MMA(1, 0, At, B0); PG8_BAR; PG8_SCHED;
            PG8_STAGE(PG8_SB(0, 1), b2 + hstep, voffB);
            PG8_WAIT_V(6); PG8_BAR; PG8_MMA(1, 1, At, B1); PG8_BAR;
            PG8_LDB(B0, 1, 0); PG8_SCHED; PG8_LDA(At, 1, 0); PG8_STAGE(PG8_SA(0, 1), a2 + hstep, voffA);
            PG8_WAIT_L(8); PG8_BAR; PG8_WAIT_L(0); PG8_MMA(0, 0, At, B0); PG8_BAR; PG8_SCHED;
            PG8_LDB(B1, 1, 1); PG8_STAGE(PG8_SB(1, 0), b3, voffB);
            PG8_BAR; PG8_WAIT_L(0); PG8_MMA(0, 1, At, B1); PG8_BAR;
            PG8_LDA(At, 1, 1); PG8_STAGE(PG8_SA(1, 0), a3, voffA);
            PG8_BAR; PG8_WAIT_L(0); PG8_MMA(1, 0, At, B0); PG8_BAR; PG8_SCHED;
            PG8_STAGE(PG8_SB(1, 1), b3 + hstep, voffB);
            PG8_WAIT_V(6); PG8_BAR; PG8_MMA(1, 1, At, B1); PG8_BAR;
        }
        E(acc, cur, wr, wc, fr, fq);
        if (!has_next) break;
#pragma unroll
        for (int a = 0; a < 2; ++a)
#pragma unroll
            for (int b = 0; b < 2; ++b)
#pragma unroll
                for (int m = 0; m < 4; ++m)
#pragma unroll
                    for (int n = 0; n < 2; ++n) acc[a][b][m][n] = (f32x4){0.f, 0.f, 0.f, 0.f};
        cur = nxt; cA = nA; cB = nB; ++ui;
    }
    PG8_WAIT_V(0);
    if (wr == 0) PG8_BAR;
    PG8_BAR;
#undef PG8_SA
#undef PG8_SB
#undef PG8_STAGE
#undef PG8_LDA
#undef PG8_LDB
#undef PG8_MMA
#undef PG8_WAIT_V
#undef PG8_WAIT_L
#undef PG8_BAR
#undef PG8_SCHED
}
}
using pg8::Unit;

#define EPI_LOOP_BEGIN \
    _Pragma("unroll") for (int ai = 0; ai < 2; ++ai) _Pragma("unroll") for (int m = 0; m < 4; ++m) { const int row = u.pm * 256 + ai * 128 + wr * 64 + m * 16 + fr; \
    _Pragma("unroll") for (int bj = 0; bj < 2; ++bj) { const int lc = bj * 128 + wc * 32 + 8 * fq; const f32x4 v0 = acc[ai][bj][m][0], v1 = acc[ai][bj][m][1];
#define EPI_LOOP_END } }

struct EpiZ {
    bf16_t* Z; bf16_t* QKV; bf16_t* KT;
    __device__ __forceinline__ void operator()(const f32x4 (&acc)[2][2][4][2], const Unit& u, int wr, int wc, int fr, int fq) const {
        const int pn = u.pn;
        if (pn >= 4 && pn < 12) {
#pragma unroll
            for (int ai = 0; ai < 2; ++ai)
#pragma unroll
                for (int m = 0; m < 4; ++m) { const int row = u.pm * 256 + ai * 128 + wr * 64 + m * 16 + fr;
                    const f32x4 a0 = acc[ai][0][m][0] * acc[ai][1][m][0], a1 = acc[ai][0][m][1] * acc[ai][1][m][1];
                    u32x4 w; w.x = cvt_pk_bf16(a0[0], a0[1]); w.y = cvt_pk_bf16(a0[2], a0[3]); w.z = cvt_pk_bf16(a1[0], a1[1]); w.w = cvt_pk_bf16(a1[2], a1[3]);
                    *(u32x4*)(Z + (size_t)row * ZC + Z_U + (pn - 4) * 128 + wc * 32 + 8 * fq) = w; }
            return;
        }
        if (pn >= 12 && pn < 24) {
            const int grp = (pn - 12) >> 2, hh = (pn - 12) & 3;
            bf16_t* dst = QKV + (size_t)grp * NTOK * DM;
            EPI_LOOP_BEGIN
                const size_t rr = row < NPROMPT ? (size_t)((row >> 11) * 4 + hh) * SEQ + (row & 2047) : (size_t)HM_SAMPLE0 + (size_t)(((row - NPROMPT) >> 2) * 4 + hh) * 4 + ((row - NPROMPT) & 3);
                u32x4 w; w.x = cvt_pk_bf16(v0[0], v0[1]); w.y = cvt_pk_bf16(v0[2], v0[3]); w.z = cvt_pk_bf16(v1[0], v1[1]); w.w = cvt_pk_bf16(v1[2], v1[3]);
                *(u32x4*)(dst + rr * 256 + lc) = w;
            EPI_LOOP_END
            return;
        }
        const int zc0 = pn < 4 ? pn * 256 : Z_O + (pn - 24) * 256;
        const bool sg = pn >= 24;
        EPI_LOOP_BEGIN
            f32x4 a0 = v0, a1 = v1;
            if (sg) {
#pragma unroll
                for (int j = 0; j < 4; ++j) { a0[j] = sigmoidf_(a0[j]); a1[j] = sigmoidf_(a1[j]); }
            }
            u32x4 w; w.x = cvt_pk_bf16(a0[0], a0[1]); w.y = cvt_pk_bf16(a0[2], a0[3]); w.z = cvt_pk_bf16(a1[0], a1[1]); w.w = cvt_pk_bf16(a1[2], a1[3]);
            *(u32x4*)(Z + (size_t)row * ZC + zc0 + lc) = w;
        EPI_LOOP_END
    }
};
struct EpiGate {
    bf16_t* O; const bf16_t* T; const bf16_t* Z; int gcol; int add;
    __device__ __forceinline__ void operator()(const f32x4 (&acc)[2][2][4][2], const Unit& u, int wr, int wc, int fr, int fq) const {
        EPI_LOOP_BEGIN
            const int col = u.pn * 256 + lc;
            const u32x4 gw = *(const u32x4*)(Z + (size_t)row * ZC + gcol + col);
            f32x4 a0, a1;
            a0[0] = bf_lo(gw.x) * v0[0]; a0[1] = bf_hi(gw.x) * v0[1]; a0[2] = bf_lo(gw.y) * v0[2]; a0[3] = bf_hi(gw.y) * v0[3];
            a1[0] = bf_lo(gw.z) * v1[0]; a1[1] = bf_hi(gw.z) * v1[1]; a1[2] = bf_lo(gw.w) * v1[2]; a1[3] = bf_hi(gw.w) * v1[3];
            if (add) { const u32x4 tw = *(const u32x4*)(T + (size_t)row * DM + col);
                a0[0] += bf_lo(tw.x); a0[1] += bf_hi(tw.x); a0[2] += bf_lo(tw.y); a0[3] += bf_hi(tw.y); a1[0] += bf_lo(tw.z); a1[1] += bf_hi(tw.z); a1[2] += bf_lo(tw.w); a1[3] += bf_hi(tw.w); }
            u32x4 w; w.x = cvt_pk_bf16(a0[0], a0[1]); w.y = cvt_pk_bf16(a0[2], a0[3]); w.z = cvt_pk_bf16(a1[0], a1[1]); w.w = cvt_pk_bf16(a1[2], a1[3]);
            *(u32x4*)(O + (size_t)row * DM + col) = w;
        EPI_LOOP_END
    }
};
#define EPI_SLAB_PATH \
        if (u.ks >= 0) { float* sl = SL + (size_t)u.ks * NSAMPLE * DM; \
            EPI_LOOP_BEGIN \
                float* dp = sl + (size_t)(row - NPROMPT) * DM + u.pn * 256 + lc; *(f32x4*)dp = v0; *(f32x4*)(dp + 4) = v1; \
            EPI_LOOP_END \
            return; }
struct EpiResX {
    bf16_t* R; const float* xp; const float* xs; float* SL;
    __device__ __forceinline__ void operator()(const f32x4 (&acc)[2][2][4][2], const Unit& u, int wr, int wc, int fr, int fq) const {
        EPI_SLAB_PATH
        EPI_LOOP_BEGIN
            const int col = u.pn * 256 + lc;
            const float* xr = (row < NPROMPT ? xp + (size_t)row * DM : xs + (size_t)(row - NPROMPT) * DM) + col;
            const f32x4 x0 = *(const f32x4*)xr, x1 = *(const f32x4*)(xr + 4);
            const f32x4 a0 = x0 * ALPHA + v0, a1 = x1 * ALPHA + v1;
            u32x4 w; w.x = cvt_pk_bf16(a0[0], a0[1]); w.y = cvt_pk_bf16(a0[2], a0[3]); w.z = cvt_pk_bf16(a1[0], a1[1]); w.w = cvt_pk_bf16(a1[2], a1[3]);
            *(u32x4*)(R + (size_t)row * DM + col) = w;
        EPI_LOOP_END
    }
};
struct EpiResB {
    bf16_t* R; const bf16_t* X1; float* SL;
    __device__ __forceinline__ void operator()(const f32x4 (&acc)[2][2][4][2], const Unit& u, int wr, int wc, int fr, int fq) const {
        EPI_SLAB_PATH
        EPI_LOOP_BEGIN
            const int col = u.pn * 256 + lc;
            const u32x4 xw = *(const u32x4*)(X1 + (size_t)row * DM + col);
            f32x4 a0, a1;
            a0[0] = bf_lo(xw.x) * ALPHA + v0[0]; a0[1] = bf_hi(xw.x) * ALPHA + v0[1]; a0[2] = bf_lo(xw.y) * ALPHA + v0[2]; a0[3] = bf_hi(xw.y) * ALPHA + v0[3];
            a1[0] = bf_lo(xw.z) * ALPHA + v1[0]; a1[1] = bf_hi(xw.z) * ALPHA + v1[1]; a1[2] = bf_lo(xw.w) * ALPHA + v1[2]; a1[3] = bf_hi(xw.w) * ALPHA + v1[3];
            u32x4 w; w.x = cvt_pk_bf16(a0[0], a0[1]); w.y = cvt_pk_bf16(a0[2], a0[3]); w.z = cvt_pk_bf16(a1[0], a1[1]); w.w = cvt_pk_bf16(a1[2], a1[3]);
            *(u32x4*)(R + (size_t)row * DM + col) = w;
        EPI_LOOP_END
    }
};
struct EpiHid {
    bf16_t* Hd;
    __device__ __forceinline__ void operator()(const f32x4 (&acc)[2][2][4][2], const Unit& u, int wr, int wc, int fr, int fq) const {
        EPI_LOOP_BEGIN
            const int col = u.pn * 256 + lc;
            f32x4 a0, a1;
#pragma unroll
            for (int j = 0; j < 4; ++j) { const float r0 = fmaxf(v0[j], 0.f), r1 = fmaxf(v1[j], 0.f); a0[j] = r0 * r0; a1[j] = r1 * r1; }
            u32x4 w; w.x = cvt_pk_bf16(a0[0], a0[1]); w.y = cvt_pk_bf16(a0[2], a0[3]); w.z = cvt_pk_bf16(a1[0], a1[1]); w.w = cvt_pk_bf16(a1[2], a1[3]);
            *(u32x4*)(Hd + (size_t)row * DFF + col) = w;
        EPI_LOOP_END
    }
};

__device__ __forceinline__ void transpose_item(const float* W, int ldw, int K, int src0, bf16_t* WT, int dst0, int kb, float scale, LAS float* scr, int lane) {
    const int k0 = kb * 64;
#pragma unroll 8
    for (int i = 0; i < 32; ++i) { const int kk = 2 * i + (lane >> 5); scr[kk * 33 + (lane & 31)] = W[(size_t)(k0 + kk) * ldw + src0 + (lane & 31)]; }
    LDS_WAIT();
    const int c = lane & 7;
#pragma unroll
    for (int j = 0; j < 4; ++j) { const int n = (lane >> 3) + 8 * j; const LAS float* s = scr + (8 * c) * 33 + n;
        u32x4 o; o.x = cvt_pk_bf16(s[0 * 33] * scale, s[1 * 33] * scale); o.y = cvt_pk_bf16(s[2 * 33] * scale, s[3 * 33] * scale);
        o.z = cvt_pk_bf16(s[4 * 33] * scale, s[5 * 33] * scale); o.w = cvt_pk_bf16(s[6 * 33] * scale, s[7 * 33] * scale);
        *(u32x4*)(WT + (size_t)(dst0 + n) * K + k0 + 8 * c) = o; }
    LDS_WAIT();
}
__device__ __forceinline__ void phase0(const Params& p, LAS unsigned char* lds) {
    const int tid = threadIdx.x, wid = tid >> 6, lane = tid & 63;
    const int gw = blockIdx.x * 8 + wid, NGW = gridDim.x * 8;
    LAS float* scr = (LAS float*)(lds + wid * 8704);
    LAS float* wg = (LAS float*)(lds + 73728);
    for (int e = tid; e < 2048; e += 512) { const int k = e >> 1, hf = e & 1; *(LAS f32x4*)(wg + k * 8 + hf * 4) = *(const f32x4*)(p.w_in + (size_t)k * DIN + 7168 + hf * 4); }
    __syncthreads();
    bf16_t* WIN = (bf16_t*)(p.ws + WS_WIN);
    constexpr int I_IN = 72 * 4 * 16, I_SQ = 32 * 16, I_F1 = 128 * 16, I_F2 = 32 * 64;
    constexpr int NITEMS = I_IN + 3 * I_SQ + I_F1 + I_F2;
    for (int it = gw; it < NITEMS; it += NGW) {
        int r = it;
        if (r < I_IN) { const int kb = r & 15, nb = r >> 4, g = nb >> 2, sub = nb & 3;
            int src; if (g < 8) src = g * 128; else if (g < 24) { const int pr = (g - 8) >> 1, hf = (g - 8) & 1; src = (hf ? 2048 : 1024) + pr * 128; } else if (g < 56) src = 3072 + (g - 24) * 128; else src = 7176 + (g - 56) * 128;
            const float sc = (g >= 32 && g < 40) ? 0.0625f : 1.0f;
            transpose_item(p.w_in, DIN, DM, src + sub * 32, WIN, g * 128 + sub * 32, kb, sc, scr, lane); continue; }
        r -= I_IN;
        if (r < 3 * I_SQ) { const int w = r / I_SQ, q = r % I_SQ, kb = q & 15, nb = q >> 4;
            const float* W = w == 0 ? p.w_co : (w == 1 ? p.w_mo : p.w_o); bf16_t* WT = (bf16_t*)(p.ws + (w == 0 ? WS_WC : (w == 1 ? WS_WM : WS_WO)));
            transpose_item(W, DM, DM, nb * 32, WT, nb * 32, kb, 1.0f, scr, lane); continue; }
        r -= 3 * I_SQ;
        if (r < I_F1) { const int kb = r & 15, nb = r >> 4; transpose_item(p.w_ff1, DFF, DM, nb * 32, (bf16_t*)(p.ws + WS_W1), nb * 32, kb, 1.0f, scr, lane); continue; }
        r -= I_F1;
        { const int kb = r & 63, nb = r >> 6; transpose_item(p.w_ff2, DM, DFF, nb * 32, (bf16_t*)(p.ws + WS_W2), nb * 32, kb, 1.0f, scr, lane); }
    }
    bf16_t* XB = (bf16_t*)(p.ws + WS_XB); float* G = (float*)(p.ws + WS_G);
    for (int r = gw; r < NTOK; r += NGW) {
        const float* xr = xrow(p, r);
        float g8[8];
#pragma unroll
        for (int j = 0; j < 8; ++j) g8[j] = 0.f;
#pragma unroll
        for (int j = 0; j < 4; ++j) { const int k = j * 256 + lane * 4; const f32x4 v = *(const f32x4*)(xr + k);
            u32x2 w; w.x = cvt_pk_bf16(v[0], v[1]); w.y = cvt_pk_bf16(v[2], v[3]); *(u32x2*)(XB + (size_t)r * DM + k) = w;
#pragma unroll
            for (int e = 0; e < 4; ++e) { const f32x4 wa = *(const LAS f32x4*)(wg + (k + e) * 8), wb = *(const LAS f32x4*)(wg + (k + e) * 8 + 4);
#pragma unroll
                for (int q = 0; q < 4; ++q) { g8[q] += v[e] * wa[q]; g8[4 + q] += v[e] * wb[q]; } } }
#pragma unroll
        for (int j = 0; j < 8; ++j) g8[j] = wave_sum(g8[j]);
        if (lane < 4) { G[(size_t)r * 8 + lane] = g8[0] * (lane == 0) + g8[1] * (lane == 1) + g8[2] * (lane == 2) + g8[3] * (lane == 3) + p.b_gate[lane]; }
        else if (lane < 8) { const float f = g8[4] * (lane == 4) + g8[5] * (lane == 5) + g8[6] * (lane == 6) + g8[7] * (lane == 7) + p.b_gate[lane];
            G[(size_t)r * 8 + lane] = fminf(f, 0.f) - log1pf(__expf(-fabsf(f))); }
    }
    __syncthreads();
}

constexpr int KS_LD = 264, VT_LD = 136;
constexpr int L_KSH = 0, L_CT = 128 * KS_LD * 2, L_VT = L_CT + 48 * KS_LD * 2, L_VW = L_VT + 48 * VT_LD * 2, L_SC = L_VW + 48 * VT_LD * 2;
__device__ __forceinline__ void mlstm_prompt_item(const Params& p, LAS unsigned char* lds, int bh, int vs) {
    const int tid = threadIdx.x, wid = __builtin_amdgcn_readfirstlane(tid >> 6), lane = tid & 63, li = lane & 15, kg = lane >> 4;
    const int b = bh >> 2, h = bh & 3, j0 = vs * 32;
    LAS bf16_t* Ksh = (LAS bf16_t*)(lds + L_KSH); LAS bf16_t* CTsh = (LAS bf16_t*)(lds + L_CT); LAS bf16_t* VTsh = (LAS bf16_t*)(lds + L_VT); LAS bf16_t* VWsh = (LAS bf16_t*)(lds + L_VW);
    LAS float* sA = (LAS float*)(lds + L_SC); LAS float* sG = sA + 128; LAS float* sB = sG + 128;
    const bf16_t* QH = (const bf16_t*)(p.ws + WS_QKV) + (size_t)bh * SEQ * 256; const bf16_t* KH = QH + (size_t)NTOK * DM; const bf16_t* VH = KH + (size_t)NTOK * DM;
    const float* G = (const float*)(p.ws + WS_G) + (size_t)b * SEQ * 8; bf16_t* H = (bf16_t*)(p.ws + WS_H);
    for (int e = tid; e < 48 * KS_LD / 2; e += 512) ((LAS unsigned*)CTsh)[e] = 0u;
    for (int e = tid; e < 16 * VT_LD; e += 512) { const int rr = e / VT_LD; VTsh[32 * VT_LD + e] = rr == 0 ? (bf16_t)0x3F80 : (bf16_t)0; VWsh[32 * VT_LD + e] = 0; }
    f32x4 Cacc[2][3];
#pragma unroll
    for (int db = 0; db < 2; ++db)
#pragma unroll
        for (int jb = 0; jb < 3; ++jb) Cacc[db][jb] = (f32x4){0.f, 0.f, 0.f, 0.f};
    float m_prev = 0.f;
    const int vs_s = tid >> 2, vs_q = tid & 3;
    u32x4 kp[8]; u32x4 vp; bf16x8 qf[8]; float gi0 = 0.f, gf0 = 0.f, gi1 = 0.f, gf1 = 0.f;
#pragma unroll
    for (int i = 0; i < 8; ++i) kp[i] = *(const u32x4*)(KH + (size_t)(i * 512 + tid) * 8);
    vp = *(const u32x4*)(VH + (size_t)vs_s * 256 + j0 + vs_q * 8);
#pragma unroll
    for (int kk = 0; kk < 8; ++kk) qf[kk] = *(const bf16x8*)(QH + (size_t)(16 * wid + li) * 256 + kk * 32 + kg * 8);
    if (wid == 0) { gi0 = G[(size_t)lane * 8 + h]; gf0 = G[(size_t)lane * 8 + 4 + h]; gi1 = G[(size_t)(64 + lane) * 8 + h]; gf1 = G[(size_t)(64 + lane) * 8 + 4 + h]; }
    for (int c = 0; c < 16; ++c) {
        const int t0 = c * 128, tn = (c < 15 ? c + 1 : c) * 128;
        if (wid == 0) {
            float b0 = gf0, b1 = gf1;
#pragma unroll
            for (int o = 1; o < 64; o <<= 1) { const float x0 = __shfl_up(b0, o), x1 = __shfl_up(b1, o); if (lane >= o) { b0 += x0; b1 += x1; } }
            b1 += __shfl(b0, 63);
            const float a0 = gi0 - b0, a1 = gi1 - b1;
            float p0 = a0, p1 = a1;
#pragma unroll
            for (int o = 1; o < 64; o <<= 1) { const float x0 = __shfl_up(p0, o), x1 = __shfl_up(p1, o); if (lane >= o) { p0 = fmaxf(p0, x0); p1 = fmaxf(p1, x1); } }
            p1 = fmaxf(p1, __shfl(p0, 63));
            sA[lane] = a0; sA[64 + lane] = a1; sG[lane] = fmaxf(m_prev, p0); sG[64 + lane] = fmaxf(m_prev, p1); sB[lane] = b0; sB[64 + lane] = b1;
            gi0 = G[(size_t)(tn + lane) * 8 + h]; gf0 = G[(size_t)(tn + lane) * 8 + 4 + h]; gi1 = G[(size_t)(tn + 64 + lane) * 8 + h]; gf1 = G[(size_t)(tn + 64 + lane) * 8 + 4 + h];
        }
        __syncthreads();
        const float g_last = sG[127], b_last = sB[127];
#pragma unroll
        for (int i = 0; i < 8; ++i) { const int pc = i * 512 + tid, row = pc >> 5, c8 = pc & 31; *(LAS u32x4*)(Ksh + row * KS_LD + c8 * 8) = kp[i]; }
        {
            const float wsv = __expf(sA[vs_s] - g_last);
            const unsigned vw[4] = {vp.x, vp.y, vp.z, vp.w};
#pragma unroll
            for (int e = 0; e < 4; ++e) { const int j = vs_q * 8 + 2 * e; const float lo = bf_lo(vw[e]), hi = bf_hi(vw[e]);
                VTsh[j * VT_LD + vs_s] = (bf16_t)(vw[e] & 0xffff); VTsh[(j + 1) * VT_LD + vs_s] = (bf16_t)(vw[e] >> 16);
                const unsigned sw = cvt_pk_bf16(lo * wsv, hi * wsv);
                VWsh[j * VT_LD + vs_s] = (bf16_t)(sw & 0xffff); VWsh[(j + 1) * VT_LD + vs_s] = (bf16_t)(sw >> 16); }
            if (vs_q == 0) VWsh[32 * VT_LD + vs_s] = (bf16_t)(cvt_pk_bf16(wsv, 0.f) & 0xffff);
        }
#pragma unroll
        for (int i = 0; i < 8; ++i) kp[i] = *(const u32x4*)(KH + (size_t)tn * 256 + (size_t)(i * 512 + tid) * 8);
        vp = *(const u32x4*)(VH + (size_t)(tn + vs_s) * 256 + j0 + vs_q * 8);
        __syncthreads();
        {
            const int t_loc = 16 * wid + li;
            const float g_t = sG[t_loc], b_t = sB[t_loc];
            f32x4 ST[8];
#pragma unroll
            for (int sb = 0; sb < 8; ++sb) ST[sb] = (f32x4){0.f, 0.f, 0.f, 0.f};
#pragma unroll
            for (int kk = 0; kk < 8; ++kk) {
#pragma unroll
                for (int hf = 0; hf < 2; ++hf) {
                    bf16x8 kf[4];
#pragma unroll
                    for (int sb = 0; sb < 4; ++sb) kf[sb] = *(const LAS bf16x8*)(Ksh + ((hf * 4 + sb) * 16 + li) * KS_LD + kk * 32 + kg * 8);
#pragma unroll
                    for (int sb = 0; sb < 4; ++sb) ST[hf * 4 + sb] = __builtin_amdgcn_mfma_f32_16x16x32_bf16(kf[sb], qf[kk], ST[hf * 4 + sb], 0, 0, 0);
                }
            }
#pragma unroll
            for (int sb = 0; sb < 8; ++sb) { const f32x4 av = *(const LAS f32x4*)(sA + sb * 16 + kg * 4);
#pragma unroll
                for (int r = 0; r < 4; ++r) { const float wgt = __expf(av[r] - g_t); const bool ok = (sb * 16 + kg * 4 + r) <= t_loc; ST[sb][r] = ok ? ST[sb][r] * wgt : 0.f; } }
            f32x4 nt[3], it[3];
#pragma unroll
            for (int jb = 0; jb < 3; ++jb) { nt[jb] = (f32x4){0.f, 0.f, 0.f, 0.f}; it[jb] = (f32x4){0.f, 0.f, 0.f, 0.f}; }
#pragma unroll
            for (int k2 = 0; k2 < 4; ++k2) {
                u32x4 pw; pw.x = cvt_pk_bf16(ST[2 * k2][0], ST[2 * k2][1]); pw.y = cvt_pk_bf16(ST[2 * k2][2], ST[2 * k2][3]);
                pw.z = cvt_pk_bf16(ST[2 * k2 + 1][0], ST[2 * k2 + 1][1]); pw.w = cvt_pk_bf16(ST[2 * k2 + 1][2], ST[2 * k2 + 1][3]);
                bf16x8 pf; __builtin_memcpy(&pf, &pw, 16);
#pragma unroll
                for (int jb = 0; jb < 3; ++jb) { const LAS bf16_t* vr = VTsh + (jb * 16 + li) * VT_LD + k2 * 32 + kg * 4;
                    u32x4 vw4; const u32x2 lo = *(const LAS u32x2*)vr, hi = *(const LAS u32x2*)(vr + 16); vw4.x = lo.x; vw4.y = lo.y; vw4.z = hi.x; vw4.w = hi.y;
                    bf16x8 vf; __builtin_memcpy(&vf, &vw4, 16);
                    nt[jb] = __builtin_amdgcn_mfma_f32_16x16x32_bf16(vf, pf, nt[jb], 0, 0, 0); } }
#pragma unroll
            for (int kk = 0; kk < 8; ++kk)
#pragma unroll
                for (int jb = 0; jb < 3; ++jb) { const bf16x8 cf = *(const LAS bf16x8*)(CTsh + (jb * 16 + li) * KS_LD + kk * 32 + kg * 8);
                    it[jb] = __builtin_amdgcn_mfma_f32_16x16x32_bf16(cf, qf[kk], it[jb], 0, 0, 0); }
#pragma unroll
            for (int kk = 0; kk < 8; ++kk) qf[kk] = *(const bf16x8*)(QH + (size_t)(tn + 16 * wid + li) * 256 + kk * 32 + kg * 8);
            const float w_int = __expf(m_prev - g_t);
#pragma unroll
            for (int jb = 0; jb < 3; ++jb) nt[jb] = nt[jb] + it[jb] * w_int;
            const float den = __shfl(nt[2][0], li);
            const float rden = 1.0f / fmaxf(fabsf(den), __expf(-(b_t + g_t)));
#pragma unroll
            for (int jb = 0; jb < 2; ++jb) { u32x2 w; w.x = cvt_pk_bf16(nt[jb][0] * rden, nt[jb][1] * rden); w.y = cvt_pk_bf16(nt[jb][2] * rden, nt[jb][3] * rden);
                *(u32x2*)(H + (size_t)(b * SEQ + t0 + t_loc) * DM + h * 256 + j0 + jb * 16 + kg * 4) = w; }
        }
        __syncthreads();
        {
            const float decay = __expf(m_prev - g_last);
#pragma unroll
            for (int db = 0; db < 2; ++db)
#pragma unroll
                for (int jb = 0; jb < 3; ++jb) Cacc[db][jb] = Cacc[db][jb] * decay;
            u32x2 kt2[2][4][2];
            {
                const unsigned tb = (unsigned)(uintptr_t)(lds + L_KSH) + (unsigned)(((kg * 8 + (li >> 2)) * KS_LD + (2 * wid) * 16 + 4 * (li & 3)) * 2);
#pragma unroll
                for (int db = 0; db < 2; ++db)
#pragma unroll
                    for (int k2 = 0; k2 < 4; ++k2)
#pragma unroll
                        for (int hf = 0; hf < 2; ++hf)
                            asm volatile("ds_read_b64_tr_b16 %0, %1 offset:%2" : "=&v"(kt2[db][k2][hf]) : "v"(tb), "i"(((k2 * 32 + hf * 4) * KS_LD + db * 16) * 2) : "memory");
#pragma unroll
                for (int db = 0; db < 2; ++db)
                    asm volatile("s_waitcnt lgkmcnt(0)" : "+v"(kt2[db][0][0]), "+v"(kt2[db][0][1]), "+v"(kt2[db][1][0]), "+v"(kt2[db][1][1]), "+v"(kt2[db][2][0]), "+v"(kt2[db][2][1]), "+v"(kt2[db][3][0]), "+v"(kt2[db][3][1]) :: "memory");
            }
#pragma unroll
            for (int k2 = 0; k2 < 4; ++k2)
#pragma unroll
                for (int jb = 0; jb < 3; ++jb) { const bf16x8 vf = *(const LAS bf16x8*)(VWsh + (jb * 16 + li) * VT_LD + k2 * 32 + kg * 8);
#pragma unroll
                    for (int db = 0; db < 2; ++db) { u32x4 kw; kw.x = kt2[db][k2][0].x; kw.y = kt2[db][k2][0].y; kw.z = kt2[db][k2][1].x; kw.w = kt2[db][k2][1].y; bf16x8 kf8; __builtin_memcpy(&kf8, &kw, 16);
                        Cacc[db][jb] = __builtin_amdgcn_mfma_f32_16x16x32_bf16(kf8, vf, Cacc[db][jb], 0, 0, 0); } }
#pragma unroll
            for (int db = 0; db < 2; ++db)
#pragma unroll
                for (int jb = 0; jb < 3; ++jb) { u32x2 w; w.x = cvt_pk_bf16(Cacc[db][jb][0], Cacc[db][jb][1]); w.y = cvt_pk_bf16(Cacc[db][jb][2], Cacc[db][jb][3]);
                    *(LAS u32x2*)(CTsh + (jb * 16 + li) * KS_LD + (2 * wid + db) * 16 + kg * 4) = w; }
            m_prev = b_last + g_last;
        }
    }
#pragma unroll
    for (int db = 0; db < 2; ++db) { const int d0 = (2 * wid + db) * 16 + kg * 4;
#pragma unroll
        for (int jb = 0; jb < 2; ++jb)
#pragma unroll
            for (int r = 0; r < 4; ++r) p.out[O_CP + ((size_t)(bh * 256 + d0 + r)) * 256 + j0 + jb * 16 + li] = Cacc[db][jb][r];
        if (vs == 0 && li == 0) {
#pragma unroll
            for (int r = 0; r < 4; ++r) p.out[O_NP + (size_t)bh * 256 + d0 + r] = Cacc[db][2][r]; } }
    if (vs == 0 && tid == 0) p.out[O_MP + bh] = m_prev;
    __syncthreads();
}

__device__ __forceinline__ void mlstm_sample_item(const Params& p, LAS unsigned char* lds, int item) {
    const int tid = threadIdx.x, bs = item >> 2, h = item & 3, tok0 = NPROMPT + bs * 4;
    LAS float* sq = (LAS float*)lds; LAS float* sk = sq + 1024; LAS float* sv = sk + 1024; LAS float* sn0 = sv + 1024; LAS float* sdot = sn0 + 256; LAS float* sc = sdot + 32; LAS float* sred = sc + 64;
    const bf16_t* QS = (const bf16_t*)(p.ws + WS_QKV) + ((size_t)HM_SAMPLE0 + (size_t)item * 4) * 256;
    const float* G = (const float*)(p.ws + WS_G); bf16_t* H = (bf16_t*)(p.ws + WS_H);
    const int c4 = tid & 63, rw = tid >> 6, col = c4 * 4;
    const float* C0 = p.sC + (size_t)item * 65536 + (size_t)(rw * 32) * 256 + col; float* C1 = p.out + O_CS + (size_t)item * 65536 + (size_t)(rw * 32) * 256 + col;
    f32x4 cv[8];
#pragma unroll
    for (int j = 0; j < 8; ++j) cv[j] = __builtin_nontemporal_load((const f32x4*)(C0 + j * 256));
    for (int e = tid; e < 3072; e += 512) { const int which = e >> 10, idx = e & 1023; sq[e] = bf2f(QS[(size_t)which * NTOK * DM + idx]); }
    if (tid < 256) sn0[tid] = p.sn[(size_t)item * 256 + tid];
    __syncthreads();
    {
        const int id = tid >> 4, part = tid & 15;
        if (id < 20) { const LAS float* va = id < 16 ? sq + (id >> 2) * 256 : sq + (id - 16) * 256; const LAS float* vb = id < 16 ? sk + (id & 3) * 256 : sn0;
            float s = 0.f;
#pragma unroll
            for (int e = 0; e < 16; ++e) s += va[part * 16 + e] * vb[part * 16 + e];
            s += __shfl_xor(s, 8); s += __shfl_xor(s, 4); s += __shfl_xor(s, 2); s += __shfl_xor(s, 1);
            if (part == 0) sdot[id] = s; }
    }
    __syncthreads();
    if (tid == 0) {
        const float m0 = p.sm[item];
        float li_[4], lf_[4], bb[4], aa[4], gg[4];
#pragma unroll
        for (int s = 0; s < 4; ++s) { li_[s] = G[(size_t)(tok0 + s) * 8 + h]; lf_[s] = G[(size_t)(tok0 + s) * 8 + 4 + h]; }
        float cum = 0.f, pm = m0;
#pragma unroll
        for (int s = 0; s < 4; ++s) { cum += lf_[s]; bb[s] = cum; aa[s] = li_[s] - cum; pm = fmaxf(pm, aa[s]); gg[s] = pm; }
#pragma unroll
        for (int t = 0; t < 4; ++t) { const float wi = __expf(m0 - gg[t]); float den = wi * sdot[16 + t];
#pragma unroll
            for (int s = 0; s < 4; ++s) { const float S = s <= t ? sdot[t * 4 + s] * __expf(aa[s] - gg[t]) : 0.f; sc[16 + t * 4 + s] = S; den += S; }
            sc[t] = wi; sc[12 + t] = 1.0f / fmaxf(fabsf(den), __expf(-(bb[t] + gg[t]))); }
#pragma unroll
        for (int s = 0; s < 4; ++s) sc[4 + s] = __expf(aa[s] - gg[3]);
        sc[8] = __expf(m0 - gg[3]); sc[9] = bb[3] + gg[3];
    }
    __syncthreads();
    const float decay = sc[8]; const float ws0 = sc[4], ws1 = sc[5], ws2 = sc[6], ws3 = sc[7];
    const f32x4 v0 = *(const LAS f32x4*)(sv + col), v1 = *(const LAS f32x4*)(sv + 256 + col), v2 = *(const LAS f32x4*)(sv + 512 + col), v3 = *(const LAS f32x4*)(sv + 768 + col);
    f32x4 a0 = {0.f, 0.f, 0.f, 0.f}, a1 = a0, a2 = a0, a3 = a0;
#pragma unroll
    for (int rb = 0; rb < 4; ++rb) {
        f32x4 cn[8];
        if (rb < 3) {
#pragma unroll
            for (int j = 0; j < 8; ++j) cn[j] = __builtin_nontemporal_load((const f32x4*)(C0 + ((rb + 1) * 8 + j) * 256));
        }
#pragma unroll
        for (int j = 0; j < 8; ++j) { const int d = rw * 32 + rb * 8 + j; const f32x4 x = cv[j];
            a0 += x * sq[d]; a1 += x * sq[256 + d]; a2 += x * sq[512 + d]; a3 += x * sq[768 + d];
            const f32x4 y = x * decay + v0 * (ws0 * sk[d]) + v1 * (ws1 * sk[256 + d]) + v2 * (ws2 * sk[512 + d]) + v3 * (ws3 * sk[768 + d]);
            __builtin_nontemporal_store(y, (f32x4*)(C1 + (rb * 8 + j) * 256)); }
        if (rb < 3) {
#pragma unroll
            for (int j = 0; j < 8; ++j) cv[j] = cn[j];
        }
    }
    *(LAS f32x4*)(sred + (rw * 4 + 0) * 256 + col) = a0; *(LAS f32x4*)(sred + (rw * 4 + 1) * 256 + col) = a1; *(LAS f32x4*)(sred + (rw * 4 + 2) * 256 + col) = a2; *(LAS f32x4*)(sred + (rw * 4 + 3) * 256 + col) = a3;
    __syncthreads();
#pragma unroll
    for (int e = 0; e < 2; ++e) { const int o = tid + 512 * e, t = o >> 8, cx = o & 255;
        float inter = 0.f;
#pragma unroll
        for (int w = 0; w < 8; ++w) inter += sred[(w * 4 + t) * 256 + cx];
        float num = sc[t] * inter;
#pragma unroll
        for (int s = 0; s < 4; ++s) num += sc[16 + t * 4 + s] * sv[s * 256 + cx];
        H[(size_t)(tok0 + t) * DM + h * 256 + cx] = (bf16_t)(cvt_pk_bf16(num * sc[12 + t], 0.f) & 0xffff); }
    if (tid < 256) p.out[O_NS + (size_t)item * 256 + tid] = decay * sn0[tid] + ws0 * sk[tid] + ws1 * sk[256 + tid] + ws2 * sk[512 + tid] + ws3 * sk[768 + tid];
    if (tid == 0) p.out[O_MS + item] = sc[9];
    __syncthreads();
}

__device__ __forceinline__ void conv_unit(const Params& p, const bf16_t* Z, bf16_t* AC, int r, int ch, const float (&cw)[24], u32x4 uw, u32x4 bw, u32x4 w1, u32x4 w2) {
    float u0[8], u1[8], u2[8], bg[8];
    const unsigned uu[4] = {uw.x, uw.y, uw.z, uw.w}, bb[4] = {bw.x, bw.y, bw.z, bw.w}, q1[4] = {w1.x, w1.y, w1.z, w1.w}, q2[4] = {w2.x, w2.y, w2.z, w2.w};
#pragma unroll
    for (int e = 0; e < 4; ++e) { u2[2 * e] = bf_lo(uu[e]); u2[2 * e + 1] = bf_hi(uu[e]); bg[2 * e] = bf_lo(bb[e]); bg[2 * e + 1] = bf_hi(bb[e]);
        u1[2 * e] = bf_lo(q1[e]); u1[2 * e + 1] = bf_hi(q1[e]); u0[2 * e] = bf_lo(q2[e]); u0[2 * e + 1] = bf_hi(q2[e]); }
    const bool prompt = r < NPROMPT; const int t = prompt ? (r & 2047) : ((r - NPROMPT) & 3); const int bs = (r - NPROMPT) >> 2;
    if (t < 1) { if (prompt) {
#pragma unroll
            for (int e = 0; e < 8; ++e) u1[e] = 0.f; }
        else { const float* sp = p.sconv + ((size_t)bs * 2 + 1) * DM + ch;
#pragma unroll
            for (int e = 0; e < 8; ++e) u1[e] = sp[e]; } }
    if (t < 2) { if (prompt) {
#pragma unroll
            for (int e = 0; e < 8; ++e) u0[e] = 0.f; }
        else { const float* sp = p.sconv + ((size_t)bs * 2 + t) * DM + ch;
#pragma unroll
            for (int e = 0; e < 8; ++e) u0[e] = sp[e]; } }
    float o[8];
#pragma unroll
    for (int e = 0; e < 8; ++e) o[e] = bg[e] * (cw[e] * u0[e] + cw[8 + e] * u1[e] + cw[16 + e] * u2[e]);
    u32x4 w; w.x = cvt_pk_bf16(o[0], o[1]); w.y = cvt_pk_bf16(o[2], o[3]); w.z = cvt_pk_bf16(o[4], o[5]); w.w = cvt_pk_bf16(o[6], o[7]);
    *(u32x4*)(AC + (size_t)r * DM + ch) = w;
    float* so = nullptr;
    if (prompt) { if (t >= SEQ - 2) so = p.out + O_CONVP + ((size_t)(r >> 11) * 2 + (t - (SEQ - 2))) * DM + ch; }
    else if (t >= 2) so = p.out + O_CONVS + ((size_t)bs * 2 + (t - 2)) * DM + ch;
    if (so) {
#pragma unroll
        for (int e = 0; e < 8; ++e) so[e] = u2[e]; }
}
__device__ __forceinline__ void conv_items(const Params& p) {
    const bf16_t* Z = (const bf16_t*)(p.ws + WS_Z); bf16_t* AC = (bf16_t*)(p.ws + WS_AC);
    const int gt = blockIdx.x * 512 + threadIdx.x, NG = gridDim.x * 512;
    const int ch = (gt & 127) * 8, r0 = gt >> 7, rstep = NG >> 7;
    float cw[24];
#pragma unroll
    for (int e = 0; e < 8; ++e) { cw[e] = p.conv_w[ch + e]; cw[8 + e] = p.conv_w[DM + ch + e]; cw[16 + e] = p.conv_w[2 * DM + ch + e]; }
    for (int rb = r0; rb < NTOK; rb += 4 * rstep) {
        u32x4 uw[4], bw[4], w1[4], w2[4];
#pragma unroll
        for (int j = 0; j < 4; ++j) { const int r = rb + j * rstep; if (r < NTOK) { const int r1 = r >= 1 ? r - 1 : r, r2 = r >= 2 ? r - 2 : r;
            uw[j] = *(const u32x4*)(Z + (size_t)r * ZC + Z_U + ch); bw[j] = *(const u32x4*)(Z + (size_t)r * ZC + Z_BG + ch);
            w1[j] = *(const u32x4*)(Z + (size_t)r1 * ZC + Z_U + ch); w2[j] = *(const u32x4*)(Z + (size_t)r2 * ZC + Z_U + ch); } }
#pragma unroll
        for (int j = 0; j < 4; ++j) { const int r = rb + j * rstep; if (r < NTOK) conv_unit(p, Z, AC, r, ch, cw, uw[j], bw[j], w1[j], w2[j]); }
    }
}

__device__ __forceinline__ void hn_items(const Params& p) {
    const bf16_t* Z = (const bf16_t*)(p.ws + WS_Z); const bf16_t* H = (const bf16_t*)(p.ws + WS_H); bf16_t* HN = (bf16_t*)(p.ws + WS_HN);
    const int lane = threadIdx.x & 63, gw = blockIdx.x * 8 + (threadIdx.x >> 6), NGW = gridDim.x * 8, c0 = lane * 16;
    f32x4 mg[4];
#pragma unroll
    for (int j = 0; j < 4; ++j) mg[j] = *(const f32x4*)(p.mh_g + c0 + 4 * j);
    for (int r = gw; r < NTOK; r += NGW) {
        const u32x4 h0 = *(const u32x4*)(H + (size_t)r * DM + c0), h1 = *(const u32x4*)(H + (size_t)r * DM + c0 + 8);
        const u32x4 o0 = *(const u32x4*)(Z + (size_t)r * ZC + Z_O + c0), o1 = *(const u32x4*)(Z + (size_t)r * ZC + Z_O + c0 + 8);
        const unsigned hw[8] = {h0.x, h0.y, h0.z, h0.w, h1.x, h1.y, h1.z, h1.w}, ow[8] = {o0.x, o0.y, o0.z, o0.w, o1.x, o1.y, o1.z, o1.w};
        float v[16]; float s = 0.f;
#pragma unroll
        for (int e = 0; e < 8; ++e) { v[2 * e] = bf_lo(hw[e]); v[2 * e + 1] = bf_hi(hw[e]); s += v[2 * e] + v[2 * e + 1]; }
        s += __shfl_xor(s, 1); s += __shfl_xor(s, 2); s += __shfl_xor(s, 4); s += __shfl_xor(s, 8);
        const float mean = s * (1.0f / 256.0f); float q = 0.f;
#pragma unroll
        for (int e = 0; e < 16; ++e) { v[e] -= mean; q += v[e] * v[e]; }
        q += __shfl_xor(q, 1); q += __shfl_xor(q, 2); q += __shfl_xor(q, 4); q += __shfl_xor(q, 8);
        const float rstd = 1.0f / sqrtf(q * (1.0f / 256.0f) + LN_EPS);
        unsigned ww[8];
#pragma unroll
        for (int e = 0; e < 8; ++e) { const float g0 = mg[(2 * e) >> 2][(2 * e) & 3], g1 = mg[(2 * e + 1) >> 2][(2 * e + 1) & 3];
            ww[e] = cvt_pk_bf16(v[2 * e] * rstd * g0 * bf_lo(ow[e]), v[2 * e + 1] * rstd * g1 * bf_hi(ow[e])); }
        u32x4 w0, w1; w0.x = ww[0]; w0.y = ww[1]; w0.z = ww[2]; w0.w = ww[3]; w1.x = ww[4]; w1.y = ww[5]; w1.z = ww[6]; w1.w = ww[7];
        *(u32x4*)(HN + (size_t)r * DM + c0) = w0; *(u32x4*)(HN + (size_t)r * DM + c0 + 8) = w1;
    }
}

template <bool OUT_F32>
__device__ __forceinline__ void ln_rows(const bf16_t* R, const float* gam, const float* bet, void* out, const float* SL, int NS, const float* xs, const bf16_t* X1) {
    const int lane = threadIdx.x & 63, gw = blockIdx.x * 8 + (threadIdx.x >> 6), NGW = gridDim.x * 8;
    f32x4 gv[4], bv[4];
#pragma unroll
    for (int j = 0; j < 4; ++j) { gv[j] = *(const f32x4*)(gam + j * 256 + lane * 4); bv[j] = *(const f32x4*)(bet + j * 256 + lane * 4); }
    for (int r = gw; r < NTOK; r += NGW) {
        f32x4 v[4]; float s = 0.f;
        if (r < NPROMPT) {
#pragma unroll
            for (int j = 0; j < 4; ++j) { const u32x2 w = *(const u32x2*)(R + (size_t)r * DM + j * 256 + lane * 4); v[j] = (f32x4){bf_lo(w.x), bf_hi(w.x), bf_lo(w.y), bf_hi(w.y)}; }
        } else {
            const int rs = r - NPROMPT;
#pragma unroll
            for (int j = 0; j < 4; ++j) { const int cc = j * 256 + lane * 4;
                if (xs) v[j] = *(const f32x4*)(xs + (size_t)rs * DM + cc) * ALPHA;
                else { const u32x2 w = *(const u32x2*)(X1 + (size_t)r * DM + cc); v[j] = (f32x4){bf_lo(w.x), bf_hi(w.x), bf_lo(w.y), bf_hi(w.y)} * ALPHA; }
                for (int k = 0; k < NS; ++k) v[j] += *(const f32x4*)(SL + ((size_t)k * NSAMPLE + rs) * DM + cc); }
        }
#pragma unroll
        for (int j = 0; j < 4; ++j) s += (v[j][0] + v[j][1]) + (v[j][2] + v[j][3]);
        const float mean = wave_sum(s) * (1.0f / DM); float q = 0.f;
#pragma unroll
        for (int j = 0; j < 4; ++j) { v[j] = v[j] - mean; q += (v[j][0] * v[j][0] + v[j][1] * v[j][1]) + (v[j][2] * v[j][2] + v[j][3] * v[j][3]); }
        const float rstd = 1.0f / sqrtf(wave_sum(q) * (1.0f / DM) + LN_EPS);
#pragma unroll
        for (int j = 0; j < 4; ++j) { const f32x4 y = v[j] * rstd * gv[j] + bv[j];
            if (OUT_F32) *(f32x4*)((float*)out + (size_t)r * DM + j * 256 + lane * 4) = y;
            else { u32x2 w; w.x = cvt_pk_bf16(y[0], y[1]); w.y = cvt_pk_bf16(y[2], y[3]); *(u32x2*)((bf16_t*)out + (size_t)r * DM + j * 256 + lane * 4) = w; } }
    }
}

__global__ void __launch_bounds__(512, 2) mega(Params p) {
    extern __shared__ __attribute__((aligned(16))) unsigned char shm_raw[];
    LAS unsigned char* lds = (LAS unsigned char*)shm_raw;
    const int G = gridDim.x, c = blockIdx.x;
    unsigned char* ws = p.ws;
    volatile LAS unsigned* xst = (volatile LAS unsigned*)(lds + 131072);
    if (threadIdx.x == 0) { xst[0] = 0u; xst[1] = 0u; }
    __syncthreads();
    const XcdBarrier xb = xcd_barrier_post((unsigned*)(ws + WS_BAR), xst);
    if (p.ph_hi > 64) cg::this_grid().sync();
#if MK_MULTI
#define PH_SYNC(k)
#else
#define PH_SYNC(k) do { if (p.ph_lo <= (k) && (k) + 1 < p.ph_hi) xcd_barrier(xb); } while (0)
#endif
#define PH_ON(k) (((PHMASK >> (k)) & 1) && p.ph_lo <= (k) && (k) < p.ph_hi)
#ifndef REPMASK
#define REPMASK 0
#endif
    if (PH_ON(0)) phase0(p, lds);
    PH_SYNC(0);
    if (PH_ON(1)) { pg8::StaticOrder S; S.init(NTOK, NZ, DM, G, c); pg8::Gemm g{(const bf16_t*)(ws + WS_XB), (const bf16_t*)(ws + WS_WIN), NTOK, NZ, DM};
        EpiZ E{(bf16_t*)(ws + WS_Z), (bf16_t*)(ws + WS_QKV), (bf16_t*)(ws + WS_KT)}; pg8::gemm_phase(lds, g, S, E); }
    PH_SYNC(1);
    if (PH_ON(2)) {
        for (int it = c; it < 256; it += G) { const int xcd = it & 7, idx = it >> 3; mlstm_prompt_item(p, lds, xcd * 4 + (idx >> 3), idx & 7); }
        for (int it = c; it < 512; it += G) mlstm_sample_item(p, lds, it);
        conv_items(p);
    }
    PH_SYNC(2);
    if (PH_ON(3)) { hn_items(p);
        pg8::StaticOrder S; S.init(NTOK, DM, DM, G, c); pg8::Gemm g{(const bf16_t*)(ws + WS_AC), (const bf16_t*)(ws + WS_WC), NTOK, DM, DM};
        EpiGate E{(bf16_t*)(ws + WS_XB), nullptr, (const bf16_t*)(ws + WS_Z), Z_GC, 0}; pg8::gemm_phase(lds, g, S, E); }
    PH_SYNC(3);
    if (PH_ON(4)) { pg8::StaticOrder S; S.init(NTOK, DM, DM, G, c); pg8::Gemm g{(const bf16_t*)(ws + WS_HN), (const bf16_t*)(ws + WS_WM), NTOK, DM, DM};
        EpiGate E{(bf16_t*)(ws + WS_AC), (const bf16_t*)(ws + WS_XB), (const bf16_t*)(ws + WS_Z), Z_GM, 1}; pg8::gemm_phase(lds, g, S, E); }
    PH_SYNC(4);
    if (PH_ON(5)) { pg8::SplitOrder S; S.init(DM, 4, G, c); pg8::Gemm g{(const bf16_t*)(ws + WS_AC), (const bf16_t*)(ws + WS_WO), NTOK, DM, DM};
        EpiResX E{(bf16_t*)(ws + WS_R), p.xp, p.xs, (float*)(ws + WS_KT)}; pg8::gemm_phase(lds, g, S, E); }
    PH_SYNC(5);
    if (PH_ON(6)) ln_rows<false>((const bf16_t*)(ws + WS_R), p.ln1g, p.ln1b, ws + WS_H, (const float*)(ws + WS_KT), 4, p.xs, nullptr);
    PH_SYNC(6);
    if (PH_ON(7)) { pg8::StaticOrder S; S.init(NTOK, DFF, DM, G, c); pg8::Gemm g{(const bf16_t*)(ws + WS_H), (const bf16_t*)(ws + WS_W1), NTOK, DFF, DM};
        EpiHid E{(bf16_t*)(ws + WS_HID)}; pg8::gemm_phase(lds, g, S, E); }
    PH_SYNC(7);
    if (PH_ON(8)) { pg8::SplitOrder S; S.init(DFF, 16, G, c); pg8::Gemm g{(const bf16_t*)(ws + WS_HID), (const bf16_t*)(ws + WS_W2), NTOK, DM, DFF};
        EpiResB E{(bf16_t*)(ws + WS_R), (const bf16_t*)(ws + WS_H), (float*)(ws + WS_KT)}; pg8::gemm_phase(lds, g, S, E); }
    PH_SYNC(8);
    if (PH_ON(9)) ln_rows<true>((const bf16_t*)(ws + WS_R), p.ln2g, p.ln2b, p.out + O_Y, (const float*)(ws + WS_KT), 16, nullptr, (const bf16_t*)(ws + WS_H));
#if MK_MULTI
    if (p.ph_lo == 11) { for (int it = c; it < 512; it += G) mlstm_sample_item(p, lds, it); }
    if (p.ph_lo == 12) conv_items(p);
    if (p.ph_lo == 10) { for (int it = c; it < 256; it += G) { const int xcd = it & 7, idx = it >> 3; mlstm_prompt_item(p, lds, xcd * 4 + (idx >> 3), idx & 7); } }
#endif
}

extern "C" void kernel_launch(void* const* d_in, const int* in_sizes, int n_in, void* d_out, int out_size, void* d_ws, size_t ws_size, hipStream_t stream) {
    static int grid = 0;
    if (grid == 0) {
        if (n_in != 19 || ws_size < WS_END) { fprintf(stderr, "kernel_launch: unexpected inputs (n_in %d, ws %zu, need %zu)\n", n_in, ws_size, (size_t)WS_END); grid = -1; return; }
        int dev = 0, cus = 0, per_cu = 0;
        hipGetDevice(&dev); hipDeviceGetAttribute(&cus, hipDeviceAttributeMultiprocessorCount, dev);
        hipFuncSetAttribute((const void*)mega, hipFuncAttributeMaxDynamicSharedMemorySize, LDS_BYTES);
        hipOccupancyMaxActiveBlocksPerMultiprocessor(&per_cu, (const void*)mega, 512, LDS_BYTES);
        if (per_cu < 1 || cus < 1) { fprintf(stderr, "kernel_launch: occupancy query says %d blocks/CU on %d CUs\n", per_cu, cus); grid = -1; return; }
        grid = cus;
    }
    if (grid < 0) return;
    Params p{};
    const float** f = (const float**)&p;
    for (int i = 0; i < 19; ++i) f[i] = (const float*)d_in[i];
    p.out = (float*)d_out; p.ws = (unsigned char*)d_ws;
#if MK_MULTI
    for (int ph = 0; ph < 10; ++ph) for (int rep = 0; rep < ((REPMASK >> ph) & 1) + 1; ++rep) { p.ph_lo = ph; p.ph_hi = ph + 1; hipLaunchKernelGGL(mega, dim3(grid), dim3(512), LDS_BYTES, stream, p); }
#ifdef EXTRA_PH
    { p.ph_lo = EXTRA_PH; p.ph_hi = EXTRA_PH + 1; hipLaunchKernelGGL(mega, dim3(grid), dim3(512), LDS_BYTES, stream, p); }
#endif
#else
    p.ph_lo = 0; p.ph_hi = 10;
    if (hipMemsetAsync((char*)d_ws + WS_BAR, 0, 16384, stream) != hipSuccess) { fprintf(stderr, "memset failed\n"); return; }
    void* args[] = {&p};
    hipError_t e = hipLaunchCooperativeKernel((const void*)mega, dim3(grid), dim3(512), args, LDS_BYTES, stream);
    if (e != hipSuccess) fprintf(stderr, "cooperative launch failed: %s (grid %d)\n", hipGetErrorString(e), grid);
#endif
}
```

```cpp
#include <hip/hip_runtime.h>
#include <hip/hip_cooperative_groups.h>
#include <cstdio>
namespace cg = cooperative_groups;

#ifndef PHMASK
#define PHMASK 1023
#endif
#ifndef MK_MULTI
#define MK_MULTI 0
#endif

#define LAS __attribute__((address_space(3)))
typedef unsigned short bf16_t;
typedef short bf16x8 __attribute__((ext_vector_type(8)));
typedef float f32x4 __attribute__((ext_vector_type(4)));
typedef float f32x2 __attribute__((ext_vector_type(2)));
typedef unsigned u32x4 __attribute__((ext_vector_type(4)));
typedef unsigned u32x2 __attribute__((ext_vector_type(2)));

constexpr int DM = 1024, NPROMPT = 8 * 2048, NSAMPLE = 128 * 4, NTOK = NPROMPT + NSAMPLE;
constexpr int SEQ = 2048, NH = 4, DH = 256, DFF = 4096, DIN = 9224, NZ = 9216, ZC = 5120;
constexpr float ALPHA = 1.189207115002721f;
constexpr float LN_EPS = 1e-5f;
constexpr int Z_BG = 0, Z_U = 1024, Z_O = 2048, Z_GC = 3072, Z_GM = 4096;
constexpr int HM_SAMPLE0 = 32 * 2048;
constexpr size_t O_Y = 0, O_CONVP = 17301504, O_CONVS = 17317888, O_CP = 17580032, O_CS = 19677184, O_NP = 53231616, O_NS = 53239808, O_MP = 53370880, O_MS = 53370912;
constexpr size_t SZ_ACT = (size_t)NTOK * DM * 2;
constexpr size_t WS_XB = 0;
constexpr size_t WS_WIN = WS_XB + SZ_ACT;
constexpr size_t WS_WC = WS_WIN + (size_t)NZ * DM * 2;
constexpr size_t WS_WM = WS_WC + (size_t)DM * DM * 2;
constexpr size_t WS_WO = WS_WM + (size_t)DM * DM * 2;
constexpr size_t WS_W1 = WS_WO + (size_t)DM * DM * 2;
constexpr size_t WS_W2 = WS_W1 + (size_t)DFF * DM * 2;
constexpr size_t WS_G = WS_W2 + (size_t)DFF * DM * 2;
constexpr size_t WS_Z = WS_G + (size_t)NTOK * 8 * 4;
constexpr size_t WS_HID = WS_Z;
constexpr size_t WS_R = WS_Z + (size_t)NTOK * DFF * 2;
constexpr size_t WS_QKV = WS_Z + (size_t)NTOK * ZC * 2;
constexpr size_t WS_KT = WS_QKV + 3 * SZ_ACT;
constexpr size_t WS_H = WS_KT + (size_t)32 * 256 * 2048 * 2;
constexpr size_t WS_AC = WS_H + SZ_ACT;
constexpr size_t WS_HN = WS_AC + SZ_ACT;
constexpr size_t WS_BAR = WS_HN + SZ_ACT;
constexpr size_t WS_END = WS_BAR + 16384;
constexpr int LDS_BYTES = 131072 + 16;

struct Params {
    const float *xp, *xs, *sconv, *sC, *sn, *sm, *w_in, *b_gate, *conv_w, *w_co, *mh_g, *w_mo, *w_o, *ln1g, *ln1b, *w_ff1, *w_ff2, *ln2g, *ln2b;
    float* out; unsigned char* ws; int ph_lo, ph_hi;
};

__device__ __forceinline__ unsigned cvt_pk_bf16(float lo, float hi) { unsigned r; asm volatile("v_cvt_pk_bf16_f32 %0, %1, %2" : "=v"(r) : "v"(lo), "v"(hi)); return r; }
__device__ __forceinline__ float bf_lo(unsigned w) { return __uint_as_float(w << 16); }
__device__ __forceinline__ float bf_hi(unsigned w) { return __uint_as_float(w & 0xffff0000u); }
__device__ __forceinline__ float bf2f(bf16_t b) { return __uint_as_float(((unsigned)b) << 16); }
__device__ __forceinline__ float sigmoidf_(float x) { return 1.0f / (1.0f + __expf(-x)); }
__device__ __forceinline__ float wave_sum(float v) {
#pragma unroll
    for (int o = 1; o < 64; o <<= 1) v += __shfl_xor(v, o);
    return v;
}
__device__ __forceinline__ const float* xrow(const Params& p, int r) { return r < NPROMPT ? p.xp + (size_t)r * DM : p.xs + (size_t)(r - NPROMPT) * DM; }
#define LDS_WAIT() asm volatile("s_waitcnt lgkmcnt(0)" ::: "memory")

#define XB_TMO      128
#define XB_XCNT(j)  (256  + 64 * (j))
#define XB_XSUB(j)  (1280 + 64 * (j))
#define XB_XGEN(j)  (2304 + 64 * (j))
#define XB_TOP      3328
#define XB_TOPGEN   3392
#define XCD_BAR_WORDS 3456
#define XB_SPIN_CAP (1u << 22)
__device__ __forceinline__ unsigned xb_ld(unsigned* p)              { return __hip_atomic_load(p, __ATOMIC_RELAXED, __HIP_MEMORY_SCOPE_AGENT); }
__device__ __forceinline__ unsigned xb_add(unsigned* p, unsigned v) { return __hip_atomic_fetch_add(p, v, __ATOMIC_RELAXED, __HIP_MEMORY_SCOPE_AGENT); }
__device__ __forceinline__ unsigned xb_xcc_id() { return (unsigned)__builtin_amdgcn_s_getreg((3 << 11) | 20) & 0xFu; }
#define XB_SPIN(cond, bar) do { unsigned _sp = 0; while (cond) { __builtin_amdgcn_s_sleep(1); \
    if ((++_sp & 255u) == 0u) { if (xb_ld(&(bar)[XB_TMO])) break; if (_sp > XB_SPIN_CAP) { atomicAdd(&(bar)[XB_TMO], 1u); break; } } } } while (0)
struct XcdBarrier { unsigned* bar; unsigned x; volatile LAS unsigned* st; };
__device__ __forceinline__ XcdBarrier xcd_barrier_post(unsigned* bar, volatile LAS unsigned* st) {
    XcdBarrier b; b.bar = bar; b.x = xb_xcc_id(); b.st = st;
    if (threadIdx.x == 0) (void)xb_add(&bar[XB_XCNT(b.x)], 1u);
    return b;
}
__device__ __forceinline__ void xcd_barrier_complete(unsigned* bar, unsigned x, unsigned& nloc, unsigned& nx) {
    const unsigned G = gridDim.x * gridDim.y * gridDim.z;
    unsigned sum, cnt, mine, sp = 0u;
    for (;;) {
        sum = 0u; cnt = 0u; mine = 0u;
#pragma unroll
        for (unsigned j = 0; j < 16; ++j) { const unsigned c = xb_ld(&bar[XB_XCNT(j)]); sum += c; cnt += (c > 0u) ? 1u : 0u; mine = (j == x) ? c : mine; }
        if (sum == G) break;
        __builtin_amdgcn_s_sleep(1);
        if ((++sp & 255u) == 0u) { if (xb_ld(&bar[XB_TMO])) break; if (sp > XB_SPIN_CAP) { atomicAdd(&bar[XB_TMO], 1u); break; } }
    }
    nloc = mine > 0u ? mine : 1u; nx = cnt > 0u ? cnt : 1u;
}
__device__ __forceinline__ void xcd_barrier(const XcdBarrier& b) {
    asm volatile("s_waitcnt vmcnt(0)" ::: "memory");
    __syncthreads();
    if (threadIdx.x == 0) {
        unsigned* bar = b.bar;
        __builtin_amdgcn_s_waitcnt(0);
        unsigned nloc = b.st[0], nx = b.st[1];
        if (nloc == 0u) { xcd_barrier_complete(bar, b.x, nloc, nx); b.st[0] = nloc; b.st[1] = nx; }
        const unsigned old = xb_add(&bar[XB_XSUB(b.x)], 1u);
        const unsigned gen = old / nloc;
        if (old + 1u == (gen + 1u) * nloc) {
            __builtin_amdgcn_fence(__ATOMIC_RELEASE, "agent");
            asm volatile("s_waitcnt vmcnt(0)" ::: "memory");
            const unsigned og = xb_add(&bar[XB_TOP], 1u);
            const unsigned tg = og / nx;
            if (og + 1u == (tg + 1u) * nx) xb_add(&bar[XB_TOPGEN], 1u);
            else XB_SPIN(xb_ld(&bar[XB_TOPGEN]) == tg, bar);
            __builtin_amdgcn_fence(__ATOMIC_ACQUIRE, "agent");
            xb_add(&bar[XB_XGEN(b.x)], 1u);
            asm volatile("s_waitcnt vmcnt(0)" ::: "memory");
        } else {
            XB_SPIN(xb_ld(&bar[XB_XGEN(b.x)]) == gen, bar);
            __builtin_amdgcn_fence(__ATOMIC_ACQUIRE, "agent");
            asm volatile("s_waitcnt vmcnt(0)" ::: "memory");
        }
    }
    __syncthreads();
}

namespace pg8 {
constexpr int BM = 256, BK = 64, HALF = 128, HTB = HALF * BK * 2, NXCD = 8, WGM = 8;
__host__ __device__ __forceinline__ int lds_byte(int r, int c) { const int st = (r >> 4) * 2 + (c >> 5), rr = r & 15, cc = c & 31, ob = rr * 64 + cc * 2; return st * 1024 + (ob ^ (((ob >> 9) & 1) << 5)); }
__host__ __device__ __forceinline__ void stage_rc(int b, int& R, int& C) { const int st = b / 1024, sb = b % 1024, swz = sb ^ (((sb >> 9) & 1) << 5); R = (st >> 1) * 16 + swz / 64; C = (st & 1) * 32 + (swz % 64) / 2; }
__host__ __device__ __forceinline__ int perm32(int rho) { const int n = rho >> 4, i = rho & 15; return 8 * (i >> 2) + 4 * n + (i & 3); }
struct Unit { int pm, pn, k0, nt, ks; };
struct Gemm { const bf16_t* A; const bf16_t* Bt; int M, N, K; };
struct StaticOrder {
    int nM, nN, nwg, G, c, kt;
    __device__ void init(int M, int N, int K, int G_, int c_) { nM = M / BM; nN = N / BM; nwg = nM * nN; G = G_; c = c_; kt = K / BK; }
    __device__ bool next(int i, Unit& u) const {
        const long L = (long)i * G + c; if (L >= nwg) return false;
        int wgid = (int)L; { const int q = nwg / NXCD, r = nwg % NXCD, xcd = wgid % NXCD, off = wgid / NXCD; wgid = (xcd < r ? xcd * (q + 1) : r * (q + 1) + (xcd - r) * q) + off; }
        const int nig = WGM * nN, gid = wgid / nig, fm = gid * WGM, gsz = (nM - fm) < WGM ? (nM - fm) : WGM;
        u.pm = fm + ((wgid % nig) % gsz); u.pn = (wgid % nig) / gsz; u.k0 = 0; u.nt = kt; u.ks = -1; return true;
    }
};
struct SplitOrder {
    StaticOrder so; int NS, ntk;
    __device__ void init(int K, int NS_, int G_, int c_) { so.init(NPROMPT, DM, K, G_, c_); NS = NS_; ntk = K / (BK * NS_); }
    __device__ bool next(int i, Unit& u) const {
        const long L = (long)i * so.G + so.c;
        if (L < so.nwg) return so.next(i, u);
        const int e = (int)(L - so.nwg); if (e >= 8 * NS) return false;
        const int tile = e / NS, ks = e % NS; u.pm = 64 + (tile >> 2); u.pn = tile & 3; u.k0 = ks * ntk * BK; u.nt = ntk; u.ks = ks; return true;
    }
};

template <class Epi, class Sched>
__device__ __forceinline__ void gemm_phase(LAS unsigned char* lds, const Gemm g, const Sched& S, const Epi& E) {
    const int tid = threadIdx.x, wid = __builtin_amdgcn_readfirstlane(tid >> 6), lane = tid & 63, wr = wid >> 2, wc = wid & 3, fr = lane & 15, fq = lane >> 4;
    const int K = g.K;
    unsigned voffA[2], voffB[2];
#pragma unroll
    for (int i = 0; i < 2; ++i) { int R, C; stage_rc(tid * 16 + i * 8192, R, C); const int Rb = (R & ~31) + perm32(R & 31);
        voffA[i] = (unsigned)(R * K + C) * 2u; voffB[i] = (unsigned)(Rb * K + C) * 2u; }
    const size_t kstep = (size_t)(BK * 2);
    const size_t hstep = (size_t)HALF * K * 2;
    const size_t tstep = 2 * hstep;
    const unsigned ldsw = (unsigned)wid * 1024u;
    const int aoff = lds_byte(wr * 64 + fr, fq * 8), boff = lds_byte(wc * 32 + fr, fq * 8);
#define PG8_SA(b, h) (((b) * 2 + (h)) * HTB)
#define PG8_SB(b, h) ((4 + (b) * 2 + (h)) * HTB)
#define PG8_STAGE(bufoff, gbase, voff) do { _Pragma("unroll") for (int _i = 0; _i < 2; ++_i) \
        __builtin_amdgcn_global_load_lds((const unsigned*)((const char*)(gbase) + (voff)[_i]), (LAS unsigned*)(lds + (bufoff) + ldsw + _i * 8192), 16, 0, 0); } while (0)
#define PG8_LDA(dst, b, h) do { _Pragma("unroll") for (int m = 0; m < 4; ++m) _Pragma("unroll") for (int k = 0; k < 2; ++k) dst[m][k] = *(const LAS bf16x8*)(lds + PG8_SA(b, h) + aoff + m * 2048 + k * 1024); } while (0)
#define PG8_LDB(dst, b, h) do { _Pragma("unroll") for (int n = 0; n < 2; ++n) _Pragma("unroll") for (int k = 0; k < 2; ++k) dst[n][k] = *(const LAS bf16x8*)(lds + PG8_SB(b, h) + boff + n * 2048 + k * 1024); } while (0)
#define PG8_MMA(ai, bj, At, Bt) do { __builtin_amdgcn_s_setprio(1); _Pragma("unroll") for (int m = 0; m < 4; ++m) _Pragma("unroll") for (int n = 0; n < 2; ++n) _Pragma("unroll") for (int k = 0; k < 2; ++k) \
        acc[ai][bj][m][n] = __builtin_amdgcn_mfma_f32_16x16x32_bf16(Bt[n][k], At[m][k], acc[ai][bj][m][n], 0, 0, 0); __builtin_amdgcn_s_setprio(0); } while (0)
#define PG8_WAIT_V(n) asm volatile("s_waitcnt vmcnt(" #n ")" ::: "memory")
#define PG8_WAIT_L(n) asm volatile("s_waitcnt lgkmcnt(" #n ")" ::: "memory")
#define PG8_BAR __builtin_amdgcn_s_barrier()
#define PG8_SCHED __builtin_amdgcn_sched_barrier(0)
    Unit cur, nxt; int ui = 0;
    if (!S.next(0, cur)) return;
    f32x4 acc[2][2][4][2];
#pragma unroll
    for (int a = 0; a < 2; ++a)
#pragma unroll
        for (int b = 0; b < 2; ++b)
#pragma unroll
            for (int m = 0; m < 4; ++m)
#pragma unroll
                for (int n = 0; n < 2; ++n) acc[a][b][m][n] = (f32x4){0.f, 0.f, 0.f, 0.f};
    bf16x8 At[4][2], B0[2][2], B1[2][2];
    const char* cA = (const char*)g.A + (size_t)cur.pm * tstep + (size_t)cur.k0 * 2; const char* cB = (const char*)g.Bt + (size_t)cur.pn * tstep + (size_t)cur.k0 * 2;
    PG8_STAGE(PG8_SB(0, 0), cB, voffB); PG8_STAGE(PG8_SA(0, 0), cA, voffA); PG8_STAGE(PG8_SB(0, 1), cB + hstep, voffB); PG8_STAGE(PG8_SA(0, 1), cA + hstep, voffA);
    if (wr == 1) PG8_BAR;
    PG8_WAIT_V(4); PG8_BAR;
    PG8_STAGE(PG8_SB(1, 0), cB + kstep, voffB); PG8_STAGE(PG8_SA(1, 0), cA + kstep, voffA); PG8_STAGE(PG8_SB(1, 1), cB + hstep + kstep, voffB);
    PG8_WAIT_V(6); PG8_BAR;
    for (;;) {
        const bool has_next = S.next(ui + 1, nxt);
        const char* nA = has_next ? (const char*)g.A + (size_t)nxt.pm * tstep + (size_t)nxt.k0 * 2 : cA; const char* nB = has_next ? (const char*)g.Bt + (size_t)nxt.pn * tstep + (size_t)nxt.k0 * 2 : cB;
        const int nt = cur.nt;
        for (int t = 0; t < nt; t += 2) {
            const bool last = (t == nt - 2);
            const char* a1 = cA + (size_t)(t + 1) * kstep;
            const char* a2 = last ? nA : cA + (size_t)(t + 2) * kstep; const char* b2 = last ? nB : cB + (size_t)(t + 2) * kstep;
            const char* a3 = a2 + kstep; const char* b3 = b2 + kstep;
            PG8_LDB(B0, 0, 0); PG8_SCHED; PG8_LDA(At, 0, 0); PG8_STAGE(PG8_SA(1, 1), a1 + hstep, voffA);
            PG8_WAIT_L(8); PG8_BAR; PG8_WAIT_L(0); PG8_MMA(0, 0, At, B0); PG8_BAR; PG8_SCHED;
            PG8_LDB(B1, 0, 1); PG8_STAGE(PG8_SB(0, 0), b2, voffB);
            PG8_BAR; PG8_WAIT_L(0); PG8_MMA(0, 1, At, B1); PG8_BAR;
            PG8_LDA(At, 0, 1); PG8_STAGE(PG8_SA(0, 0), a2, voffA);
            PG8_BAR; PG8_WAIT_L(0); PG8_MMA(1, 0, At, B0); PG8_BAR; PG8_SCHED;
            PG8_STAGE(PG8_SB(0, 1), b2 + hstep, voffB);
            PG8_WAIT_V(6); PG8_BAR; PG8_MMA(1, 1, At, B1); PG8_BAR;
            PG8_LDB(B0, 1, 0); PG8_SCHED; PG8_LDA(At, 1, 0); PG8_STAGE(PG8_SA(0, 1), a2 + hstep, voffA);
            PG8_WAIT_L(8); PG8_BAR; PG8_WAIT_L(0); PG8_MMA(0, 0, At, B0); PG8_BAR; PG8_SCHED;
            PG8_LDB(B1, 1, 1); PG8_STAGE(PG8_SB(1, 0), b3, voffB);
            PG8_BAR; PG8_WAIT_L(0); PG8_MMA(0, 1, At, B1); PG8_BAR;
            PG8_LDA(At, 1, 1); PG8_STAGE(PG8_SA(1, 0), a3, voffA);
            PG8_BAR; PG8_WAIT_L(0); PG8_MMA(1, 0, At, B0); PG8_BAR; PG8_SCHED;
            PG8_STAGE(PG8_SB(1, 1), b3 + hstep, voffB);
            PG8_WAIT_V(6); PG8_BAR; PG8_MMA(1, 1, At, B1); PG8_BAR;
        }
        E(acc, cur, wr, wc, fr, fq);
        if (!has_next) break;
#pragma unroll
        for (int a = 0; a < 2; ++a)
#pragma unroll
            for (int b = 0; b < 2; ++b)
#pragma unroll
                for (int m = 0; m < 4; ++m)
#pragma unroll
                    for (int n = 0; n < 2; ++n) acc[a][b][m][n] = (f32x4){0.f, 0.f, 0.f, 0.f};
        cur = nxt; cA = nA; cB = nB; ++ui;
    }
    PG8_WAIT_V(0);
    if (wr == 0) PG8_BAR;
    PG8_BAR;
#undef PG8_SA
#undef PG8_SB
#undef PG8_STAGE
#undef PG8_LDA
#undef PG8_LDB
#undef PG8_MMA
#undef PG8_WAIT_V
#undef PG8_WAIT_L
#undef PG8_BAR
#undef PG8_SCHED
}
}
using pg8::Unit;

#define EPI_LOOP_BEGIN \
    _Pragma("unroll") for (int ai = 0; ai < 2; ++ai) _Pragma("unroll") for (int m = 0; m < 4; ++m) { const int row = u.pm * 256 + ai * 128 + wr * 64 + m * 16 + fr; \
    _Pragma("unroll") for (int bj = 0; bj < 2; ++bj) { const int lc = bj * 128 + wc * 32 + 8 * fq; const f32x4 v0 = acc[ai][bj][m][0], v1 = acc[ai][bj][m][1];
#define EPI_LOOP_END } }

struct EpiZ {
    bf16_t* Z; bf16_t* QKV; bf16_t* KT;
    __device__ __forceinline__ void operator()(const f32x4 (&acc)[2][2][4][2], const Unit& u, int wr, int wc, int fr, int fq) const {
        const int pn = u.pn;
        if (pn >= 4 && pn < 12) {
#pragma unroll
            for (int ai = 0; ai < 2; ++ai)
#pragma unroll
                for (int m = 0; m < 4; ++m) { const int row = u.pm * 256 + ai * 128 + wr * 64 + m * 16 + fr;
                    const f32x4 a0 = acc[ai][0][m][0] * acc[ai][1][m][0], a1 = acc[ai][0][m][1] * acc[ai][1][m][1];
                    u32x4 w; w.x = cvt_pk_bf16(a0[0], a0[1]); w.y = cvt_pk_bf16(a0[2], a0[3]); w.z = cvt_pk_bf16(a1[0], a1[1]); w.w = cvt_pk_bf16(a1[2], a1[3]);
                    *(u32x4*)(Z + (size_t)row * ZC + Z_U + (pn - 4) * 128 + wc * 32 + 8 * fq) = w; }
            return;
        }
        if (pn >= 12 && pn < 24) {
            const int grp = (pn - 12) >> 2, hh = (pn - 12) & 3;
            bf16_t* dst = QKV + (size_t)grp * NTOK * DM;
            EPI_LOOP_BEGIN
                const size_t rr = row < NPROMPT ? (size_t)((row >> 11) * 4 + hh) * SEQ + (row & 2047) : (size_t)HM_SAMPLE0 + (size_t)(((row - NPROMPT) >> 2) * 4 + hh) * 4 + ((row - NPROMPT) & 3);
                u32x4 w; w.x = cvt_pk_bf16(v0[0], v0[1]); w.y = cvt_pk_bf16(v0[2], v0[3]); w.z = cvt_pk_bf16(v1[0], v1[1]); w.w = cvt_pk_bf16(v1[2], v1[3]);
                *(u32x4*)(dst + rr * 256 + lc) = w;
            EPI_LOOP_END
            return;
        }
        const int zc0 = pn < 4 ? pn * 256 : Z_O + (pn - 24) * 256;
        const bool sg = pn >= 24;
        EPI_LOOP_BEGIN
            f32x4 a0 = v0, a1 = v1;
            if (sg) {
#pragma unroll
                for (int j = 0; j < 4; ++j) { a0[j] = sigmoidf_(a0[j]); a1[j] = sigmoidf_(a1[j]); }
            }
            u32x4 w; w.x = cvt_pk_bf16(a0[0], a0[1]); w.y = cvt_pk_bf16(a0[2], a0[3]); w.z = cvt_pk_bf16(a1[0], a1[1]); w.w = cvt_pk_bf16(a1[2], a1[3]);
            *(u32x4*)(Z + (size_t)row * ZC + zc0 + lc) = w;
        EPI_LOOP_END
    }
};
struct EpiGate {
    bf16_t* O; const bf16_t* T; const bf16_t* Z; int gcol; int add;
    __device__ __forceinline__ void operator()(const f32x4 (&acc)[2][2][4][2], const Unit& u, int wr, int wc, int fr, int fq) const {
        EPI_LOOP_BEGIN
            const int col = u.pn * 256 + lc;
            const u32x4 gw = *(const u32x4*)(Z + (size_t)row * ZC + gcol + col);
            f32x4 a0, a1;
            a0[0] = bf_lo(gw.x) * v0[0]; a0[1] = bf_hi(gw.x) * v0[1]; a0[2] = bf_lo(gw.y) * v0[2]; a0[3] = bf_hi(gw.y) * v0[3];
            a1[0] = bf_lo(gw.z) * v1[0]; a1[1] = bf_hi(gw.z) * v1[1]; a1[2] = bf_lo(gw.w) * v1[2]; a1[3] = bf_hi(gw.w) * v1[3];
            if (add) { const u32x4 tw = *(const u32x4*)(T + (size_t)row * DM + col);
                a0[0] += bf_lo(tw.x); a0[1] += bf_hi(tw.x); a0[2] += bf_lo(tw.y); a0[3] += bf_hi(tw.y); a1[0] += bf_lo(tw.z); a1[1] += bf_hi(tw.z); a1[2] += bf_lo(tw.w); a1[3] += bf_hi(tw.w); }
            u32x4 w; w.x = cvt_pk_bf16(a0[0], a0[1]); w.y = cvt_pk_bf16(a0[2], a0[3]); w.z = cvt_pk_bf16(a1[0], a1[1]); w.w = cvt_pk_bf16(a1[2], a1[3]);
            *(u32x4*)(O + (size_t)row * DM + col) = w;
        EPI_LOOP_END
    }
};
#define EPI_SLAB_PATH \
        if (u.ks >= 0) { float* sl = SL + (size_t)u.ks * NSAMPLE * DM; \
            EPI_LOOP_BEGIN \
                float* dp = sl + (size_t)(row - NPROMPT) * DM + u.pn * 256 + lc; *(f32x4*)dp = v0; *(f32x4*)(dp + 4) = v1; \
            EPI_LOOP_END \
            return; }
struct EpiResX {
    bf16_t* R; const float* xp; const float* xs; float* SL;
    __device__ __forceinline__ void operator()(const f32x4 (&acc)[2][2][4][2], const Unit& u, int wr, int wc, int fr, int fq) const {
        EPI_SLAB_PATH
        EPI_LOOP_BEGIN
            const int col = u.pn * 256 + lc;
            const float* xr = (row < NPROMPT ? xp + (size_t)row * DM : xs + (size_t)(row - NPROMPT) * DM) + col;
            const f32x4 x0 = *(const f32x4*)xr, x1 = *(const f32x4*)(xr + 4);
            const f32x4 a0 = x0 * ALPHA + v0, a1 = x1 * ALPHA + v1;
            u32x4 w; w.x = cvt_pk_bf16(a0[0], a0[1]); w.y = cvt_pk_bf16(a0[2], a0[3]); w.z = cvt_pk_bf16(a1[0], a1[1]); w.w = cvt_pk_bf16(a1[2], a1[3]);
            *(u32x4*)(R + (size_t)row * DM + col) = w;
        EPI_LOOP_END
    }
};
struct EpiResB {
    bf16_t* R; const bf16_t* X1; float* SL;
    __device__ __forceinline__ void operator()(const f32x4 (&acc)[2][2][4][2], const Unit& u, int wr, int wc, int fr, int fq) const {
        EPI_SLAB_PATH
        EPI_LOOP_BEGIN
            const int col = u.pn * 256 + lc;
            const u32x4 xw = *(const u32x4*)(X1 + (size_t)row * DM + col);
            f32x4 a0, a1;
            a0[0] = bf_lo(xw.x) * ALPHA + v0[0]; a0[1] = bf_hi(xw.x) * ALPHA + v0[1]; a0[2] = bf_lo(xw.y) * ALPHA + v0[2]; a0[3] = bf_hi(xw.y) * ALPHA + v0[3];
            a1[0] = bf_lo(xw.z) * ALPHA + v1[0]; a1[1] = bf_hi(xw.z) * ALPHA + v1[1]; a1[2] = bf_lo(xw.w) * ALPHA + v1[2]; a1[3] = bf_hi(xw.w) * ALPHA + v1[3];
            u32x4 w; w.x = cvt_pk_bf16(a0[0], a0[1]); w.y = cvt_pk_bf16(a0[2], a0[3]); w.z = cvt_pk_bf16(a1[0], a1[1]); w.w = cvt_pk_bf16(a1[2], a1[3]);
            *(u32x4*)(R + (size_t)row * DM + col) = w;
        EPI_LOOP_END
    }
};
struct EpiHid {
    bf16_t* Hd;
    __device__ __forceinline__ void operator()(const f32x4 (&acc)[2][2][4][2], const Unit& u, int wr, int wc, int fr, int fq) const {
        EPI_LOOP_BEGIN
            const int col = u.pn * 256 + lc;
            f32x4 a0, a1;
#pragma unroll
            for (int j = 0; j < 4; ++j) { const float r0 = fmaxf(v0[j], 0.f), r1 = fmaxf(v1[j], 0.f); a0[j] = r0 * r0; a1[j] = r1 * r1; }
            u32x4 w; w.x = cvt_pk_bf16(a0[0], a0[1]); w.y = cvt_pk_bf16(a0[2], a0[3]); w.z = cvt_pk_bf16(a1[0], a1[1]); w.w = cvt_pk_bf16(a1[2], a1[3]);
            *(u32x4*)(Hd + (size_t)row * DFF + col) = w;
        EPI_LOOP_END
    }
};

__device__ __forceinline__ void transpose_item(const float* W, int ldw, int K, int src0, bf16_t* WT, int dst0, int kb, float scale, LAS float* scr, int lane) {
    const int k0 = kb * 64;
#pragma unroll 8
    for (int i = 0; i < 32; ++i) { const int kk = 2 * i + (lane >> 5); scr[kk * 33 + (lane & 31)] = W[(size_t)(k0 + kk) * ldw + src0 + (lane & 31)]; }
    LDS_WAIT();
    const int c = lane & 7;
#pragma unroll
    for (int j = 0; j < 4; ++j) { const int n = (lane >> 3) + 8 * j; const LAS float* s = scr + (8 * c) * 33 + n;
        u32x4 o; o.x = cvt_pk_bf16(s[0 * 33] * scale, s[1 * 33] * scale); o.y = cvt_pk_bf16(s[2 * 33] * scale, s[3 * 33] * scale);
        o.z = cvt_pk_bf16(s[4 * 33] * scale, s[5 * 33] * scale); o.w = cvt_pk_bf16(s[6 * 33] * scale, s[7 * 33] * scale);
        *(u32x4*)(WT + (size_t)(dst0 + n) * K + k0 + 8 * c) = o; }
    LDS_WAIT();
}
__device__ __forceinline__ void phase0(const Params& p, LAS unsigned char* lds) {
    const int tid = threadIdx.x, wid = tid >> 6, lane = tid & 63;
    const int gw = blockIdx.x * 8 + wid, NGW = gridDim.x * 8;
    LAS float* scr = (LAS float*)(lds + wid * 8704);
    LAS float* wg = (LAS float*)(lds + 73728);
    for (int e = tid; e < 2048; e += 512) { const int k = e >> 1, hf = e & 1; *(LAS f32x4*)(wg + k * 8 + hf * 4) = *(const f32x4*)(p.w_in + (size_t)k * DIN + 7168 + hf * 4); }
    __syncthreads();
    bf16_t* WIN = (bf16_t*)(p.ws + WS_WIN);
    constexpr int I_IN = 72 * 4 * 16, I_SQ = 32 * 16, I_F1 = 128 * 16, I_F2 = 32 * 64;
    constexpr int NITEMS = I_IN + 3 * I_SQ + I_F1 + I_F2;
    for (int it = gw; it < NITEMS; it += NGW) {
        int r = it;
        if (r < I_IN) { const int kb = r & 15, nb = r >> 4, g = nb >> 2, sub = nb & 3;
            int src; if (g < 8) src = g * 128; else if (g < 24) { const int pr = (g - 8) >> 1, hf = (g - 8) & 1; src = (hf ? 2048 : 1024) + pr * 128; } else if (g < 56) src = 3072 + (g - 24) * 128; else src = 7176 + (g - 56) * 128;
            const float sc = (g >= 32 && g < 40) ? 0.0625f : 1.0f;
            transpose_item(p.w_in, DIN, DM, src + sub * 32, WIN, g * 128 + sub * 32, kb, sc, scr, lane); continue; }
        r -= I_IN;
        if (r < 3 * I_SQ) { const int w = r / I_SQ, q = r % I_SQ, kb = q & 15, nb = q >> 4;
            const float* W = w == 0 ? p.w_co : (w == 1 ? p.w_mo : p.w_o); bf16_t* WT = (bf16_t*)(p.ws + (w == 0 ? WS_WC : (w == 1 ? WS_WM : WS_WO)));
            transpose_item(W, DM, DM, nb * 32, WT, nb * 32, kb, 1.0f, scr, lane); continue; }
        r -= 3 * I_SQ;
        if (r < I_F1) { const int kb = r & 15, nb = r >> 4; transpose_item(p.w_ff1, DFF, DM, nb * 32, (bf16_t*)(p.ws + WS_W1), nb * 32, kb, 1.0f, scr, lane); continue; }
        r -= I_F1;
        { const int kb = r & 63, nb = r >> 6; transpose_item(p.w_ff2, DM, DFF, nb * 32, (bf16_t*)(p.ws + WS_W2), nb * 32, kb, 1.0f, scr, lane); }
    }
    bf16_t* XB = (bf16_t*)(p.ws + WS_XB); float* G = (float*)(p.ws + WS_G);
    for (int r = gw; r < NTOK; r += NGW) {
        const float* xr = xrow(p, r);
        float g8[8];
#pragma unroll
        for (int j = 0; j < 8; ++j) g8[j] = 0.f;
#pragma unroll
        for (int j = 0; j < 4; ++j) { const int k = j * 256 + lane * 4; const f32x4 v = *(const f32x4*)(xr + k);
            u32x2 w; w.x = cvt_pk_bf16(v[0], v[1]); w.y = cvt_pk_bf16(v[2], v[3]); *(u32x2*)(XB + (size_t)r * DM + k) = w;
#pragma unroll
            for (int e = 0; e < 4; ++e) { const f32x4 wa = *(const LAS f32x4*)(wg + (k + e) * 8), wb = *(const LAS f32x4*)(wg + (k + e) * 8 + 4);
#pragma unroll
                for (int q = 0; q < 4; ++q) { g8[q] += v[e] * wa[q]; g8[4 + q] += v[e] * wb[q]; } } }
#pragma unroll
        for (int j = 0; j < 8; ++j) g8[j] = wave_sum(g8[j]);
        if (lane < 4) { G[(size_t)r * 8 + lane] = g8[0] * (lane == 0) + g8[1] * (lane == 1) + g8[2] * (lane == 2) + g8[3] * (lane == 3) + p.b_gate[lane]; }
        else if (lane < 8) { const float f = g8[4] * (lane == 4) + g8[5] * (lane == 5) + g8[6] * (lane == 6) + g8[7] * (lane == 7) + p.b_gate[lane];
            G[(size_t)r * 8 + lane] = fminf(f, 0.f) - log1pf(__expf(-fabsf(f))); }
    }
    __syncthreads();
}

constexpr int KS_LD = 264, VT_LD = 136;
constexpr int L_KSH = 0, L_CT = 128 * KS_LD * 2, L_VT = L_CT + 48 * KS_LD * 2, L_VW = L_VT + 48 * VT_LD * 2, L_SC = L_VW + 48 * VT_LD * 2;
__device__ __forceinline__ void mlstm_prompt_item(const Params& p, LAS unsigned char* lds, int bh, int vs) {
    const int tid = threadIdx.x, wid = __builtin_amdgcn_readfirstlane(tid >> 6), lane = tid & 63, li = lane & 15, kg = lane >> 4;
    const int b = bh >> 2, h = bh & 3, j0 = vs * 32;
    LAS bf16_t* Ksh = (LAS bf16_t*)(lds + L_KSH); LAS bf16_t* CTsh = (LAS bf16_t*)(lds + L_CT); LAS bf16_t* VTsh = (LAS bf16_t*)(lds + L_VT); LAS bf16_t* VWsh = (LAS bf16_t*)(lds + L_VW);
    LAS float* sA = (LAS float*)(lds + L_SC); LAS float* sG = sA + 128; LAS float* sB = sG + 128;
    const bf16_t* QH = (const bf16_t*)(p.ws + WS_QKV) + (size_t)bh * SEQ * 256; const bf16_t* KH = QH + (size_t)NTOK * DM; const bf16_t* VH = KH + (size_t)NTOK * DM;
    const float* G = (const float*)(p.ws + WS_G) + (size_t)b * SEQ * 8; bf16_t* H = (bf16_t*)(p.ws + WS_H);
    for (int e = tid; e < 48 * KS_LD / 2; e += 512) ((LAS unsigned*)CTsh)[e] = 0u;
    for (int e = tid; e < 16 * VT_LD; e += 512) { const int rr = e / VT_LD; VTsh[32 * VT_LD + e] = rr == 0 ? (bf16_t)0x3F80 : (bf16_t)0; VWsh[32 * VT_LD + e] = 0; }
    f32x4 Cacc[2][3];
#pragma unroll
    for (int db = 0; db < 2; ++db)
#pragma unroll
        for (int jb = 0; jb < 3; ++jb) Cacc[db][jb] = (f32x4){0.f, 0.f, 0.f, 0.f};
    float m_prev = 0.f;
    const int vs_s = tid >> 2, vs_q = tid & 3;
    u32x4 kp[8]; u32x4 vp; bf16x8 qf[8]; float gi0 = 0.f, gf0 = 0.f, gi1 = 0.f, gf1 = 0.f;
#pragma unroll
    for (int i = 0; i < 8; ++i) kp[i] = *(const u32x4*)(KH + (size_t)(i * 512 + tid) * 8);
    vp = *(const u32x4*)(VH + (size_t)vs_s * 256 + j0 + vs_q * 8);
#pragma unroll
    for (int kk = 0; kk < 8; ++kk) qf[kk] = *(const bf16x8*)(QH + (size_t)(16 * wid + li) * 256 + kk * 32 + kg * 8);
    if (wid == 0) { gi0 = G[(size_t)lane * 8 + h]; gf0 = G[(size_t)lane * 8 + 4 + h]; gi1 = G[(size_t)(64 + lane) * 8 + h]; gf1 = G[(size_t)(64 + lane) * 8 + 4 + h]; }
    for (int c = 0; c < 16; ++c) {
        const int t0 = c * 128, tn = (c < 15 ? c + 1 : c) * 128;
        if (wid == 0) {
            float b0 = gf0, b1 = gf1;
#pragma unroll
            for (int o = 1; o < 64; o <<= 1) { const float x0 = __shfl_up(b0, o), x1 = __shfl_up(b1, o); if (lane >= o) { b0 += x0; b1 += x1; } }
            b1 += __shfl(b0, 63);
            const float a0 = gi0 - b0, a1 = gi1 - b1;
            float p0 = a0, p1 = a1;
#pragma unroll
            for (int o = 1; o < 64; o <<= 1) { const float x0 = __shfl_up(p0, o), x1 = __shfl_up(p1, o); if (lane >= o) { p0 = fmaxf(p0, x0); p1 = fmaxf(p1, x1); } }
            p1 = fmaxf(p1, __shfl(p0, 63));
            sA[lane] = a0; sA[64 + lane] = a1; sG[lane] = fmaxf(m_prev, p0); sG[64 + lane] = fmaxf(m_prev, p1); sB[lane] = b0; sB[64 + lane] = b1;
            gi0 = G[(size_t)(tn + lane) * 8 + h]; gf0 = G[(size_t)(tn + lane) * 8 + 4 + h]; gi1 = G[(size_t)(tn + 64 + lane) * 8 + h]; gf1 = G[(size_t)(tn + 64 + lane) * 8 + 4 + h];
        }
        __syncthreads();
        const float g_last = sG[127], b_last = sB[127];
#pragma unroll
        for (int i = 0; i < 8; ++i) { const int pc = i * 512 + tid, row = pc >> 5, c8 = pc & 31; *(LAS u32x4*)(Ksh + row * KS_LD + c8 * 8) = kp[i]; }
        {
            const float wsv = __expf(sA[vs_s] - g_last);
            const unsigned vw[4] = {vp.x, vp.y, vp.z, vp.w};
#pragma unroll
            for (int e = 0; e < 4; ++e) { const int j = vs_q * 8 + 2 * e; const float lo = bf_lo(vw[e]), hi = bf_hi(vw[e]);
                VTsh[j * VT_LD + vs_s] = (bf16_t)(vw[e] & 0xffff); VTsh[(j + 1) * VT_LD + vs_s] = (bf16_t)(vw[e] >> 16);
                const unsigned sw = cvt_pk_bf16(lo * wsv, hi * wsv);
                VWsh[j * VT_LD + vs_s] = (bf16_t)(sw & 0xffff); VWsh[(j + 1) * VT_LD + vs_s] = (bf16_t)(sw >> 16); }
            if (vs_q == 0) VWsh[32 * VT_LD + vs_s] = (bf16_t)(cvt_pk_bf16(wsv, 0.f) & 0xffff);
        }
#pragma unroll
        for (int i = 0; i < 8; ++i) kp[i] = *(const u32x4*)(KH + (size_t)tn * 256 + (size_t)(i * 512 + tid) * 8);
        vp = *(const u32x4*)(VH + (size_t)(tn + vs_s) * 256 + j0 + vs_q * 8);
        __syncthreads();
        {
            const int t_loc = 16 * wid + li;
            const float g_t = sG[t_loc], b_t = sB[t_loc];
            f32x4 ST[8];
#pragma unroll
            for (int sb = 0; sb < 8; ++sb) ST[sb] = (f32x4){0.f, 0.f, 0.f, 0.f};
#pragma unroll
            for (int kk = 0; kk < 8; ++kk) {
#pragma unroll
                for (int hf = 0; hf < 2; ++hf) {
                    bf16x8 kf[4];
#pragma unroll
                    for (int sb = 0; sb < 4; ++sb) kf[sb] = *(const LAS bf16x8*)(Ksh + ((hf * 4 + sb) * 16 + li) * KS_LD + kk * 32 + kg * 8);
#pragma unroll
                    for (int sb = 0; sb < 4; ++sb) ST[hf * 4 + sb] = __builtin_amdgcn_mfma_f32_16x16x32_bf16(kf[sb], qf[kk], ST[hf * 4 + sb], 0, 0, 0);
                }
            }
#pragma unroll
            for (int sb = 0; sb < 8; ++sb) { const f32x4 av = *(const LAS f32x4*)(sA + sb * 16 + kg * 4);
#pragma unroll
                for (int r = 0; r < 4; ++r) { const float wgt = __expf(av[r] - g_t); const bool ok = (sb * 16 + kg * 4 + r) <= t_loc; ST[sb][r] = ok ? ST[sb][r] * wgt : 0.f; } }
            f32x4 nt[3], it[3];
#pragma unroll
            for (int jb = 0; jb < 3; ++jb) { nt[jb] = (f32x4){0.f, 0.f, 0.f, 0.f}; it[jb] = (f32x4){0.f, 0.f, 0.f, 0.f}; }
#pragma unroll
            for (int k2 = 0; k2 < 4; ++k2) {
                u32x4 pw; pw.x = cvt_pk_bf16(ST[2 * k2][0], ST[2 * k2][1]); pw.y = cvt_pk_bf16(ST[2 * k2][2], ST[2 * k2][3]);
                pw.z = cvt_pk_bf16(ST[2 * k2 + 1][0], ST[2 * k2 + 1][1]); pw.w = cvt_pk_bf16(ST[2 * k2 + 1][2], ST[2 * k2 + 1][3]);
                bf16x8 pf; __builtin_memcpy(&pf, &pw, 16);
#pragma unroll
                for (int jb = 0; jb < 3; ++jb) { const LAS bf16_t* vr = VTsh + (jb * 16 + li) * VT_LD + k2 * 32 + kg * 4;
                    u32x4 vw4; const u32x2 lo = *(const LAS u32x2*)vr, hi = *(const LAS u32x2*)(vr + 16); vw4.x = lo.x; vw4.y = lo.y; vw4.z = hi.x; vw4.w = hi.y;
                    bf16x8 vf; __builtin_memcpy(&vf, &vw4, 16);
                    nt[jb] = __builtin_amdgcn_mfma_f32_16x16x32_bf16(vf, pf, nt[jb], 0, 0, 0); } }
#pragma unroll
            for (int kk = 0; kk < 8; ++kk)
#pragma unroll
                for (int jb = 0; jb < 3; ++jb) { const bf16x8 cf = *(const LAS bf16x8*)(CTsh + (jb * 16 + li) * KS_LD + kk * 32 + kg * 8);
                    it[jb] = __builtin_amdgcn_mfma_f32_16x16x32_bf16(cf, qf[kk], it[jb], 0, 0, 0); }
#pragma unroll
            for (int kk = 0; kk < 8; ++kk) qf[kk] = *(const bf16x8*)(QH + (size_t)(tn + 16 * wid + li) * 256 + kk * 32 + kg * 8);
            const float w_int = __expf(m_prev - g_t);
#pragma unroll
            for (int jb = 0; jb < 3; ++jb) nt[jb] = nt[jb] + it[jb] * w_int;
            const float den = __shfl(nt[2][0], li);
            const float rden = 1.0f / fmaxf(fabsf(den), __expf(-(b_t + g_t)));
#pragma unroll
            for (int jb = 0; jb < 2; ++jb) { u32x2 w; w.x = cvt_pk_bf16(nt[jb][0] * rden, nt[jb][1] * rden); w.y = cvt_pk_bf16(nt[jb][2] * rden, nt[jb][3] * rden);
                *(u32x2*)(H + (size_t)(b * SEQ + t0 + t_loc) * DM + h * 256 + j0 + jb * 16 + kg * 4) = w; }
        }
        __syncthreads();
        {
            const float decay = __expf(m_prev - g_last);
#pragma unroll
            for (int db = 0; db < 2; ++db)
#pragma unroll
                for (int jb = 0; jb < 3; ++jb) Cacc[db][jb] = Cacc[db][jb] * decay;
            u32x2 kt2[2][4][2];
            {
                const unsigned tb = (unsigned)(uintptr_t)(lds + L_KSH) + (unsigned)(((kg * 8 + (li >> 2)) * KS_LD + (2 * wid) * 16 + 4 * (li & 3)) * 2);
#pragma unroll
                for (int db = 0; db < 2; ++db)
#pragma unroll
                    for (int k2 = 0; k2 < 4; ++k2)
#pragma unroll
                        for (int hf = 0; hf < 2; ++hf)
                            asm volatile("ds_read_b64_tr_b16 %0, %1 offset:%2" : "=&v"(kt2[db][k2][hf]) : "v"(tb), "i"(((k2 * 32 + hf * 4) * KS_LD + db * 16) * 2) : "memory");
#pragma unroll
                for (int db = 0; db < 2; ++db)
                    asm volatile("s_waitcnt lgkmcnt(0)" : "+v"(kt2[db][0][0]), "+v"(kt2[db][0][1]), "+v"(kt2[db][1][0]), "+v"(kt2[db][1][1]), "+v"(kt2[db][2][0]), "+v"(kt2[db][2][1]), "+v"(kt2[db][3][0]), "+v"(kt2[db][3][1]) :: "memory");
            }
#pragma unroll
            for (int k2 = 0; k2 < 4; ++k2)
#pragma unroll
                for (int jb = 0; jb < 3; ++jb) { const bf16x8 vf = *(const LAS bf16x8*)(VWsh + (jb * 16 + li) * VT_LD + k2 * 32 + kg * 8);
#pragma unroll
                    for (int db = 0; db < 2; ++db) { u32x4 kw; kw.x = kt2[db][k2][0].x; kw.y = kt2[db][k2][0].y; kw.z = kt2[db][k2][1].x; kw.w = kt2[db][k2][1].y; bf16x8 kf8; __builtin_memcpy(&kf8, &kw, 16);
                        Cacc[db][jb] = __builtin_amdgcn_mfma_f32_16x16x32_bf16(kf8, vf, Cacc[db][jb], 0, 0, 0); } }
#pragma unroll
            for (int db = 0; db < 2; ++db)
#pragma unroll
                for (int jb = 0; jb < 3; ++jb) { u32x2 w; w.x = cvt_pk_bf16(Cacc[db][jb][0], Cacc[db][jb][1]); w.y = cvt_pk_bf16(Cacc[db][jb][2], Cacc[db][jb][3]);
                    *(LAS u32x2*)(CTsh + (jb * 16 + li) * KS_LD + (2 * wid + db) * 16 + kg * 4) = w; }
            m_prev = b_last + g_last;
        }
    }
#pragma unroll
    for (int db = 0; db < 2; ++db) { const int d0 = (2 * wid + db) * 16 + kg * 4;
#pragma unroll
        for (int jb = 0; jb < 2; ++jb)
#pragma unroll
            for (int r = 0; r < 4; ++r) p.out[O_CP + ((size_t)(bh * 256 + d0 + r)) * 256 + j0 + jb * 16 + li] = Cacc[db][jb][r];
        if (vs == 0 && li == 0) {
#pragma unroll
            for (int r = 0; r < 4; ++r) p.out[O_NP + (size_t)bh * 256 + d0 + r] = Cacc[db][2][r]; } }
    if (vs == 0 && tid == 0) p.out[O_MP + bh] = m_prev;
    __syncthreads();
}

__device__ __forceinline__ void mlstm_sample_item(const Params& p, LAS unsigned char* lds, int item) {
    const int tid = threadIdx.x, bs = item >> 2, h = item & 3, tok0 = NPROMPT + bs * 4;
    LAS float* sq = (LAS float*)lds; LAS float* sk = sq + 1024; LAS float* sv = sk + 1024; LAS float* sn0 = sv + 1024; LAS float* sdot = sn0 + 256; LAS float* sc = sdot + 32; LAS float* sred = sc + 64;
    const bf16_t* QS = (const bf16_t*)(p.ws + WS_QKV) + ((size_t)HM_SAMPLE0 + (size_t)item * 4) * 256;
    const float* G = (const float*)(p.ws + WS_G); bf16_t* H = (bf16_t*)(p.ws + WS_H);
    const int c4 = tid & 63, rw = tid >> 6, col = c4 * 4;
    const float* C0 = p.sC + (size_t)item * 65536 + (size_t)(rw * 32) * 256 + col; float* C1 = p.out + O_CS + (size_t)item * 65536 + (size_t)(rw * 32) * 256 + col;
    f32x4 cv[8];
#pragma unroll
    for (int j = 0; j < 8; ++j) cv[j] = __builtin_nontemporal_load((const f32x4*)(C0 + j * 256));
    for (int e = tid; e < 3072; e += 512) { const int which = e >> 10, idx = e & 1023; sq[e] = bf2f(QS[(size_t)which * NTOK * DM + idx]); }
    if (tid < 256) sn0[tid] = p.sn[(size_t)item * 256 + tid];
    __syncthreads();
    {
        const int id = tid >> 4, part = tid & 15;
        if (id < 20) { const LAS float* va = id < 16 ? sq + (id >> 2) * 256 : sq + (id - 16) * 256; const LAS float* vb = id < 16 ? sk + (id & 3) * 256 : sn0;
            float s = 0.f;
#pragma unroll
            for (int e = 0; e < 16; ++e) s += va[part * 16 + e] * vb[part * 16 + e];
            s += __shfl_xor(s, 8); s += __shfl_xor(s, 4); s += __shfl_xor(s, 2); s += __shfl_xor(s, 1);
            if (part == 0) sdot[id] = s; }
    }
    __syncthreads();
    if (tid == 0) {
        const float m0 = p.sm[item];
        float li_[4], lf_[4], bb[4], aa[4], gg[4];
#pragma unroll
        for (int s = 0; s < 4; ++s) { li_[s] = G[(size_t)(tok0 + s) * 8 + h]; lf_[s] = G[(size_t)(tok0 + s) * 8 + 4 + h]; }
        float cum = 0.f, pm = m0;
#pragma unroll
        for (int s = 0; s < 4; ++s) { cum += lf_[s]; bb[s] = cum; aa[s] = li_[s] - cum; pm = fmaxf(pm, aa[s]); gg[s] = pm; }
#pragma unroll
        for (int t = 0; t < 4; ++t) { const float wi = __expf(m0 - gg[t]); float den = wi * sdot[16 + t];
#pragma unroll
            for (int s = 0; s < 4; ++s) { const float S = s <= t ? sdot[t * 4 + s] * __expf(aa[s] - gg[t]) : 0.f; sc[16 + t * 4 + s] = S; den += S; }
            sc[t] = wi; sc[12 + t] = 1.0f / fmaxf(fabsf(den), __expf(-(bb[t] + gg[t]))); }
#pragma unroll
        for (int s = 0; s < 4; ++s) sc[4 + s] = __expf(aa[s] - gg[3]);
        sc[8] = __expf(m0 - gg[3]); sc[9] = bb[3] + gg[3];
    }
    __syncthreads();
    const float decay = sc[8]; const float ws0 = sc[4], ws1 = sc[5], ws2 = sc[6], ws3 = sc[7];
    const f32x4 v0 = *(const LAS f32x4*)(sv + col), v1 = *(const LAS f32x4*)(sv + 256 + col), v2 = *(const LAS f32x4*)(sv + 512 + col), v3 = *(const LAS f32x4*)(sv + 768 + col);
    f32x4 a0 = {0.f, 0.f, 0.f, 0.f}, a1 = a0, a2 = a0, a3 = a0;
#pragma unroll
    for (int rb = 0; rb < 4; ++rb) {
        f32x4 cn[8];
        if (rb < 3) {
#pragma unroll
            for (int j = 0; j < 8; ++j) cn[j] = __builtin_nontemporal_load((const f32x4*)(C0 + ((rb + 1) * 8 + j) * 256));
        }
#pragma unroll
        for (int j = 0; j < 8; ++j) { const int d = rw * 32 + rb * 8 + j; const f32x4 x = cv[j];
            a0 += x * sq[d]; a1 += x * sq[256 + d]; a2 += x * sq[512 + d]; a3 += x * sq[768 + d];
            const f32x4 y = x * decay + v0 * (ws0 * sk[d]) + v1 * (ws1 * sk[256 + d]) + v2 * (ws2 * sk[512 + d]) + v3 * (ws3 * sk[768 + d]);
            __builtin_nontemporal_store(y, (f32x4*)(C1 + (rb * 8 + j) * 256)); }
        if (rb < 3) {
#pragma unroll
            for (int j = 0; j < 8; ++j) cv[j] = cn[j];
        }
    }
    *(LAS f32x4*)(sred + (rw * 4 + 0) * 256 + col) = a0; *(LAS f32x4*)(sred + (rw * 4 + 1) * 256 + col) = a1; *(LAS f32x4*)(sred + (rw * 4 + 2) * 256 + col) = a2; *(LAS f32x4*)(sred + (rw * 4 + 3) * 256 + col) = a3;
    __syncthreads();
#pragma unroll
    for (int e = 0; e < 2; ++e) { const int o = tid + 512 * e, t = o >> 8, cx = o & 255;
        float inter = 0.f;
#pragma unroll
        for (int w = 0; w < 8; ++w) inter += sred[(w * 4 + t) * 256 + cx];
        float num = sc[t] * inter;
#pragma unroll
        for (int s = 0; s < 4; ++s) num += sc[16 + t * 4 + s] * sv[s * 256 + cx];
        H[(size_t)(tok0 + t) * DM + h * 256 + cx] = (bf16_t)(cvt_pk_bf16(num * sc[12 + t], 0.f) & 0xffff); }
    if (tid < 256) p.out[O_NS + (size_t)item * 256 + tid] = decay * sn0[tid] + ws0 * sk[tid] + ws1 * sk[256 + tid] + ws2 * sk[512 + tid] + ws3 * sk[768 + tid];
    if (tid == 0) p.out[O_MS + item] = sc[9];
    __syncthreads();
}

__device__ __forceinline__ void conv_unit(const Params& p, const bf16_t* Z, bf16_t* AC, int r, int ch, const float (&cw)[24], u32x4 uw, u32x4 bw, u32x4 w1, u32x4 w2) {
    float u0[8], u1[8], u2[8], bg[8];
    const unsigned uu[4] = {uw.x, uw.y, uw.z, uw.w}, bb[4] = {bw.x, bw.y, bw.z, bw.w}, q1[4] = {w1.x, w1.y, w1.z, w1.w}, q2[4] = {w2.x, w2.y, w2.z, w2.w};
#pragma unroll
    for (int e = 0; e < 4; ++e) { u2[2 * e] = bf_lo(uu[e]); u2[2 * e + 1] = bf_hi(uu[e]); bg[2 * e] = bf_lo(bb[e]); bg[2 * e + 1] = bf_hi(bb[e]);
        u1[2 * e] = bf_lo(q1[e]); u1[2 * e + 1] = bf_hi(q1[e]); u0[2 * e] = bf_lo(q2[e]); u0[2 * e + 1] = bf_hi(q2[e]); }
    const bool prompt = r < NPROMPT; const int t = prompt ? (r & 2047) : ((r - NPROMPT) & 3); const int bs = (r - NPROMPT) >> 2;
    if (t < 1) { if (prompt) {
#pragma unroll
            for (int e = 0; e < 8; ++e) u1[e] = 0.f; }
        else { const float* sp = p.sconv + ((size_t)bs * 2 + 1) * DM + ch;
#pragma unroll
            for (int e = 0; e < 8; ++e) u1[e] = sp[e]; } }
    if (t < 2) { if (prompt) {
#pragma unroll
            for (int e = 0; e < 8; ++e) u0[e] = 0.f; }
        else { const float* sp = p.sconv + ((size_t)bs * 2 + t) * DM + ch;
#pragma unroll
            for (int e = 0; e < 8; ++e) u0[e] = sp[e]; } }
    float o[8];
#pragma unroll
    for (int e = 0; e < 8; ++e) o[e] = bg[e] * (cw[e] * u0[e] + cw[8 + e] * u1[e] + cw[16 + e] * u2[e]);
    u32x4 w; w.x = cvt_pk_bf16(o[0], o[1]); w.y = cvt_pk_bf16(o[2], o[3]); w.z = cvt_pk_bf16(o[4], o[5]); w.w = cvt_pk_bf16(o[6], o[7]);
    *(u32x4*)(AC + (size_t)r * DM + ch) = w;
    float* so = nullptr;
    if (prompt) { if (t >= SEQ - 2) so = p.out + O_CONVP + ((size_t)(r >> 11) * 2 + (t - (SEQ - 2))) * DM + ch; }
    else if (t >= 2) so = p.out + O_CONVS + ((size_t)bs * 2 + (t - 2)) * DM + ch;
    if (so) {
#pragma unroll
        for (int e = 0; e < 8; ++e) so[e] = u2[e]; }
}
__device__ __forceinline__ void conv_items(const Params& p) {
    const bf16_t* Z = (const bf16_t*)(p.ws + WS_Z); bf16_t* AC = (bf16_t*)(p.ws + WS_AC);
    const int gt = blockIdx.x * 512 + threadIdx.x, NG = gridDim.x * 512;
    const int ch = (gt & 127) * 8, r0 = gt >> 7, rstep = NG >> 7;
    float cw[24];
#pragma unroll
    for (int e = 0; e < 8; ++e) { cw[e] = p.conv_w[ch + e]; cw[8 + e] = p.conv_w[DM + ch + e]; cw[16 + e] = p.conv_w[2 * DM + ch + e]; }
    for (int rb = r0; rb < NTOK; rb += 4 * rstep) {
        u32x4 uw[4], bw[4], w1[4], w2[4];
#pragma unroll
        for (int j = 0; j < 4; ++j) { const int r = rb + j * rstep; if (r < NTOK) { const int r1 = r >= 1 ? r - 1 : r, r2 = r >= 2 ? r - 2 : r;
            uw[j] = *(const u32x4*)(Z + (size_t)r * ZC + Z_U + ch); bw[j] = *(const u32x4*)(Z + (size_t)r * ZC + Z_BG + ch);
            w1[j] = *(const u32x4*)(Z + (size_t)r1 * ZC + Z_U + ch); w2[j] = *(const u32x4*)(Z + (size_t)r2 * ZC + Z_U + ch); } }
#pragma unroll
        for (int j = 0; j < 4; ++j) { const int r = rb + j * rstep; if (r < NTOK) conv_unit(p, Z, AC, r, ch, cw, uw[j], bw[j], w1[j], w2[j]); }
    }
}

__device__ __forceinline__ void hn_items(const Params& p) {
    const bf16_t* Z = (const bf16_t*)(p.ws + WS_Z); const bf16_t* H = (const bf16_t*)(p.ws + WS_H); bf16_t* HN = (bf16_t*)(p.ws + WS_HN);
    const int lane = threadIdx.x & 63, gw = blockIdx.x * 8 + (threadIdx.x >> 6), NGW = gridDim.x * 8, c0 = lane * 16;
    f32x4 mg[4];
#pragma unroll
    for (int j = 0; j < 4; ++j) mg[j] = *(const f32x4*)(p.mh_g + c0 + 4 * j);
    for (int r = gw; r < NTOK; r += NGW) {
        const u32x4 h0 = *(const u32x4*)(H + (size_t)r * DM + c0), h1 = *(const u32x4*)(H + (size_t)r * DM + c0 + 8);
        const u32x4 o0 = *(const u32x4*)(Z + (size_t)r * ZC + Z_O + c0), o1 = *(const u32x4*)(Z + (size_t)r * ZC + Z_O + c0 + 8);
        const unsigned hw[8] = {h0.x, h0.y, h0.z, h0.w, h1.x, h1.y, h1.z, h1.w}, ow[8] = {o0.x, o0.y, o0.z, o0.w, o1.x, o1.y, o1.z, o1.w};
        float v[16]; float s = 0.f;
#pragma unroll
        for (int e = 0; e < 8; ++e) { v[2 * e] = bf_lo(hw[e]); v[2 * e + 1] = bf_hi(hw[e]); s += v[2 * e] + v[2 * e + 1]; }
        s += __shfl_xor(s, 1); s += __shfl_xor(s, 2); s += __shfl_xor(s, 4); s += __shfl_xor(s, 8);
        const float mean = s * (1.0f / 256.0f); float q = 0.f;
#pragma unroll
        for (int e = 0; e < 16; ++e) { v[e] -= mean; q += v[e] * v[e]; }
        q += __shfl_xor(q, 1); q += __shfl_xor(q, 2); q += __shfl_xor(q, 4); q += __shfl_xor(q, 8);
        const float rstd = 1.0f / sqrtf(q * (1.0f / 256.0f) + LN_EPS);
        unsigned ww[8];
#pragma unroll
        for (int e = 0; e < 8; ++e) { const float g0 = mg[(2 * e) >> 2][(2 * e) & 3], g1 = mg[(2 * e + 1) >> 2][(2 * e + 1) & 3];
            ww[e] = cvt_pk_bf16(v[2 * e] * rstd * g0 * bf_lo(ow[e]), v[2 * e + 1] * rstd * g1 * bf_hi(ow[e])); }
        u32x4 w0, w1; w0.x = ww[0]; w0.y = ww[1]; w0.z = ww[2]; w0.w = ww[3]; w1.x = ww[4]; w1.y = ww[5]; w1.z = ww[6]; w1.w = ww[7];
        *(u32x4*)(HN + (size_t)r * DM + c0) = w0; *(u32x4*)(HN + (size_t)r * DM + c0 + 8) = w1;
    }
}

template <bool OUT_F32>
__device__ __forceinline__ void ln_rows(const bf16_t* R, const float* gam, const float* bet, void* out, const float* SL, int NS, const float* xs, const bf16_t* X1) {
    const int lane = threadIdx.x & 63, gw = blockIdx.x * 8 + (threadIdx.x >> 6), NGW = gridDim.x * 8;
    f32x4 gv[4], bv[4];
#pragma unroll
    for (int j = 0; j < 4; ++j) { gv[j] = *(const f32x4*)(gam + j * 256 + lane * 4); bv[j] = *(const f32x4*)(bet + j * 256 + lane * 4); }
    for (int r = gw; r < NTOK; r += NGW) {
        f32x4 v[4]; float s = 0.f;
        if (r < NPROMPT) {
#pragma unroll
            for (int j = 0; j < 4; ++j) { const u32x2 w = *(const u32x2*)(R + (size_t)r * DM + j * 256 + lane * 4); v[j] = (f32x4){bf_lo(w.x), bf_hi(w.x), bf_lo(w.y), bf_hi(w.y)}; }
        } else {
            const int rs = r - NPROMPT;
#pragma unroll
            for (int j = 0; j < 4; ++j) { const int cc = j * 256 + lane * 4;
                if (xs) v[j] = *(const f32x4*)(xs + (size_t)rs * DM + cc) * ALPHA;
                else { const u32x2 w = *(const u32x2*)(X1 + (size_t)r * DM + cc); v[j] = (f32x4){bf_lo(w.x), bf_hi(w.x), bf_lo(w.y), bf_hi(w.y)} * ALPHA; }
                for (int k = 0; k < NS; ++k) v[j] += *(const f32x4*)(SL + ((size_t)k * NSAMPLE + rs) * DM + cc); }
        }
#pragma unroll
        for (int j = 0; j < 4; ++j) s += (v[j][0] + v[j][1]) + (v[j][2] + v[j][3]);
        const float mean = wave_sum(s) * (1.0f / DM); float q = 0.f;
#pragma unroll
        for (int j = 0; j < 4; ++j) { v[j] = v[j] - mean; q += (v[j][0] * v[j][0] + v[j][1] * v[j][1]) + (v[j][2] * v[j][2] + v[j][3] * v[j][3]); }
        const float rstd = 1.0f / sqrtf(wave_sum(q) * (1.0f / DM) + LN_EPS);
#pragma unroll
        for (int j = 0; j < 4; ++j) { const f32x4 y = v[j] * rstd * gv[j] + bv[j];
            if (OUT_F32) *(f32x4*)((float*)out + (size_t)r * DM + j * 256 + lane * 4) = y;
            else { u32x2 w; w.x = cvt_pk_bf16(y[0], y[1]); w.y = cvt_pk_bf16(y[2], y[3]); *(u32x2*)((bf16_t*)out + (size_t)r * DM + j * 256 + lane * 4) = w; } }
    }
}

__global__ void __launch_bounds__(512, 2) mega(Params p) {
    extern __shared__ __attribute__((aligned(16))) unsigned char shm_raw[];
    LAS unsigned char* lds = (LAS unsigned char*)shm_raw;
    const int G = gridDim.x, c = blockIdx.x;
    unsigned char* ws = p.ws;
    volatile LAS unsigned* xst = (volatile LAS unsigned*)(lds + 131072);
    if (threadIdx.x == 0) { xst[0] = 0u; xst[1] = 0u; }
    __syncthreads();
    const XcdBarrier xb = xcd_barrier_post((unsigned*)(ws + WS_BAR), xst);
    if (p.ph_hi > 64) cg::this_grid().sync();
#if MK_MULTI
#define PH_SYNC(k)
#else
#define PH_SYNC(k) do { if (p.ph_lo <= (k) && (k) + 1 < p.ph_hi) xcd_barrier(xb); } while (0)
#endif
#define PH_ON(k) (((PHMASK >> (k)) & 1) && p.ph_lo <= (k) && (k) < p.ph_hi)
#ifndef REPMASK
#define REPMASK 0
#endif
    if (PH_ON(0)) phase0(p, lds);
    PH_SYNC(0);
    if (PH_ON(1)) { pg8::StaticOrder S; S.init(NTOK, NZ, DM, G, c); pg8::Gemm g{(const bf16_t*)(ws + WS_XB), (const bf16_t*)(ws + WS_WIN), NTOK, NZ, DM};
        EpiZ E{(bf16_t*)(ws + WS_Z), (bf16_t*)(ws + WS_QKV), (bf16_t*)(ws + WS_KT)}; pg8::gemm_phase(lds, g, S, E); }
    PH_SYNC(1);
    if (PH_ON(2)) {
        const bool sample_first = ((c >> 6) & 1) != 0;
        if (sample_first) { for (int it = c; it < 512; it += G) mlstm_sample_item(p, lds, it); }
        for (int it = c; it < 256; it += G) { const int xcd = it & 7, idx = it >> 3; mlstm_prompt_item(p, lds, xcd * 4 + (idx >> 3), idx & 7); }
        if (!sample_first) { for (int it = c; it < 512; it += G) mlstm_sample_item(p, lds, it); }
        conv_items(p);
    }
    PH_SYNC(2);
    if (PH_ON(3)) { hn_items(p);
        pg8::StaticOrder S; S.init(NTOK, DM, DM, G, c); pg8::Gemm g{(const bf16_t*)(ws + WS_AC), (const bf16_t*)(ws + WS_WC), NTOK, DM, DM};
        EpiGate E{(bf16_t*)(ws + WS_XB), nullptr, (const bf16_t*)(ws + WS_Z), Z_GC, 0}; pg8::gemm_phase(lds, g, S, E); }
    PH_SYNC(3);
    if (PH_ON(4)) { pg8::StaticOrder S; S.init(NTOK, DM, DM, G, c); pg8::Gemm g{(const bf16_t*)(ws + WS_HN), (const bf16_t*)(ws + WS_WM), NTOK, DM, DM};
        EpiGate E{(bf16_t*)(ws + WS_AC), (const bf16_t*)(ws + WS_XB), (const bf16_t*)(ws + WS_Z), Z_GM, 1}; pg8::gemm_phase(lds, g, S, E); }
    PH_SYNC(4);
    if (PH_ON(5)) { pg8::SplitOrder S; S.init(DM, 4, G, c); pg8::Gemm g{(const bf16_t*)(ws + WS_AC), (const bf16_t*)(ws + WS_WO), NTOK, DM, DM};
        EpiResX E{(bf16_t*)(ws + WS_R), p.xp, p.xs, (float*)(ws + WS_KT)}; pg8::gemm_phase(lds, g, S, E); }
    PH_SYNC(5);
    if (PH_ON(6)) ln_rows<false>((const bf16_t*)(ws + WS_R), p.ln1g, p.ln1b, ws + WS_H, (const float*)(ws + WS_KT), 4, p.xs, nullptr);
    PH_SYNC(6);
    if (PH_ON(7)) { pg8::StaticOrder S; S.init(NTOK, DFF, DM, G, c); pg8::Gemm g{(const bf16_t*)(ws + WS_H), (const bf16_t*)(ws + WS_W1), NTOK, DFF, DM};
        EpiHid E{(bf16_t*)(ws + WS_HID)}; pg8::gemm_phase(lds, g, S, E); }
    PH_SYNC(7);
    if (PH_ON(8)) { pg8::SplitOrder S; S.init(DFF, 16, G, c); pg8::Gemm g{(const bf16_t*)(ws + WS_HID), (const bf16_t*)(ws + WS_W2), NTOK, DM, DFF};
        EpiResB E{(bf16_t*)(ws + WS_R), (const bf16_t*)(ws + WS_H), (float*)(ws + WS_KT)}; pg8::gemm_phase(lds, g, S, E); }
    PH_SYNC(8);
    if (PH_ON(9)) ln_rows<true>((const bf16_t*)(ws + WS_R), p.ln2g, p.ln2b, p.out + O_Y, (const float*)(ws + WS_KT), 16, nullptr, (const bf16_t*)(ws + WS_H));
#if MK_MULTI
    if (p.ph_lo == 11) { for (int it = c; it < 512; it += G) mlstm_sample_item(p, lds, it); }
    if (p.ph_lo == 12) conv_items(p);
    if (p.ph_lo == 10) { for (int it = c; it < 256; it += G) { const int xcd = it & 7, idx = it >> 3; mlstm_prompt_item(p, lds, xcd * 4 + (idx >> 3), idx & 7); } }
#endif
}

extern "C" void kernel_launch(void* const* d_in, const int* in_sizes, int n_in, void* d_out, int out_size, void* d_ws, size_t ws_size, hipStream_t stream) {
    static int grid = 0;
    if (grid == 0) {
        if (n_in != 19 || ws_size < WS_END) { fprintf(stderr, "kernel_launch: unexpected inputs (n_in %d, ws %zu, need %zu)\n", n_in, ws_size, (size_t)WS_END); grid = -1; return; }
        int dev = 0, cus = 0, per_cu = 0;
        hipGetDevice(&dev); hipDeviceGetAttribute(&cus, hipDeviceAttributeMultiprocessorCount, dev);
        hipFuncSetAttribute((const void*)mega, hipFuncAttributeMaxDynamicSharedMemorySize, LDS_BYTES);
        hipOccupancyMaxActiveBlocksPerMultiprocessor(&per_cu, (const void*)mega, 512, LDS_BYTES);
        if (per_cu < 1 || cus < 1) { fprintf(stderr, "kernel_launch: occupancy query says %d blocks/CU on %d CUs\n", per_cu, cus); grid = -1; return; }
        grid = cus;
    }
    if (grid < 0) return;
    Params p{};
    const float** f = (const float**)&p;
    for (int i = 0; i < 19; ++i) f[i] = (const float*)d_in[i];
    p.out = (float*)d_out; p.ws = (unsigned char*)d_ws;
#if MK_MULTI
    for (int ph = 0; ph < 10; ++ph) for (int rep = 0; rep < ((REPMASK >> ph) & 1) + 1; ++rep) { p.ph_lo = ph; p.ph_hi = ph + 1; hipLaunchKernelGGL(mega, dim3(grid), dim3(512), LDS_BYTES, stream, p); }
#ifdef EXTRA_PH
    { p.ph_lo = EXTRA_PH; p.ph_hi = EXTRA_PH + 1; hipLaunchKernelGGL(mega, dim3(grid), dim3(512), LDS_BYTES, stream, p); }
#endif
#else
    p.ph_lo = 0; p.ph_hi = 10;
    if (hipMemsetAsync((char*)d_ws + WS_BAR, 0, 16384, stream) != hipSuccess) { fprintf(stderr, "memset failed\n"); return; }
    void* args[] = {&p};
    hipError_t e = hipLaunchCooperativeKernel((const void*)mega, dim3(grid), dim3(512), args, LDS_BYTES, stream);
    if (e != hipSuccess) fprintf(stderr, "cooperative launch failed: %s (grid %d)\n", hipGetErrorString(e), grid);
#endif
}
```

```cpp
#include <hip/hip_runtime.h>
#include <hip/hip_cooperative_groups.h>
#include <cstdio>
namespace cg = cooperative_groups;

#ifndef PHMASK
#define PHMASK 1023
#endif
#ifndef MK_MULTI
#define MK_MULTI 0
#endif

#define LAS __attribute__((address_space(3)))
typedef unsigned short bf16_t;
typedef short bf16x8 __attribute__((ext_vector_type(8)));
typedef float f32x4 __attribute__((ext_vector_type(4)));
typedef float f32x2 __attribute__((ext_vector_type(2)));
typedef unsigned u32x4 __attribute__((ext_vector_type(4)));
typedef unsigned u32x2 __attribute__((ext_vector_type(2)));

constexpr int DM = 1024, NPROMPT = 8 * 2048, NSAMPLE = 128 * 4, NTOK = NPROMPT + NSAMPLE;
constexpr int SEQ = 2048, NH = 4, DH = 256, DFF = 4096, DIN = 9224, NZ = 9216, ZC = 5120;
constexpr float ALPHA = 1.189207115002721f;
constexpr float LN_EPS = 1e-5f;
constexpr int Z_BG = 0, Z_U = 1024, Z_O = 2048, Z_GC = 3072, Z_GM = 4096;
constexpr int HM_SAMPLE0 = 32 * 2048;
constexpr size_t O_Y = 0, O_CONVP = 17301504, O_CONVS = 17317888, O_CP = 17580032, O_CS = 19677184, O_NP = 53231616, O_NS = 53239808, O_MP = 53370880, O_MS = 53370912;
constexpr size_t SZ_ACT = (size_t)NTOK * DM * 2;
constexpr size_t WS_XB = 0;
constexpr size_t WS_WIN = WS_XB + SZ_ACT;
constexpr size_t WS_WC = WS_WIN + (size_t)NZ * DM * 2;
constexpr size_t WS_WM = WS_WC + (size_t)DM * DM * 2;
constexpr size_t WS_WO = WS_WM + (size_t)DM * DM * 2;
constexpr size_t WS_W1 = WS_WO + (size_t)DM * DM * 2;
constexpr size_t WS_W2 = WS_W1 + (size_t)DFF * DM * 2;
constexpr size_t WS_G = WS_W2 + (size_t)DFF * DM * 2;
constexpr size_t WS_Z = WS_G + (size_t)NTOK * 8 * 4;
constexpr size_t WS_HID = WS_Z;
constexpr size_t WS_R = WS_Z + (size_t)NTOK * DFF * 2;
constexpr size_t WS_QKV = WS_Z + (size_t)NTOK * ZC * 2;
constexpr size_t WS_KT = WS_QKV + 3 * SZ_ACT;
constexpr size_t WS_H = WS_KT + (size_t)32 * 256 * 2048 * 2;
constexpr size_t WS_AC = WS_H + SZ_ACT;
constexpr size_t WS_HN = WS_AC + SZ_ACT;
constexpr size_t WS_BAR = WS_HN + SZ_ACT;
constexpr size_t WS_END = WS_BAR + 16384;
constexpr int LDS_BYTES = 131072 + 16;

struct Params {
    const float *xp, *xs, *sconv, *sC, *sn, *sm, *w_in, *b_gate, *conv_w, *w_co, *mh_g, *w_mo, *w_o, *ln1g, *ln1b, *w_ff1, *w_ff2, *ln2g, *ln2b;
    float* out; unsigned char* ws; int ph_lo, ph_hi;
};

__device__ __forceinline__ unsigned cvt_pk_bf16(float lo, float hi) { unsigned r; asm volatile("v_cvt_pk_bf16_f32 %0, %1, %2" : "=v"(r) : "v"(lo), "v"(hi)); return r; }
__device__ __forceinline__ float bf_lo(unsigned w) { return __uint_as_float(w << 16); }
__device__ __forceinline__ float bf_hi(unsigned w) { return __uint_as_float(w & 0xffff0000u); }
__device__ __forceinline__ float bf2f(bf16_t b) { return __uint_as_float(((unsigned)b) << 16); }
__device__ __forceinline__ float sigmoidf_(float x) { return 1.0f / (1.0f + __expf(-x)); }
__device__ __forceinline__ float wave_sum(float v) {
#pragma unroll
    for (int o = 1; o < 64; o <<= 1) v += __shfl_xor(v, o);
    return v;
}
__device__ __forceinline__ const float* xrow(const Params& p, int r) { return r < NPROMPT ? p.xp + (size_t)r * DM : p.xs + (size_t)(r - NPROMPT) * DM; }
#define LDS_WAIT() asm volatile("s_waitcnt lgkmcnt(0)" ::: "memory")

#define XB_TMO      128
#define XB_XCNT(j)  (256  + 64 * (j))
#define XB_XSUB(j)  (1280 + 64 * (j))
#define XB_XGEN(j)  (2304 + 64 * (j))
#define XB_TOP      3328
#define XB_TOPGEN   3392
#define XCD_BAR_WORDS 3456
#define XB_SPIN_CAP (1u << 22)
__device__ __forceinline__ unsigned xb_ld(unsigned* p)              { return __hip_atomic_load(p, __ATOMIC_RELAXED, __HIP_MEMORY_SCOPE_AGENT); }
__device__ __forceinline__ unsigned xb_add(unsigned* p, unsigned v) { return __hip_atomic_fetch_add(p, v, __ATOMIC_RELAXED, __HIP_MEMORY_SCOPE_AGENT); }
__device__ __forceinline__ unsigned xb_xcc_id() { return (unsigned)__builtin_amdgcn_s_getreg((3 << 11) | 20) & 0xFu; }
#define XB_SPIN(cond, bar) do { unsigned _sp = 0; while (cond) { __builtin_amdgcn_s_sleep(1); \
    if ((++_sp & 255u) == 0u) { if (xb_ld(&(bar)[XB_TMO])) break; if (_sp > XB_SPIN_CAP) { atomicAdd(&(bar)[XB_TMO], 1u); break; } } } } while (0)
struct XcdBarrier { unsigned* bar; unsigned x; volatile LAS unsigned* st; };
__device__ __forceinline__ XcdBarrier xcd_barrier_post(unsigned* bar, volatile LAS unsigned* st) {
    XcdBarrier b; b.bar = bar; b.x = xb_xcc_id(); b.st = st;
    if (threadIdx.x == 0) (void)xb_add(&bar[XB_XCNT(b.x)], 1u);
    return b;
}
__device__ __forceinline__ void xcd_barrier_complete(unsigned* bar, unsigned x, unsigned& nloc, unsigned& nx) {
    const unsigned G = gridDim.x * gridDim.y * gridDim.z;
    unsigned sum, cnt, mine, sp = 0u;
    for (;;) {
        sum = 0u; cnt = 0u; mine = 0u;
#pragma unroll
        for (unsigned j = 0; j < 16; ++j) { const unsigned c = xb_ld(&bar[XB_XCNT(j)]); sum += c; cnt += (c > 0u) ? 1u : 0u; mine = (j == x) ? c : mine; }
        if (sum == G) break;
        __builtin_amdgcn_s_sleep(1);
        if ((++sp & 255u) == 0u) { if (xb_ld(&bar[XB_TMO])) break; if (sp > XB_SPIN_CAP) { atomicAdd(&bar[XB_TMO], 1u); break; } }
    }
    nloc = mine > 0u ? mine : 1u; nx = cnt > 0u ? cnt : 1u;
}
__device__ __forceinline__ void xcd_barrier(const XcdBarrier& b) {
    asm volatile("s_waitcnt vmcnt(0)" ::: "memory");
    __syncthreads();
    if (threadIdx.x == 0) {
        unsigned* bar = b.bar;
        __builtin_amdgcn_s_waitcnt(0);
        unsigned nloc = b.st[0], nx = b.st[1];
        if (nloc == 0u) { xcd_barrier_complete(bar, b.x, nloc, nx); b.st[0] = nloc; b.st[1] = nx; }
        const unsigned old = xb_add(&bar[XB_XSUB(b.x)], 1u);
        const unsigned gen = old / nloc;
        if (old + 1u == (gen + 1u) * nloc) {
            __builtin_amdgcn_fence(__ATOMIC_RELEASE, "agent");
            asm volatile("s_waitcnt vmcnt(0)" ::: "memory");
            const unsigned og = xb_add(&bar[XB_TOP], 1u);
            const unsigned tg = og / nx;
            if (og + 1u == (tg + 1u) * nx) xb_add(&bar[XB_TOPGEN], 1u);
            else XB_SPIN(xb_ld(&bar[XB_TOPGEN]) == tg, bar);
            __builtin_amdgcn_fence(__ATOMIC_ACQUIRE, "agent");
            xb_add(&bar[XB_XGEN(b.x)], 1u);
            asm volatile("s_waitcnt vmcnt(0)" ::: "memory");
        } else {
            XB_SPIN(xb_ld(&bar[XB_XGEN(b.x)]) == gen, bar);
            __builtin_amdgcn_fence(__ATOMIC_ACQUIRE, "agent");
            asm volatile("s_waitcnt vmcnt(0)" ::: "memory");
        }
    }
    __syncthreads();
}

namespace pg8 {
constexpr int BM = 256, BK = 64, HALF = 128, HTB = HALF * BK * 2, NXCD = 8, WGM = 8;
__host__ __device__ __forceinline__ int lds_byte(int r, int c) { const int st = (r >> 4) * 2 + (c >> 5), rr = r & 15, cc = c & 31, ob = rr * 64 + cc * 2; return st * 1024 + (ob ^ (((ob >> 9) & 1) << 5)); }
__host__ __device__ __forceinline__ void stage_rc(int b, int& R, int& C) { const int st = b / 1024, sb = b % 1024, swz = sb ^ (((sb >> 9) & 1) << 5); R = (st >> 1) * 16 + swz / 64; C = (st & 1) * 32 + (swz % 64) / 2; }
__host__ __device__ __forceinline__ int perm32(int rho) { const int n = rho >> 4, i = rho & 15; return 8 * (i >> 2) + 4 * n + (i & 3); }
struct Unit { int pm, pn, k0, nt, ks; };
struct Gemm { const bf16_t* A; const bf16_t* Bt; int M, N, K; };
struct StaticOrder {
    int nM, nN, nwg, G, c, kt;
    __device__ void init(int M, int N, int K, int G_, int c_) { nM = M / BM; nN = N / BM; nwg = nM * nN; G = G_; c = c_; kt = K / BK; }
    __device__ bool next(int i, Unit& u) const {
        const long L = (long)i * G + c; if (L >= nwg) return false;
        int wgid = (int)L; { const int q = nwg / NXCD, r = nwg % NXCD, xcd = wgid % NXCD, off = wgid / NXCD; wgid = (xcd < r ? xcd * (q + 1) : r * (q + 1) + (xcd - r) * q) + off; }
        const int nig = WGM * nN, gid = wgid / nig, fm = gid * WGM, gsz = (nM - fm) < WGM ? (nM - fm) : WGM;
        u.pm = fm + ((wgid % nig) % gsz); u.pn = (wgid % nig) / gsz; u.k0 = 0; u.nt = kt; u.ks = -1; return true;
    }
};
struct SplitOrder {
    StaticOrder so; int NS, ntk;
    __device__ void init(int K, int NS_, int G_, int c_) { so.init(NPROMPT, DM, K, G_, c_); NS = NS_; ntk = K / (BK * NS_); }
    __device__ bool next(int i, Unit& u) const {
        const long L = (long)i * so.G + so.c;
        if (L < so.nwg) return so.next(i, u);
        const int e = (int)(L - so.nwg); if (e >= 8 * NS) return false;
        const int tile = e / NS, ks = e % NS; u.pm = 64 + (tile >> 2); u.pn = tile & 3; u.k0 = ks * ntk * BK; u.nt = ntk; u.ks = ks; return true;
    }
};

template <class Epi, class Sched>
__device__ __forceinline__ void gemm_phase(LAS unsigned char* lds, const Gemm g, const Sched& S, const Epi& E) {
    const int tid = threadIdx.x, wid = __builtin_amdgcn_readfirstlane(tid >> 6), lane = tid & 63, wr = wid >> 2, wc = wid & 3, fr = lane & 15, fq = lane >> 4;
    const int K = g.K;
    unsigned voffA[2], voffB[2];
#pragma unroll
    for (int i = 0; i < 2; ++i) { int R, C; stage_rc(tid * 16 + i * 8192, R, C); const int Rb = (R & ~31) + perm32(R & 31);
        voffA[i] = (unsigned)(R * K + C) * 2u; voffB[i] = (unsigned)(Rb * K + C) * 2u; }
    const size_t kstep = (size_t)(BK * 2);
    const size_t hstep = (size_t)HALF * K * 2;
    const size_t tstep = 2 * hstep;
    const unsigned ldsw = (unsigned)wid * 1024u;
    const int aoff = lds_byte(wr * 64 + fr, fq * 8), boff = lds_byte(wc * 32 + fr, fq * 8);
#define PG8_SA(b, h) (((b) * 2 + (h)) * HTB)
#define PG8_SB(b, h) ((4 + (b) * 2 + (h)) * HTB)
#define PG8_STAGE(bufoff, gbase, voff) do { _Pragma("unroll") for (int _i = 0; _i < 2; ++_i) \
        __builtin_amdgcn_global_load_lds((const unsigned*)((const char*)(gbase) + (voff)[_i]), (LAS unsigned*)(lds + (bufoff) + ldsw + _i * 8192), 16, 0, 0); } while (0)
#define PG8_LDA(dst, b, h) do { _Pragma("unroll") for (int m = 0; m < 4; ++m) _Pragma("unroll") for (int k = 0; k < 2; ++k) dst[m][k] = *(const LAS bf16x8*)(lds + PG8_SA(b, h) + aoff + m * 2048 + k * 1024); } while (0)
#define PG8_LDB(dst, b, h) do { _Pragma("unroll") for (int n = 0; n < 2; ++n) _Pragma("unroll") for (int k = 0; k < 2; ++k) dst[n][k] = *(const LAS bf16x8*)(lds + PG8_SB(b, h) + boff + n * 2048 + k * 1024); } while (0)
#define PG8_MMA(ai, bj, At, Bt) do { __builtin_amdgcn_s_setprio(1); _Pragma("unroll") for (int m = 0; m < 4; ++m) _Pragma("unroll") for (int n = 0; n < 2; ++n) _Pragma("unroll") for (int k = 0; k < 2; ++k) \
        acc[ai][bj][m][n] = __builtin_amdgcn_mfma_f32_16x16x32_bf16(Bt[n][k], At[m][k], acc[ai][bj][m][n], 0, 0, 0); __builtin_amdgcn_s_setprio(0); } while (0)
#define PG8_WAIT_V(n) asm volatile("s_waitcnt vmcnt(" #n ")" ::: "memory")
#define PG8_WAIT_L(n) asm volatile("s_waitcnt lgkmcnt(" #n ")" ::: "memory")
#define PG8_BAR __builtin_amdgcn_s_barrier()
#define PG8_SCHED __builtin_amdgcn_sched_barrier(0)
    Unit cur, nxt; int ui = 0;
    if (!S.next(0, cur)) return;
    f32x4 acc[2][2][4][2];
#pragma unroll
    for (int a = 0; a < 2; ++a)
#pragma unroll
        for (int b = 0; b < 2; ++b)
#pragma unroll
            for (int m = 0; m < 4; ++m)
#pragma unroll
                for (int n = 0; n < 2; ++n) acc[a][b][m][n] = (f32x4){0.f, 0.f, 0.f, 0.f};
    bf16x8 At[4][2], B0[2][2], B1[2][2];
    const char* cA = (const char*)g.A + (size_t)cur.pm * tstep + (size_t)cur.k0 * 2; const char* cB = (const char*)g.Bt + (size_t)cur.pn * tstep + (size_t)cur.k0 * 2;
    PG8_STAGE(PG8_SB(0, 0), cB, voffB); PG8_STAGE(PG8_SA(0, 0), cA, voffA); PG8_STAGE(PG8_SB(0, 1), cB + hstep, voffB); PG8_STAGE(PG8_SA(0, 1), cA + hstep, voffA);
    if (wr == 1) PG8_BAR;
    PG8_WAIT_V(4); PG8_BAR;
    PG8_STAGE(PG8_SB(1, 0), cB + kstep, voffB); PG8_STAGE(PG8_SA(1, 0), cA + kstep, voffA); PG8_STAGE(PG8_SB(1, 1), cB + hstep + kstep, voffB);
    PG8_WAIT_V(6); PG8_BAR;
    for (;;) {
        const bool has_next = S.next(ui + 1, nxt);
        const char* nA = has_next ? (const char*)g.A + (size_t)nxt.pm * tstep + (size_t)nxt.k0 * 2 : cA; const char* nB = has_next ? (const char*)g.Bt + (size_t)nxt.pn * tstep + (size_t)nxt.k0 * 2 : cB;
        const int nt = cur.nt;
        for (int t = 0; t < nt; t += 2) {
            const bool last = (t == nt - 2);
            const char* a1 = cA + (size_t)(t + 1) * kstep;
            const char* a2 = last ? nA : cA + (size_t)(t + 2) * kstep; const char* b2 = last ? nB : cB + (size_t)(t + 2) * kstep;
            const char* a3 = a2 + kstep; const char* b3 = b2 + kstep;
            PG8_LDB(B0, 0, 0); PG8_SCHED; PG8_LDA(At, 0, 0); PG8_STAGE(PG8_SA(1, 1), a1 + hstep, voffA);
            PG8_WAIT_L(8); PG8_BAR; PG8_WAIT_L(0); PG8_MMA(0, 0, At, B0); PG8_BAR; PG8_SCHED;
            PG8_LDB(B1, 0, 1); PG8_STAGE(PG8_SB(0, 0), b2, voffB);
            PG8_BAR; PG8_WAIT_L(0); PG8_MMA(0, 1, At, B1); PG8_BAR;
            PG8_LDA(At, 0, 1); PG8_STAGE(PG8_SA(0, 0), a2, voffA);
            PG8_BAR; PG8_WAIT_L(0); PG8_MMA(1, 0, At, B0); PG8_BAR; PG8_SCHED;
            PG8_STAGE(PG8_SB(0, 1), b2 + hstep, voffB);
            PG8_WAIT_V(6); PG8_BAR; PG8_MMA(1, 1, At, B1); PG8_BAR;
            PG8_LDB(B0, 1, 0); PG8_SCHED; PG8_LDA(At, 1, 0); PG8_STAGE(PG8_SA(0, 1), a2 + hstep, voffA);
            PG8_WAIT_L(8); PG8_BAR; PG8_WAIT_L(0); PG8_MMA(0, 0, At, B0); PG8_BAR; PG8_SCHED;
            PG8_LDB(B1, 1, 1); PG8_STAGE(PG8_SB(1, 0), b3, voffB);
            PG8_BAR; PG8_WAIT_L(0); PG8_MMA(0, 1, At, B1); PG8_BAR;
            PG8_LDA(At, 1, 1); PG8_STAGE(PG8_SA(1, 0), a3, voffA);
            PG8_BAR; PG8_WAIT_L(0); PG8_MMA(1, 0, At, B0); PG8_BAR; PG8_SCHED;
            PG8_STAGE(PG8_SB(1, 1), b3 + hstep, voffB);
            PG8_WAIT_V(6); PG8_BAR; PG8_MMA(1, 1, At, B1); PG8_BAR;
        }
        E(acc, cur, wr, wc, fr, fq);
        if (!has_next) break;
#pragma unroll
        for (int a = 0; a < 2; ++a)
#pragma unroll
            for (int b = 0; b < 2; ++b)
#pragma unroll
                for (int m = 0; m < 4; ++m)
#pragma unroll
                    for (int n = 0; n < 2; ++n) acc[a][b][m][n] = (f32x4){0.f, 0.f, 0.f, 0.f};
        cur = nxt; cA = nA; cB = nB; ++ui;
    }
    PG8_WAIT_V(0);
    if (wr == 0) PG8_BAR;
    PG8_BAR;
#undef PG8_SA
#undef PG8_SB
#undef PG8_STAGE
#undef PG8_LDA
#undef PG8_LDB
#undef PG8_MMA
#undef PG8_WAIT_V
#undef PG8_WAIT_L
#undef PG8_BAR
#undef PG8_SCHED
}
}
using pg8::Unit;

#define EPI_LOOP_BEGIN \
    _Pragma("unroll") for (int ai = 0; ai < 2; ++ai) _Pragma("unroll") for (int m = 0; m < 4; ++m) { const int row = u.pm * 256 + ai * 128 + wr * 64 + m * 16 + fr; \
    _Pragma("unroll") for (int bj = 0; bj < 2; ++bj) { const int lc = bj * 128 + wc * 32 + 8 * fq; const f32x4 v0 = acc[ai][bj][m][0], v1 = acc[ai][bj][m][1];
#define EPI_LOOP_END } }

struct EpiZ {
    bf16_t* Z; bf16_t* QKV; bf16_t* KT;
    __device__ __forceinline__ void operator()(const f32x4 (&acc)[2][2][4][2], const Unit& u, int wr, int wc, int fr, int fq) const {
        const int pn = u.pn;
        if (pn >= 4 && pn < 12) {
#pragma unroll
            for (int ai = 0; ai < 2; ++ai)
#pragma unroll
                for (int m = 0; m < 4; ++m) { const int row = u.pm * 256 + ai * 128 + wr * 64 + m * 16 + fr;
                    const f32x4 a0 = acc[ai][0][m][0] * acc[ai][1][m][0], a1 = acc[ai][0][m][1] * acc[ai][1][m][1];
                    u32x4 w; w.x = cvt_pk_bf16(a0[0], a0[1]); w.y = cvt_pk_bf16(a0[2], a0[3]); w.z = cvt_pk_bf16(a1[0], a1[1]); w.w = cvt_pk_bf16(a1[2], a1[3]);
                    *(u32x4*)(Z + (size_t)row * ZC + Z_U + (pn - 4) * 128 + wc * 32 + 8 * fq) = w; }
            return;
        }
        if (pn >= 12 && pn < 24) {
            const int grp = (pn - 12) >> 2, hh = (pn - 12) & 3;
            bf16_t* dst = QKV + (size_t)grp * NTOK * DM;
            EPI_LOOP_BEGIN
                const size_t rr = row < NPROMPT ? (size_t)((row >> 11) * 4 + hh) * SEQ + (row & 2047) : (size_t)HM_SAMPLE0 + (size_t)(((row - NPROMPT) >> 2) * 4 + hh) * 4 + ((row - NPROMPT) & 3);
                u32x4 w; w.x = cvt_pk_bf16(v0[0], v0[1]); w.y = cvt_pk_bf16(v0[2], v0[3]); w.z = cvt_pk_bf16(v1[0], v1[1]); w.w = cvt_pk_bf16(v1[2], v1[3]);
                *(u32x4*)(dst + rr * 256 + lc) = w;
            EPI_LOOP_END
            return;
        }
        const int zc0 = pn < 4 ? pn * 256 : Z_O + (pn - 24) * 256;
        const bool sg = pn >= 24;
        EPI_LOOP_BEGIN
            f32x4 a0 = v0, a1 = v1;
            if (sg) {
#pragma unroll
                for (int j = 0; j < 4; ++j) { a0[j] = sigmoidf_(a0[j]); a1[j] = sigmoidf_(a1[j]); }
            }
            u32x4 w; w.x = cvt_pk_bf16(a0[0], a0[1]); w.y = cvt_pk_bf16(a0[2], a0[3]); w.z = cvt_pk_bf16(a1[0], a1[1]); w.w = cvt_pk_bf16(a1[2], a1[3]);
            *(u32x4*)(Z + (size_t)row * ZC + zc0 + lc) = w;
        EPI_LOOP_END
    }
};
struct EpiGate {
    bf16_t* O; const bf16_t* T; const bf16_t* Z; int gcol; int add;
    __device__ __forceinline__ void operator()(const f32x4 (&acc)[2][2][4][2], const Unit& u, int wr, int wc, int fr, int fq) const {
        EPI_LOOP_BEGIN
            const int col = u.pn * 256 + lc;
            const u32x4 gw = *(const u32x4*)(Z + (size_t)row * ZC + gcol + col);
            f32x4 a0, a1;
            a0[0] = bf_lo(gw.x) * v0[0]; a0[1] = bf_hi(gw.x) * v0[1]; a0[2] = bf_lo(gw.y) * v0[2]; a0[3] = bf_hi(gw.y) * v0[3];
            a1[0] = bf_lo(gw.z) * v1[0]; a1[1] = bf_hi(gw.z) * v1[1]; a1[2] = bf_lo(gw.w) * v1[2]; a1[3] = bf_hi(gw.w) * v1[3];
            if (add) { const u32x4 tw = *(const u32x4*)(T + (size_t)row * DM + col);
                a0[0] += bf_lo(tw.x); a0[1] += bf_hi(tw.x); a0[2] += bf_lo(tw.y); a0[3] += bf_hi(tw.y); a1[0] += bf_lo(tw.z); a1[1] += bf_hi(tw.z); a1[2] += bf_lo(tw.w); a1[3] += bf_hi(tw.w); }
            u32x4 w; w.x = cvt_pk_bf16(a0[0], a0[1]); w.y = cvt_pk_bf16(a0[2], a0[3]); w.z = cvt_pk_bf16(a1[0], a1[1]); w.w = cvt_pk_bf16(a1[2], a1[3]);
            *(u32x4*)(O + (size_t)row * DM + col) = w;
        EPI_LOOP_END
    }
};
#define EPI_SLAB_PATH \
        if (u.ks >= 0) { float* sl = SL + (size_t)u.ks * NSAMPLE * DM; \
            EPI_LOOP_BEGIN \
                float* dp = sl + (size_t)(row - NPROMPT) * DM + u.pn * 256 + lc; *(f32x4*)dp = v0; *(f32x4*)(dp + 4) = v1; \
            EPI_LOOP_END \
            return; }
struct EpiResX {
    bf16_t* R; const float* xp; const float* xs; float* SL;
    __device__ __forceinline__ void operator()(const f32x4 (&acc)[2][2][4][2], const Unit& u, int wr, int wc, int fr, int fq) const {
        EPI_SLAB_PATH
        EPI_LOOP_BEGIN
            const int col = u.pn * 256 + lc;
            const float* xr = (row < NPROMPT ? xp + (size_t)row * DM : xs + (size_t)(row - NPROMPT) * DM) + col;
            const f32x4 x0 = *(const f32x4*)xr, x1 = *(const f32x4*)(xr + 4);
            const f32x4 a0 = x0 * ALPHA + v0, a1 = x1 * ALPHA + v1;
            u32x4 w; w.x = cvt_pk_bf16(a0[0], a0[1]); w.y = cvt_pk_bf16(a0[2], a0[3]); w.z = cvt_pk_bf16(a1[0], a1[1]); w.w = cvt_pk_bf16(a1[2], a1[3]);
            *(u32x4*)(R + (size_t)row * DM + col) = w;
        EPI_LOOP_END
    }
};
struct EpiResB {
    bf16_t* R; const bf16_t* X1; float* SL;
    __device__ __forceinline__ void operator()(const f32x4 (&acc)[2][2][4][2], const Unit& u, int wr, int wc, int fr, int fq) const {
        EPI_SLAB_PATH
        EPI_LOOP_BEGIN
            const int col = u.pn * 256 + lc;
            const u32x4 xw = *(const u32x4*)(X1 + (size_t)row * DM + col);
            f32x4 a0, a1;
            a0[0] = bf_lo(xw.x) * ALPHA + v0[0]; a0[1] = bf_hi(xw.x) * ALPHA + v0[1]; a0[2] = bf_lo(xw.y) * ALPHA + v0[2]; a0[3] = bf_hi(xw.y) * ALPHA + v0[3];
            a1[0] = bf_lo(xw.z) * ALPHA + v1[0]; a1[1] = bf_hi(xw.z) * ALPHA + v1[1]; a1[2] = bf_lo(xw.w) * ALPHA + v1[2]; a1[3] = bf_hi(xw.w) * ALPHA + v1[3];
            u32x4 w; w.x = cvt_pk_bf16(a0[0], a0[1]); w.y = cvt_pk_bf16(a0[2], a0[3]); w.z = cvt_pk_bf16(a1[0], a1[1]); w.w = cvt_pk_bf16(a1[2], a1[3]);
            *(u32x4*)(R + (size_t)row * DM + col) = w;
        EPI_LOOP_END
    }
};
struct EpiHid {
    bf16_t* Hd;
    __device__ __forceinline__ void operator()(const f32x4 (&acc)[2][2][4][2], const Unit& u, int wr, int wc, int fr, int fq) const {
        EPI_LOOP_BEGIN
            const int col = u.pn * 256 + lc;
            f32x4 a0, a1;
#pragma unroll
            for (int j = 0; j < 4; ++j) { const float r0 = fmaxf(v0[j], 0.f), r1 = fmaxf(v1[j], 0.f); a0[j] = r0 * r0; a1[j] = r1 * r1; }
            u32x4 w; w.x = cvt_pk_bf16(a0[0], a0[1]); w.y = cvt_pk_bf16(a0[2], a0[3]); w.z = cvt_pk_bf16(a1[0], a1[1]); w.w = cvt_pk_bf16(a1[2], a1[3]);
            *(u32x4*)(Hd + (size_t)row * DFF + col) = w;
        EPI_LOOP_END
    }
};

__device__ __forceinline__ void transpose_item(const float* W, int ldw, int K, int src0, bf16_t* WT, int dst0, int kb, float scale, LAS float* scr, int lane) {
    const int k0 = kb * 64;
#pragma unroll 8
    for (int i = 0; i < 32; ++i) { const int kk = 2 * i + (lane >> 5); scr[kk * 33 + (lane & 31)] = W[(size_t)(k0 + kk) * ldw + src0 + (lane & 31)]; }
    LDS_WAIT();
    const int c = lane & 7;
#pragma unroll
    for (int j = 0; j < 4; ++j) { const int n = (lane >> 3) + 8 * j; const LAS float* s = scr + (8 * c) * 33 + n;
        u32x4 o; o.x = cvt_pk_bf16(s[0 * 33] * scale, s[1 * 33] * scale); o.y = cvt_pk_bf16(s[2 * 33] * scale, s[3 * 33] * scale);
        o.z = cvt_pk_bf16(s[4 * 33] * scale, s[5 * 33] * scale); o.w = cvt_pk_bf16(s[6 * 33] * scale, s[7 * 33] * scale);
        *(u32x4*)(WT + (size_t)(dst0 + n) * K + k0 + 8 * c) = o; }
    LDS_WAIT();
}
__device__ __forceinline__ void weight_items(const Params& p, LAS unsigned char* lds, int it_lo, int it_hi, int gw, int NGW) {
    const int wid = threadIdx.x >> 6, lane = threadIdx.x & 63;
    LAS float* scr = (LAS float*)(lds + wid * 8704);
    bf16_t* WIN = (bf16_t*)(p.ws + WS_WIN);
    constexpr int I_IN = 72 * 4 * 16, I_SQ = 32 * 16, I_F1 = 128 * 16;
    for (int it = it_lo + gw; it < it_hi; it += NGW) {
        int r = it;
        if (r < I_IN) { const int kb = r & 15, nb = r >> 4, g = nb >> 2, sub = nb & 3;
            int src; if (g < 8) src = g * 128; else if (g < 24) { const int pr = (g - 8) >> 1, hf = (g - 8) & 1; src = (hf ? 2048 : 1024) + pr * 128; } else if (g < 56) src = 3072 + (g - 24) * 128; else src = 7176 + (g - 56) * 128;
            const float sc = (g >= 32 && g < 40) ? 0.0625f : 1.0f;
            transpose_item(p.w_in, DIN, DM, src + sub * 32, WIN, g * 128 + sub * 32, kb, sc, scr, lane); continue; }
        r -= I_IN;
        if (r < 3 * I_SQ) { const int w = r / I_SQ, q = r % I_SQ, kb = q & 15, nb = q >> 4;
            const float* W = w == 0 ? p.w_co : (w == 1 ? p.w_mo : p.w_o); bf16_t* WT = (bf16_t*)(p.ws + (w == 0 ? WS_WC : (w == 1 ? WS_WM : WS_WO)));
            transpose_item(W, DM, DM, nb * 32, WT, nb * 32, kb, 1.0f, scr, lane); continue; }
        r -= 3 * I_SQ;
        if (r < I_F1) { const int kb = r & 15, nb = r >> 4; transpose_item(p.w_ff1, DFF, DM, nb * 32, (bf16_t*)(p.ws + WS_W1), nb * 32, kb, 1.0f, scr, lane); continue; }
        r -= I_F1;
        { const int kb = r & 63, nb = r >> 6; transpose_item(p.w_ff2, DM, DFF, nb * 32, (bf16_t*)(p.ws + WS_W2), nb * 32, kb, 1.0f, scr, lane); }
    }
}
#define P0_W_HI (gridDim.x == 256 ? WI_IN : WI_ALL)
constexpr int WI_IN = 72 * 4 * 16, WI_ALL = WI_IN + 3 * 32 * 16 + 128 * 16 + 32 * 64;
__device__ __forceinline__ void phase0(const Params& p, LAS unsigned char* lds) {
    const int tid = threadIdx.x, wid = tid >> 6, lane = tid & 63;
    const int gw = blockIdx.x * 8 + wid, NGW = gridDim.x * 8;
    LAS float* wg = (LAS float*)(lds + 73728);
    for (int e = tid; e < 2048; e += 512) { const int k = e >> 1, hf = e & 1; *(LAS f32x4*)(wg + k * 8 + hf * 4) = *(const f32x4*)(p.w_in + (size_t)k * DIN + 7168 + hf * 4); }
    __syncthreads();
    weight_items(p, lds, 0, P0_W_HI, gw, NGW);
    bf16_t* XB = (bf16_t*)(p.ws + WS_XB); float* G = (float*)(p.ws + WS_G);
    for (int r = gw; r < NTOK; r += NGW) {
        const float* xr = xrow(p, r);
        float g8[8];
#pragma unroll
        for (int j = 0; j < 8; ++j) g8[j] = 0.f;
#pragma unroll
        for (int j = 0; j < 4; ++j) { const int k = j * 256 + lane * 4; const f32x4 v = *(const f32x4*)(xr + k);
            u32x2 w; w.x = cvt_pk_bf16(v[0], v[1]); w.y = cvt_pk_bf16(v[2], v[3]); *(u32x2*)(XB + (size_t)r * DM + k) = w;
#pragma unroll
            for (int e = 0; e < 4; ++e) { const f32x4 wa = *(const LAS f32x4*)(wg + (k + e) * 8), wb = *(const LAS f32x4*)(wg + (k + e) * 8 + 4);
#pragma unroll
                for (int q = 0; q < 4; ++q) { g8[q] += v[e] * wa[q]; g8[4 + q] += v[e] * wb[q]; } } }
#pragma unroll
        for (int j = 0; j < 8; ++j) g8[j] = wave_sum(g8[j]);
        if (lane < 4) { G[(size_t)r * 8 + lane] = g8[0] * (lane == 0) + g8[1] * (lane == 1) + g8[2] * (lane == 2) + g8[3] * (lane == 3) + p.b_gate[lane]; }
        else if (lane < 8) { const float f = g8[4] * (lane == 4) + g8[5] * (lane == 5) + g8[6] * (lane == 6) + g8[7] * (lane == 7) + p.b_gate[lane];
            G[(size_t)r * 8 + lane] = fminf(f, 0.f) - log1pf(__expf(-fabsf(f))); }
    }
    __syncthreads();
}

constexpr int KS_LD = 264, VT_LD = 136;
constexpr int L_KSH = 0, L_CT = 128 * KS_LD * 2, L_VT = L_CT + 48 * KS_LD * 2, L_VW = L_VT + 48 * VT_LD * 2, L_SC = L_VW + 48 * VT_LD * 2;
__device__ __forceinline__ void mlstm_prompt_item(const Params& p, LAS unsigned char* lds, int bh, int vs) {
    const int tid = threadIdx.x, wid = __builtin_amdgcn_readfirstlane(tid >> 6), lane = tid & 63, li = lane & 15, kg = lane >> 4;
    const int b = bh >> 2, h = bh & 3, j0 = vs * 32;
    LAS bf16_t* Ksh = (LAS bf16_t*)(lds + L_KSH); LAS bf16_t* CTsh = (LAS bf16_t*)(lds + L_CT); LAS bf16_t* VTsh = (LAS bf16_t*)(lds + L_VT); LAS bf16_t* VWsh = (LAS bf16_t*)(lds + L_VW);
    LAS float* sA = (LAS float*)(lds + L_SC); LAS float* sG = sA + 128; LAS float* sB = sG + 128;
    const bf16_t* QH = (const bf16_t*)(p.ws + WS_QKV) + (size_t)bh * SEQ * 256; const bf16_t* KH = QH + (size_t)NTOK * DM; const bf16_t* VH = KH + (size_t)NTOK * DM;
    const float* G = (const float*)(p.ws + WS_G) + (size_t)b * SEQ * 8; bf16_t* H = (bf16_t*)(p.ws + WS_H);
    for (int e = tid; e < 48 * KS_LD / 2; e += 512) ((LAS unsigned*)CTsh)[e] = 0u;
    for (int e = tid; e < 16 * VT_LD; e += 512) { const int rr = e / VT_LD; VTsh[32 * VT_LD + e] = rr == 0 ? (bf16_t)0x3F80 : (bf16_t)0; VWsh[32 * VT_LD + e] = 0; }
    f32x4 Cacc[2][3];
#pragma unroll
    for (int db = 0; db < 2; ++db)
#pragma unroll
        for (int jb = 0; jb < 3; ++jb) Cacc[db][jb] = (f32x4){0.f, 0.f, 0.f, 0.f};
    float m_prev = 0.f;
    const int vs_s = tid >> 2, vs_q = tid & 3;
    u32x4 kp[8]; u32x4 vp; bf16x8 qf[8]; float gi0 = 0.f, gf0 = 0.f, gi1 = 0.f, gf1 = 0.f;
#pragma unroll
    for (int i = 0; i < 8; ++i) kp[i] = *(const u32x4*)(KH + (size_t)(i * 512 + tid) * 8);
    vp = *(const u32x4*)(VH + (size_t)vs_s * 256 + j0 + vs_q * 8);
#pragma unroll
    for (int kk = 0; kk < 8; ++kk) qf[kk] = *(const bf16x8*)(QH + (size_t)(16 * wid + li) * 256 + kk * 32 + kg * 8);
    if (wid == 0) { gi0 = G[(size_t)lane * 8 + h]; gf0 = G[(size_t)lane * 8 + 4 + h]; gi1 = G[(size_t)(64 + lane) * 8 + h]; gf1 = G[(size_t)(64 + lane) * 8 + 4 + h]; }
    for (int c = 0; c < 16; ++c) {
        const int t0 = c * 128, tn = (c < 15 ? c + 1 : c) * 128;
        if (wid == 0) {
            float b0 = gf0, b1 = gf1;
#pragma unroll
            for (int o = 1; o < 64; o <<= 1) { const float x0 = __shfl_up(b0, o), x1 = __shfl_up(b1, o); if (lane >= o) { b0 += x0; b1 += x1; } }
            b1 += __shfl(b0, 63);
            const float a0 = gi0 - b0, a1 = gi1 - b1;
            float p0 = a0, p1 = a1;
#pragma unroll
            for (int o = 1; o < 64; o <<= 1) { const float x0 = __shfl_up(p0, o), x1 = __shfl_up(p1, o); if (lane >= o) { p0 = fmaxf(p0, x0); p1 = fmaxf(p1, x1); } }
            p1 = fmaxf(p1, __shfl(p0, 63));
            sA[lane] = a0; sA[64 + lane] = a1; sG[lane] = fmaxf(m_prev, p0); sG[64 + lane] = fmaxf(m_prev, p1); sB[lane] = b0; sB[64 + lane] = b1;
            gi0 = G[(size_t)(tn + lane) * 8 + h]; gf0 = G[(size_t)(tn + lane) * 8 + 4 + h]; gi1 = G[(size_t)(tn + 64 + lane) * 8 + h]; gf1 = G[(size_t)(tn + 64 + lane) * 8 + 4 + h];
        }
        __syncthreads();
        const float g_last = sG[127], b_last = sB[127];
#pragma unroll
        for (int i = 0; i < 8; ++i) { const int pc = i * 512 + tid, row = pc >> 5, c8 = pc & 31; *(LAS u32x4*)(Ksh + row * KS_LD + c8 * 8) = kp[i]; }
        {
            const float wsv = __expf(sA[vs_s] - g_last);
            const unsigned vw[4] = {vp.x, vp.y, vp.z, vp.w};
#pragma unroll
            for (int e = 0; e < 4; ++e) { const int j = vs_q * 8 + 2 * e; const float lo = bf_lo(vw[e]), hi = bf_hi(vw[e]);
                VTsh[j * VT_LD + vs_s] = (bf16_t)(vw[e] & 0xffff); VTsh[(j + 1) * VT_LD + vs_s] = (bf16_t)(vw[e] >> 16);
                const unsigned sw = cvt_pk_bf16(lo * wsv, hi * wsv);
                VWsh[j * VT_LD + vs_s] = (bf16_t)(sw & 0xffff); VWsh[(j + 1) * VT_LD + vs_s] = (bf16_t)(sw >> 16); }
            if (vs_q == 0) VWsh[32 * VT_LD + vs_s] = (bf16_t)(cvt_pk_bf16(wsv, 0.f) & 0xffff);
        }
#pragma unroll
        for (int i = 0; i < 8; ++i) kp[i] = *(const u32x4*)(KH + (size_t)tn * 256 + (size_t)(i * 512 + tid) * 8);
        vp = *(const u32x4*)(VH + (size_t)(tn + vs_s) * 256 + j0 + vs_q * 8);
        __syncthreads();
        {
            const int t_loc = 16 * wid + li;
            const float g_t = sG[t_loc], b_t = sB[t_loc];
            f32x4 ST[8];
#pragma unroll
            for (int sb = 0; sb < 8; ++sb) ST[sb] = (f32x4){0.f, 0.f, 0.f, 0.f};
#pragma unroll
            for (int kk = 0; kk < 8; ++kk) {
#pragma unroll
                for (int hf = 0; hf < 2; ++hf) {
                    bf16x8 kf[4];
#pragma unroll
                    for (int sb = 0; sb < 4; ++sb) kf[sb] = *(const LAS bf16x8*)(Ksh + ((hf * 4 + sb) * 16 + li) * KS_LD + kk * 32 + kg * 8);
#pragma unroll
                    for (int sb = 0; sb < 4; ++sb) ST[hf * 4 + sb] = __builtin_amdgcn_mfma_f32_16x16x32_bf16(kf[sb], qf[kk], ST[hf * 4 + sb], 0, 0, 0);
                }
            }
#pragma unroll
            for (int sb = 0; sb < 8; ++sb) { const f32x4 av = *(const LAS f32x4*)(sA + sb * 16 + kg * 4);
#pragma unroll
                for (int r = 0; r < 4; ++r) { const float wgt = __expf(av[r] - g_t); const bool ok = (sb * 16 + kg * 4 + r) <= t_loc; ST[sb][r] = ok ? ST[sb][r] * wgt : 0.f; } }
            f32x4 nt[3], it[3];
#pragma unroll
            for (int jb = 0; jb < 3; ++jb) { nt[jb] = (f32x4){0.f, 0.f, 0.f, 0.f}; it[jb] = (f32x4){0.f, 0.f, 0.f, 0.f}; }
#pragma unroll
            for (int k2 = 0; k2 < 4; ++k2) {
                u32x4 pw; pw.x = cvt_pk_bf16(ST[2 * k2][0], ST[2 * k2][1]); pw.y = cvt_pk_bf16(ST[2 * k2][2], ST[2 * k2][3]);
                pw.z = cvt_pk_bf16(ST[2 * k2 + 1][0], ST[2 * k2 + 1][1]); pw.w = cvt_pk_bf16(ST[2 * k2 + 1][2], ST[2 * k2 + 1][3]);
                bf16x8 pf; __builtin_memcpy(&pf, &pw, 16);
#pragma unroll
                for (int jb = 0; jb < 3; ++jb) { const LAS bf16_t* vr = VTsh + (jb * 16 + li) * VT_LD + k2 * 32 + kg * 4;
                    u32x4 vw4; const u32x2 lo = *(const LAS u32x2*)vr, hi = *(const LAS u32x2*)(vr + 16); vw4.x = lo.x; vw4.y = lo.y; vw4.z = hi.x; vw4.w = hi.y;
                    bf16x8 vf; __builtin_memcpy(&vf, &vw4, 16);
                    nt[jb] = __builtin_amdgcn_mfma_f32_16x16x32_bf16(vf, pf, nt[jb], 0, 0, 0); } }
#pragma unroll
            for (int kk = 0; kk < 8; ++kk)
#pragma unroll
                for (int jb = 0; jb < 3; ++jb) { const bf16x8 cf = *(const LAS bf16x8*)(CTsh + (jb * 16 + li) * KS_LD + kk * 32 + kg * 8);
                    it[jb] = __builtin_amdgcn_mfma_f32_16x16x32_bf16(cf, qf[kk], it[jb], 0, 0, 0); }
#pragma unroll
            for (int kk = 0; kk < 8; ++kk) qf[kk] = *(const bf16x8*)(QH + (size_t)(tn + 16 * wid + li) * 256 + kk * 32 + kg * 8);
            const float w_int = __expf(m_prev - g_t);
#pragma unroll
            for (int jb = 0; jb < 3; ++jb) nt[jb] = nt[jb] + it[jb] * w_int;
            const float den = __shfl(nt[2][0], li);
            const float rden = 1.0f / fmaxf(fabsf(den), __expf(-(b_t + g_t)));
#pragma unroll
            for (int jb = 0; jb < 2; ++jb) { u32x2 w; w.x = cvt_pk_bf16(nt[jb][0] * rden, nt[jb][1] * rden); w.y = cvt_pk_bf16(nt[jb][2] * rden, nt[jb][3] * rden);
                *(u32x2*)(H + (size_t)(b * SEQ + t0 + t_loc) * DM + h * 256 + j0 + jb * 16 + kg * 4) = w; }
        }
        __syncthreads();
        {
            const float decay = __expf(m_prev - g_last);
#pragma unroll
            for (int db = 0; db < 2; ++db)
#pragma unroll
                for (int jb = 0; jb < 3; ++jb) Cacc[db][jb] = Cacc[db][jb] * decay;
            u32x2 kt2[2][4][2];
            {
                const unsigned tb = (unsigned)(uintptr_t)(lds + L_KSH) + (unsigned)(((kg * 8 + (li >> 2)) * KS_LD + (2 * wid) * 16 + 4 * (li & 3)) * 2);
#pragma unroll
                for (int db = 0; db < 2; ++db)
#pragma unroll
                    for (int k2 = 0; k2 < 4; ++k2)
#pragma unroll
                        for (int hf = 0; hf < 2; ++hf)
                            asm volatile("ds_read_b64_tr_b16 %0, %1 offset:%2" : "=&v"(kt2[db][k2][hf]) : "v"(tb), "i"(((k2 * 32 + hf * 4) * KS_LD + db * 16) * 2) : "memory");
#pragma unroll
                for (int db = 0; db < 2; ++db)
                    asm volatile("s_waitcnt lgkmcnt(0)" : "+v"(kt2[db][0][0]), "+v"(kt2[db][0][1]), "+v"(kt2[db][1][0]), "+v"(kt2[db][1][1]), "+v"(kt2[db][2][0]), "+v"(kt2[db][2][1]), "+v"(kt2[db][3][0]), "+v"(kt2[db][3][1]) :: "memory");
            }
#pragma unroll
            for (int k2 = 0; k2 < 4; ++k2)
#pragma unroll
                for (int jb = 0; jb < 3; ++jb) { const bf16x8 vf = *(const LAS bf16x8*)(VWsh + (jb * 16 + li) * VT_LD + k2 * 32 + kg * 8);
#pragma unroll
                    for (int db = 0; db < 2; ++db) { u32x4 kw; kw.x = kt2[db][k2][0].x; kw.y = kt2[db][k2][0].y; kw.z = kt2[db][k2][1].x; kw.w = kt2[db][k2][1].y; bf16x8 kf8; __builtin_memcpy(&kf8, &kw, 16);
                        Cacc[db][jb] = __builtin_amdgcn_mfma_f32_16x16x32_bf16(kf8, vf, Cacc[db][jb], 0, 0, 0); } }
#pragma unroll
            for (int db = 0; db < 2; ++db)
#pragma unroll
                for (int jb = 0; jb < 3; ++jb) { u32x2 w; w.x = cvt_pk_bf16(Cacc[db][jb][0], Cacc[db][jb][1]); w.y = cvt_pk_bf16(Cacc[db][jb][2], Cacc[db][jb][3]);
                    *(LAS u32x2*)(CTsh + (jb * 16 + li) * KS_LD + (2 * wid + db) * 16 + kg * 4) = w; }
            m_prev = b_last + g_last;
        }
    }
#pragma unroll
    for (int db = 0; db < 2; ++db) { const int d0 = (2 * wid + db) * 16 + kg * 4;
#pragma unroll
        for (int jb = 0; jb < 2; ++jb)
#pragma unroll
            for (int r = 0; r < 4; ++r) p.out[O_CP + ((size_t)(bh * 256 + d0 + r)) * 256 + j0 + jb * 16 + li] = Cacc[db][jb][r];
        if (vs == 0 && li == 0) {
#pragma unroll
            for (int r = 0; r < 4; ++r) p.out[O_NP + (size_t)bh * 256 + d0 + r] = Cacc[db][2][r]; } }
    if (vs == 0 && tid == 0) p.out[O_MP + bh] = m_prev;
    __syncthreads();
}

__device__ __forceinline__ void mlstm_sample_item(const Params& p, LAS unsigned char* lds, int item) {
    const int tid = threadIdx.x, bs = item >> 2, h = item & 3, tok0 = NPROMPT + bs * 4;
    LAS float* sq = (LAS float*)lds; LAS float* sk = sq + 1024; LAS float* sv = sk + 1024; LAS float* sn0 = sv + 1024; LAS float* sdot = sn0 + 256; LAS float* sc = sdot + 32; LAS float* sred = sc + 64;
    const bf16_t* QS = (const bf16_t*)(p.ws + WS_QKV) + ((size_t)HM_SAMPLE0 + (size_t)item * 4) * 256;
    const float* G = (const float*)(p.ws + WS_G); bf16_t* H = (bf16_t*)(p.ws + WS_H);
    const int c4 = tid & 63, rw = tid >> 6, col = c4 * 4;
    const float* C0 = p.sC + (size_t)item * 65536 + (size_t)(rw * 32) * 256 + col; float* C1 = p.out + O_CS + (size_t)item * 65536 + (size_t)(rw * 32) * 256 + col;
    f32x4 cv[8];
#pragma unroll
    for (int j = 0; j < 8; ++j) cv[j] = __builtin_nontemporal_load((const f32x4*)(C0 + j * 256));
    for (int e = tid; e < 3072; e += 512) { const int which = e >> 10, idx = e & 1023; sq[e] = bf2f(QS[(size_t)which * NTOK * DM + idx]); }
    if (tid < 256) sn0[tid] = p.sn[(size_t)item * 256 + tid];
    __syncthreads();
    {
        const int id = tid >> 4, part = tid & 15;
        if (id < 20) { const LAS float* va = id < 16 ? sq + (id >> 2) * 256 : sq + (id - 16) * 256; const LAS float* vb = id < 16 ? sk + (id & 3) * 256 : sn0;
            float s = 0.f;
#pragma unroll
            for (int e = 0; e < 16; ++e) s += va[part * 16 + e] * vb[part * 16 + e];
            s += __shfl_xor(s, 8); s += __shfl_xor(s, 4); s += __shfl_xor(s, 2); s += __shfl_xor(s, 1);
            if (part == 0) sdot[id] = s; }
    }
    __syncthreads();
    if (tid == 0) {
        const float m0 = p.sm[item];
        float li_[4], lf_[4], bb[4], aa[4], gg[4];
#pragma unroll
        for (int s = 0; s < 4; ++s) { li_[s] = G[(size_t)(tok0 + s) * 8 + h]; lf_[s] = G[(size_t)(tok0 + s) * 8 + 4 + h]; }
        float cum = 0.f, pm = m0;
#pragma unroll
        for (int s = 0; s < 4; ++s) { cum += lf_[s]; bb[s] = cum; aa[s] = li_[s] - cum; pm = fmaxf(pm, aa[s]); gg[s] = pm; }
#pragma unroll
        for (int t = 0; t < 4; ++t) { const float wi = __expf(m0 - gg[t]); float den = wi * sdot[16 + t];
#pragma unroll
            for (int s = 0; s < 4; ++s) { const float S = s <= t ? sdot[t * 4 + s] * __expf(aa[s] - gg[t]) : 0.f; sc[16 + t * 4 + s] = S; den += S; }
            sc[t] = wi; sc[12 + t] = 1.0f / fmaxf(fabsf(den), __expf(-(bb[t] + gg[t]))); }
#pragma unroll
        for (int s = 0; s < 4; ++s) sc[4 + s] = __expf(aa[s] - gg[3]);
        sc[8] = __expf(m0 - gg[3]); sc[9] = bb[3] + gg[3];
    }
    __syncthreads();
    const float decay = sc[8]; const float ws0 = sc[4], ws1 = sc[5], ws2 = sc[6], ws3 = sc[7];
    const f32x4 v0 = *(const LAS f32x4*)(sv + col), v1 = *(const LAS f32x4*)(sv + 256 + col), v2 = *(const LAS f32x4*)(sv + 512 + col), v3 = *(const LAS f32x4*)(sv + 768 + col);
    f32x4 a0 = {0.f, 0.f, 0.f, 0.f}, a1 = a0, a2 = a0, a3 = a0;
#pragma unroll
    for (int rb = 0; rb < 4; ++rb) {
        f32x4 cn[8];
        if (rb < 3) {
#pragma unroll
            for (int j = 0; j < 8; ++j) cn[j] = __builtin_nontemporal_load((const f32x4*)(C0 + ((rb + 1) * 8 + j) * 256));
        }
#pragma unroll
        for (int j = 0; j < 8; ++j) { const int d = rw * 32 + rb * 8 + j; const f32x4 x = cv[j];
            a0 += x * sq[d]; a1 += x * sq[256 + d]; a2 += x * sq[512 + d]; a3 += x * sq[768 + d];
            const f32x4 y = x * decay + v0 * (ws0 * sk[d]) + v1 * (ws1 * sk[256 + d]) + v2 * (ws2 * sk[512 + d]) + v3 * (ws3 * sk[768 + d]);
            __builtin_nontemporal_store(y, (f32x4*)(C1 + (rb * 8 + j) * 256)); }
        if (rb < 3) {
#pragma unroll
            for (int j = 0; j < 8; ++j) cv[j] = cn[j];
        }
    }
    *(LAS f32x4*)(sred + (rw * 4 + 0) * 256 + col) = a0; *(LAS f32x4*)(sred + (rw * 4 + 1) * 256 + col) = a1; *(LAS f32x4*)(sred + (rw * 4 + 2) * 256 + col) = a2; *(LAS f32x4*)(sred + (rw * 4 + 3) * 256 + col) = a3;
    __syncthreads();
#pragma unroll
    for (int e = 0; e < 2; ++e) { const int o = tid + 512 * e, t = o >> 8, cx = o & 255;
        float inter = 0.f;
#pragma unroll
        for (int w = 0; w < 8; ++w) inter += sred[(w * 4 + t) * 256 + cx];
        float num = sc[t] * inter;
#pragma unroll
        for (int s = 0; s < 4; ++s) num += sc[16 + t * 4 + s] * sv[s * 256 + cx];
        H[(size_t)(tok0 + t) * DM + h * 256 + cx] = (bf16_t)(cvt_pk_bf16(num * sc[12 + t], 0.f) & 0xffff); }
    if (tid < 256) p.out[O_NS + (size_t)item * 256 + tid] = decay * sn0[tid] + ws0 * sk[tid] + ws1 * sk[256 + tid] + ws2 * sk[512 + tid] + ws3 * sk[768 + tid];
    if (tid == 0) p.out[O_MS + item] = sc[9];
    __syncthreads();
}

__device__ __forceinline__ void conv_unit(const Params& p, const bf16_t* Z, bf16_t* AC, int r, int ch, const float (&cw)[24], u32x4 uw, u32x4 bw, u32x4 w1, u32x4 w2) {
    float u0[8], u1[8], u2[8], bg[8];
    const unsigned uu[4] = {uw.x, uw.y, uw.z, uw.w}, bb[4] = {bw.x, bw.y, bw.z, bw.w}, q1[4] = {w1.x, w1.y, w1.z, w1.w}, q2[4] = {w2.x, w2.y, w2.z, w2.w};
#pragma unroll
    for (int e = 0; e < 4; ++e) { u2[2 * e] = bf_lo(uu[e]); u2[2 * e + 1] = bf_hi(uu[e]); bg[2 * e] = bf_lo(bb[e]); bg[2 * e + 1] = bf_hi(bb[e]);
        u1[2 * e] = bf_lo(q1[e]); u1[2 * e + 1] = bf_hi(q1[e]); u0[2 * e] = bf_lo(q2[e]); u0[2 * e + 1] = bf_hi(q2[e]); }
    const bool prompt = r < NPROMPT; const int t = prompt ? (r & 2047) : ((r - NPROMPT) & 3); const int bs = (r - NPROMPT) >> 2;
    if (t < 1) { if (prompt) {
#pragma unroll
            for (int e = 0; e < 8; ++e) u1[e] = 0.f; }
        else { const float* sp = p.sconv + ((size_t)bs * 2 + 1) * DM + ch;
#pragma unroll
            for (int e = 0; e < 8; ++e) u1[e] = sp[e]; } }
    if (t < 2) { if (prompt) {
#pragma unroll
            for (int e = 0; e < 8; ++e) u0[e] = 0.f; }
        else { const float* sp = p.sconv + ((size_t)bs * 2 + t) * DM + ch;
#pragma unroll
            for (int e = 0; e < 8; ++e) u0[e] = sp[e]; } }
    float o[8];
#pragma unroll
    for (int e = 0; e < 8; ++e) o[e] = bg[e] * (cw[e] * u0[e] + cw[8 + e] * u1[e] + cw[16 + e] * u2[e]);
    u32x4 w; w.x = cvt_pk_bf16(o[0], o[1]); w.y = cvt_pk_bf16(o[2], o[3]); w.z = cvt_pk_bf16(o[4], o[5]); w.w = cvt_pk_bf16(o[6], o[7]);
    *(u32x4*)(AC + (size_t)r * DM + ch) = w;
    float* so = nullptr;
    if (prompt) { if (t >= SEQ - 2) so = p.out + O_CONVP + ((size_t)(r >> 11) * 2 + (t - (SEQ - 2))) * DM + ch; }
    else if (t >= 2) so = p.out + O_CONVS + ((size_t)bs * 2 + (t - 2)) * DM + ch;
    if (so) {
#pragma unroll
        for (int e = 0; e < 8; ++e) so[e] = u2[e]; }
}
__device__ __forceinline__ void conv_items(const Params& p) {
    const bf16_t* Z = (const bf16_t*)(p.ws + WS_Z); bf16_t* AC = (bf16_t*)(p.ws + WS_AC);
    const int gt = blockIdx.x * 512 + threadIdx.x, NG = gridDim.x * 512;
    const int ch = (gt & 127) * 8, r0 = gt >> 7, rstep = NG >> 7;
    float cw[24];
#pragma unroll
    for (int e = 0; e < 8; ++e) { cw[e] = p.conv_w[ch + e]; cw[8 + e] = p.conv_w[DM + ch + e]; cw[16 + e] = p.conv_w[2 * DM + ch + e]; }
    for (int rb = r0; rb < NTOK; rb += 4 * rstep) {
        u32x4 uw[4], bw[4], w1[4], w2[4];
#pragma unroll
        for (int j = 0; j < 4; ++j) { const int r = rb + j * rstep; if (r < NTOK) { const int r1 = r >= 1 ? r - 1 : r, r2 = r >= 2 ? r - 2 : r;
            uw[j] = *(const u32x4*)(Z + (size_t)r * ZC + Z_U + ch); bw[j] = *(const u32x4*)(Z + (size_t)r * ZC + Z_BG + ch);
            w1[j] = *(const u32x4*)(Z + (size_t)r1 * ZC + Z_U + ch); w2[j] = *(const u32x4*)(Z + (size_t)r2 * ZC + Z_U + ch); } }
#pragma unroll
        for (int j = 0; j < 4; ++j) { const int r = rb + j * rstep; if (r < NTOK) conv_unit(p, Z, AC, r, ch, cw, uw[j], bw[j], w1[j], w2[j]); }
    }
}

__device__ __forceinline__ void hn_items(const Params& p, int wblk, int nwblk) {
    const bf16_t* Z = (const bf16_t*)(p.ws + WS_Z); const bf16_t* H = (const bf16_t*)(p.ws + WS_H); bf16_t* HN = (bf16_t*)(p.ws + WS_HN);
    const int lane = threadIdx.x & 63, gw = wblk * 8 + (threadIdx.x >> 6), NGW = nwblk * 8, c0 = lane * 16;
    f32x4 mg[4];
#pragma unroll
    for (int j = 0; j < 4; ++j) mg[j] = *(const f32x4*)(p.mh_g + c0 + 4 * j);
    for (int r = gw; r < NTOK; r += NGW) {
        const u32x4 h0 = *(const u32x4*)(H + (size_t)r * DM + c0), h1 = *(const u32x4*)(H + (size_t)r * DM + c0 + 8);
        const u32x4 o0 = *(const u32x4*)(Z + (size_t)r * ZC + Z_O + c0), o1 = *(const u32x4*)(Z + (size_t)r * ZC + Z_O + c0 + 8);
        const unsigned hw[8] = {h0.x, h0.y, h0.z, h0.w, h1.x, h1.y, h1.z, h1.w}, ow[8] = {o0.x, o0.y, o0.z, o0.w, o1.x, o1.y, o1.z, o1.w};
        float v[16]; float s = 0.f;
#pragma unroll
        for (int e = 0; e < 8; ++e) { v[2 * e] = bf_lo(hw[e]); v[2 * e + 1] = bf_hi(hw[e]); s += v[2 * e] + v[2 * e + 1]; }
        s += __shfl_xor(s, 1); s += __shfl_xor(s, 2); s += __shfl_xor(s, 4); s += __shfl_xor(s, 8);
        const float mean = s * (1.0f / 256.0f); float q = 0.f;
#pragma unroll
        for (int e = 0; e < 16; ++e) { v[e] -= mean; q += v[e] * v[e]; }
        q += __shfl_xor(q, 1); q += __shfl_xor(q, 2); q += __shfl_xor(q, 4); q += __shfl_xor(q, 8);
        const float rstd = 1.0f / sqrtf(q * (1.0f / 256.0f) + LN_EPS);
        unsigned ww[8];
#pragma unroll
        for (int e = 0; e < 8; ++e) { const float g0 = mg[(2 * e) >> 2][(2 * e) & 3], g1 = mg[(2 * e + 1) >> 2][(2 * e + 1) & 3];
            ww[e] = cvt_pk_bf16(v[2 * e] * rstd * g0 * bf_lo(ow[e]), v[2 * e + 1] * rstd * g1 * bf_hi(ow[e])); }
        u32x4 w0, w1; w0.x = ww[0]; w0.y = ww[1]; w0.z = ww[2]; w0.w = ww[3]; w1.x = ww[4]; w1.y = ww[5]; w1.z = ww[6]; w1.w = ww[7];
        *(u32x4*)(HN + (size_t)r * DM + c0) = w0; *(u32x4*)(HN + (size_t)r * DM + c0 + 8) = w1;
    }
}

template <bool OUT_F32>
__device__ __forceinline__ void ln_rows(const bf16_t* R, const float* gam, const float* bet, void* out, const float* SL, int NS, const float* xs, const bf16_t* X1) {
    const int lane = threadIdx.x & 63, gw = blockIdx.x * 8 + (threadIdx.x >> 6), NGW = gridDim.x * 8;
    f32x4 gv[4], bv[4];
#pragma unroll
    for (int j = 0; j < 4; ++j) { gv[j] = *(const f32x4*)(gam + j * 256 + lane * 4); bv[j] = *(const f32x4*)(bet + j * 256 + lane * 4); }
    for (int r = gw; r < NTOK; r += NGW) {
        f32x4 v[4]; float s = 0.f;
        if (r < NPROMPT) {
#pragma unroll
            for (int j = 0; j < 4; ++j) { const u32x2 w = *(const u32x2*)(R + (size_t)r * DM + j * 256 + lane * 4); v[j] = (f32x4){bf_lo(w.x), bf_hi(w.x), bf_lo(w.y), bf_hi(w.y)}; }
        } else {
            const int rs = r - NPROMPT;
#pragma unroll
            for (int j = 0; j < 4; ++j) { const int cc = j * 256 + lane * 4;
                if (xs) v[j] = *(const f32x4*)(xs + (size_t)rs * DM + cc) * ALPHA;
                else { const u32x2 w = *(const u32x2*)(X1 + (size_t)r * DM + cc); v[j] = (f32x4){bf_lo(w.x), bf_hi(w.x), bf_lo(w.y), bf_hi(w.y)} * ALPHA; }
                for (int k = 0; k < NS; ++k) v[j] += *(const f32x4*)(SL + ((size_t)k * NSAMPLE + rs) * DM + cc); }
        }
#pragma unroll
        for (int j = 0; j < 4; ++j) s += (v[j][0] + v[j][1]) + (v[j][2] + v[j][3]);
        const float mean = wave_sum(s) * (1.0f / DM); float q = 0.f;
#pragma unroll
        for (int j = 0; j < 4; ++j) { v[j] = v[j] - mean; q += (v[j][0] * v[j][0] + v[j][1] * v[j][1]) + (v[j][2] * v[j][2] + v[j][3] * v[j][3]); }
        const float rstd = 1.0f / sqrtf(wave_sum(q) * (1.0f / DM) + LN_EPS);
#pragma unroll
        for (int j = 0; j < 4; ++j) { const f32x4 y = v[j] * rstd * gv[j] + bv[j];
            if (OUT_F32) *(f32x4*)((float*)out + (size_t)r * DM + j * 256 + lane * 4) = y;
            else { u32x2 w; w.x = cvt_pk_bf16(y[0], y[1]); w.y = cvt_pk_bf16(y[2], y[3]); *(u32x2*)((bf16_t*)out + (size_t)r * DM + j * 256 + lane * 4) = w; } }
    }
}

__global__ void __launch_bounds__(512, 2) mega(Params p) {
    extern __shared__ __attribute__((aligned(16))) unsigned char shm_raw[];
    LAS unsigned char* lds = (LAS unsigned char*)shm_raw;
    const int G = gridDim.x, c = blockIdx.x;
    unsigned char* ws = p.ws;
    volatile LAS unsigned* xst = (volatile LAS unsigned*)(lds + 131072);
    if (threadIdx.x == 0) { xst[0] = 0u; xst[1] = 0u; }
    __syncthreads();
    const XcdBarrier xb = xcd_barrier_post((unsigned*)(ws + WS_BAR), xst);
    if (p.ph_hi > 64) cg::this_grid().sync();
#if MK_MULTI
#define PH_SYNC(k)
#else
#define PH_SYNC(k) do { if (p.ph_lo <= (k) && (k) + 1 < p.ph_hi) xcd_barrier(xb); } while (0)
#endif
#define PH_ON(k) (((PHMASK >> (k)) & 1) && p.ph_lo <= (k) && (k) < p.ph_hi)
#ifndef REPMASK
#define REPMASK 0
#endif
    if (PH_ON(0)) phase0(p, lds);
    PH_SYNC(0);
    if (PH_ON(1)) { pg8::StaticOrder S; S.init(NTOK, NZ, DM, G, c); pg8::Gemm g{(const bf16_t*)(ws + WS_XB), (const bf16_t*)(ws + WS_WIN), NTOK, NZ, DM};
        EpiZ E{(bf16_t*)(ws + WS_Z), (bf16_t*)(ws + WS_QKV), (bf16_t*)(ws + WS_KT)}; pg8::gemm_phase(lds, g, S, E);
        if (G == 256 && c >= 72) weight_items(p, lds, WI_IN, WI_ALL, (c - 72) * 8 + (threadIdx.x >> 6), (256 - 72) * 8); }
    PH_SYNC(1);
    if (PH_ON(2)) {
        const bool sample_first = ((c >> 6) & 1) != 0;
        if (sample_first) { for (int it = c; it < 512; it += G) mlstm_sample_item(p, lds, it); }
        for (int it = c; it < 256; it += G) { const int xcd = it & 7, idx = it >> 3; mlstm_prompt_item(p, lds, xcd * 4 + (idx >> 3), idx & 7); }
        if (!sample_first) { for (int it = c; it < 512; it += G) mlstm_sample_item(p, lds, it); }
        conv_items(p);
    }
    PH_SYNC(2);
    if (PH_ON(3)) {
        const int extra = (264 > G && 264 < 2 * G) ? 264 - G : 0;
        pg8::StaticOrder S; S.init(NTOK, DM, DM, G, c); pg8::Gemm g{(const bf16_t*)(ws + WS_AC), (const bf16_t*)(ws + WS_WC), NTOK, DM, DM};
        EpiGate E{(bf16_t*)(ws + WS_XB), nullptr, (const bf16_t*)(ws + WS_Z), Z_GC, 0}; pg8::gemm_phase(lds, g, S, E);
        if (c >= extra) hn_items(p, c - extra, G - extra); }
    PH_SYNC(3);
    if (PH_ON(4)) { pg8::StaticOrder S; S.init(NTOK, DM, DM, G, c); pg8::Gemm g{(const bf16_t*)(ws + WS_HN), (const bf16_t*)(ws + WS_WM), NTOK, DM, DM};
        EpiGate E{(bf16_t*)(ws + WS_AC), (const bf16_t*)(ws + WS_XB), (const bf16_t*)(ws + WS_Z), Z_GM, 1}; pg8::gemm_phase(lds, g, S, E); }
    PH_SYNC(4);
    if (PH_ON(5)) { pg8::SplitOrder S; S.init(DM, 4, G, c); pg8::Gemm g{(const bf16_t*)(ws + WS_AC), (const bf16_t*)(ws + WS_WO), NTOK, DM, DM};
        EpiResX E{(bf16_t*)(ws + WS_R), p.xp, p.xs, (float*)(ws + WS_KT)}; pg8::gemm_phase(lds, g, S, E); }
    PH_SYNC(5);
    if (PH_ON(6)) ln_rows<false>((const bf16_t*)(ws + WS_R), p.ln1g, p.ln1b, ws + WS_H, (const float*)(ws + WS_KT), 4, p.xs, nullptr);
    PH_SYNC(6);
    if (PH_ON(7)) { pg8::StaticOrder S; S.init(NTOK, DFF, DM, G, c); pg8::Gemm g{(const bf16_t*)(ws + WS_H), (const bf16_t*)(ws + WS_W1), NTOK, DFF, DM};
        EpiHid E{(bf16_t*)(ws + WS_HID)}; pg8::gemm_phase(lds, g, S, E); }
    PH_SYNC(7);
    if (PH_ON(8)) { pg8::SplitOrder S; S.init(DFF, 16, G, c); pg8::Gemm g{(const bf16_t*)(ws + WS_HID), (const bf16_t*)(ws + WS_W2), NTOK, DM, DFF};
        EpiResB E{(bf16_t*)(ws + WS_R), (const bf16_t*)(ws + WS_H), (float*)(ws + WS_KT)}; pg8::gemm_phase(lds, g, S, E); }
    PH_SYNC(8);
    if (PH_ON(9)) ln_rows<true>((const bf16_t*)(ws + WS_R), p.ln2g, p.ln2b, p.out + O_Y, (const float*)(ws + WS_KT), 16, nullptr, (const bf16_t*)(ws + WS_H));
#if MK_MULTI
    if (p.ph_lo == 11) { for (int it = c; it < 512; it += G) mlstm_sample_item(p, lds, it); }
    if (p.ph_lo == 12) conv_items(p);
    if (p.ph_lo == 10) { for (int it = c; it < 256; it += G) { const int xcd = it & 7, idx = it >> 3; mlstm_prompt_item(p, lds, xcd * 4 + (idx >> 3), idx & 7); } }
#endif
}

extern "C" void kernel_launch(void* const* d_in, const int* in_sizes, int n_in, void* d_out, int out_size, void* d_ws, size_t ws_size, hipStream_t stream) {
    static int grid = 0;
    if (grid == 0) {
        if (n_in != 19 || ws_size < WS_END) { fprintf(stderr, "kernel_launch: unexpected inputs (n_in %d, ws %zu, need %zu)\n", n_in, ws_size, (size_t)WS_END); grid = -1; return; }
        int dev = 0, cus = 0, per_cu = 0;
        hipGetDevice(&dev); hipDeviceGetAttribute(&cus, hipDeviceAttributeMultiprocessorCount, dev);
        hipFuncSetAttribute((const void*)mega, hipFuncAttributeMaxDynamicSharedMemorySize, LDS_BYTES);
        hipOccupancyMaxActiveBlocksPerMultiprocessor(&per_cu, (const void*)mega, 512, LDS_BYTES);
        if (per_cu < 1 || cus < 1) { fprintf(stderr, "kernel_launch: occupancy query says %d blocks/CU on %d CUs\n", per_cu, cus); grid = -1; return; }
        grid = cus;
    }
    if (grid < 0) return;
    Params p{};
    const float** f = (const float**)&p;
    for (int i = 0; i < 19; ++i) f[i] = (const float*)d_in[i];
    p.out = (float*)d_out; p.ws = (unsigned char*)d_ws;
#if MK_MULTI
    for (int ph = 0; ph < 10; ++ph) for (int rep = 0; rep < ((REPMASK >> ph) & 1) + 1; ++rep) { p.ph_lo = ph; p.ph_hi = ph + 1; hipLaunchKernelGGL(mega, dim3(grid), dim3(512), LDS_BYTES, stream, p); }
#ifdef EXTRA_PH
    { p.ph_lo = EXTRA_PH; p.ph_hi = EXTRA_PH + 1; hipLaunchKernelGGL(mega, dim3(grid), dim3(512), LDS_BYTES, stream, p); }
#endif
#else
    p.ph_lo = 0; p.ph_hi = 10;
    if (hipMemsetAsync((char*)d_ws + WS_BAR, 0, 16384, stream) != hipSuccess) { fprintf(stderr, "memset failed\n"); return; }
    void* args[] = {&p};
    hipError_t e = hipLaunchCooperativeKernel((const void*)mega, dim3(grid), dim3(512), args, LDS_BYTES, stream);
    if (e != hipSuccess) fprintf(stderr, "cooperative launch failed: %s (grid %d)\n", hipGetErrorString(e), grid);
#endif
}
```

```cpp
#include <hip/hip_runtime.h>
#include <hip/hip_cooperative_groups.h>
#include <cstdio>
namespace cg = cooperative_groups;

#ifndef PHMASK
#define PHMASK 1023
#endif
#ifndef MK_MULTI
#define MK_MULTI 0
#endif

#define LAS __attribute__((address_space(3)))
typedef unsigned short bf16_t;
typedef short bf16x8 __attribute__((ext_vector_type(8)));
typedef float f32x4 __attribute__((ext_vector_type(4)));
typedef float f32x2 __attribute__((ext_vector_type(2)));
typedef unsigned u32x4 __attribute__((ext_vector_type(4)));
typedef unsigned u32x2 __attribute__((ext_vector_type(2)));

constexpr int DM = 1024, NPROMPT = 8 * 2048, NSAMPLE = 128 * 4, NTOK = NPROMPT + NSAMPLE;
constexpr int SEQ = 2048, NH = 4, DH = 256, DFF = 4096, DIN = 9224, NZ = 9216, ZC = 5120;
constexpr float ALPHA = 1.189207115002721f;
constexpr float LN_EPS = 1e-5f;
constexpr int Z_BG = 0, Z_U = 1024, Z_O = 2048, Z_GC = 3072, Z_GM = 4096;
constexpr int HM_SAMPLE0 = 32 * 2048;
constexpr size_t O_Y = 0, O_CONVP = 17301504, O_CONVS = 17317888, O_CP = 17580032, O_CS = 19677184, O_NP = 53231616, O_NS = 53239808, O_MP = 53370880, O_MS = 53370912;
constexpr size_t SZ_ACT = (size_t)NTOK * DM * 2;
constexpr size_t WS_XB = 0;
constexpr size_t WS_WIN = WS_XB + SZ_ACT;
constexpr size_t WS_WC = WS_WIN + (size_t)NZ * DM * 2;
constexpr size_t WS_WM = WS_WC + (size_t)DM * DM * 2;
constexpr size_t WS_WO = WS_WM + (size_t)DM * DM * 2;
constexpr size_t WS_W1 = WS_WO + (size_t)DM * DM * 2;
constexpr size_t WS_W2 = WS_W1 + (size_t)DFF * DM * 2;
constexpr size_t WS_G = WS_W2 + (size_t)DFF * DM * 2;
constexpr size_t WS_Z = WS_G + (size_t)NTOK * 8 * 4;
constexpr size_t WS_HID = WS_Z;
constexpr size_t WS_R = WS_Z + (size_t)NTOK * DFF * 2;
constexpr size_t WS_QKV = WS_Z + (size_t)NTOK * ZC * 2;
constexpr size_t WS_KT = WS_QKV + 3 * SZ_ACT;
constexpr size_t WS_H = WS_KT + (size_t)32 * 256 * 2048 * 2;
constexpr size_t WS_AC = WS_H + SZ_ACT;
constexpr size_t WS_HN = WS_AC + SZ_ACT;
constexpr size_t WS_BAR = WS_HN + SZ_ACT;
constexpr size_t WS_END = WS_BAR + 16384;
constexpr int LDS_BYTES = 131072 + 16;

struct Params {
    const float *xp, *xs, *sconv, *sC, *sn, *sm, *w_in, *b_gate, *conv_w, *w_co, *mh_g, *w_mo, *w_o, *ln1g, *ln1b, *w_ff1, *w_ff2, *ln2g, *ln2b;
    float* out; unsigned char* ws; int ph_lo, ph_hi;
};

__device__ __forceinline__ unsigned cvt_pk_bf16(float lo, float hi) { unsigned r; asm volatile("v_cvt_pk_bf16_f32 %0, %1, %2" : "=v"(r) : "v"(lo), "v"(hi)); return r; }
__device__ __forceinline__ float bf_lo(unsigned w) { return __uint_as_float(w << 16); }
__device__ __forceinline__ float bf_hi(unsigned w) { return __uint_as_float(w & 0xffff0000u); }
__device__ __forceinline__ float bf2f(bf16_t b) { return __uint_as_float(((unsigned)b) << 16); }
__device__ __forceinline__ float sigmoidf_(float x) { return 1.0f / (1.0f + __expf(-x)); }
__device__ __forceinline__ float wave_sum(float v) {
#pragma unroll
    for (int o = 1; o < 64; o <<= 1) v += __shfl_xor(v, o);
    return v;
}
__device__ __forceinline__ const float* xrow(const Params& p, int r) { return r < NPROMPT ? p.xp + (size_t)r * DM : p.xs + (size_t)(r - NPROMPT) * DM; }
#define LDS_WAIT() asm volatile("s_waitcnt lgkmcnt(0)" ::: "memory")

#define XB_TMO      128
#define XB_XCNT(j)  (256  + 64 * (j))
#define XB_XSUB(j)  (1280 + 64 * (j))
#define XB_XGEN(j)  (2304 + 64 * (j))
#define XB_TOP      3328
#define XB_TOPGEN   3392
#define XCD_BAR_WORDS 3456
#define XB_SPIN_CAP (1u << 22)
__device__ __forceinline__ unsigned xb_ld(unsigned* p)              { return __hip_atomic_load(p, __ATOMIC_RELAXED, __HIP_MEMORY_SCOPE_AGENT); }
__device__ __forceinline__ unsigned xb_add(unsigned* p, unsigned v) { return __hip_atomic_fetch_add(p, v, __ATOMIC_RELAXED, __HIP_MEMORY_SCOPE_AGENT); }
__device__ __forceinline__ unsigned xb_xcc_id() { return (unsigned)__builtin_amdgcn_s_getreg((3 << 11) | 20) & 0xFu; }
#define XB_SPIN(cond, bar) do { unsigned _sp = 0; while (cond) { __builtin_amdgcn_s_sleep(1); \
    if ((++_sp & 255u) == 0u) { if (xb_ld(&(bar)[XB_TMO])) break; if (_sp > XB_SPIN_CAP) { atomicAdd(&(bar)[XB_TMO], 1u); break; } } } } while (0)
struct XcdBarrier { unsigned* bar; unsigned x; volatile LAS unsigned* st; };
__device__ __forceinline__ XcdBarrier xcd_barrier_post(unsigned* bar, volatile LAS unsigned* st) {
    XcdBarrier b; b.bar = bar; b.x = xb_xcc_id(); b.st = st;
    if (threadIdx.x == 0) (void)xb_add(&bar[XB_XCNT(b.x)], 1u);
    return b;
}
__device__ __forceinline__ void xcd_barrier_complete(unsigned* bar, unsigned x, unsigned& nloc, unsigned& nx) {
    const unsigned G = gridDim.x * gridDim.y * gridDim.z;
    unsigned sum, cnt, mine, sp = 0u;
    for (;;) {
        sum = 0u; cnt = 0u; mine = 0u;
#pragma unroll
        for (unsigned j = 0; j < 16; ++j) { const unsigned c = xb_ld(&bar[XB_XCNT(j)]); sum += c; cnt += (c > 0u) ? 1u : 0u; mine = (j == x) ? c : mine; }
        if (sum == G) break;
        __builtin_amdgcn_s_sleep(1);
        if ((++sp & 255u) == 0u) { if (xb_ld(&bar[XB_TMO])) break; if (sp > XB_SPIN_CAP) { atomicAdd(&bar[XB_TMO], 1u); break; } }
    }
    nloc = mine > 0u ? mine : 1u; nx = cnt > 0u ? cnt : 1u;
}
__device__ __forceinline__ void xcd_barrier(const XcdBarrier& b) {
    asm volatile("s_waitcnt vmcnt(0)" ::: "memory");
    __syncthreads();
    if (threadIdx.x == 0) {
        unsigned* bar = b.bar;
        __builtin_amdgcn_s_waitcnt(0);
        unsigned nloc = b.st[0], nx = b.st[1];
        if (nloc == 0u) { xcd_barrier_complete(bar, b.x, nloc, nx); b.st[0] = nloc; b.st[1] = nx; }
        const unsigned old = xb_add(&bar[XB_XSUB(b.x)], 1u);
        const unsigned gen = old / nloc;
        if (old + 1u == (gen + 1u) * nloc) {
            __builtin_amdgcn_fence(__ATOMIC_RELEASE, "agent");
            asm volatile("s_waitcnt vmcnt(0)" ::: "memory");
            const unsigned og = xb_add(&bar[XB_TOP], 1u);
            const unsigned tg = og / nx;
            if (og + 1u == (tg + 1u) * nx) xb_add(&bar[XB_TOPGEN], 1u);
            else XB_SPIN(xb_ld(&bar[XB_TOPGEN]) == tg, bar);
            __builtin_amdgcn_fence(__ATOMIC_ACQUIRE, "agent");
            xb_add(&bar[XB_XGEN(b.x)], 1u);
            asm volatile("s_waitcnt vmcnt(0)" ::: "memory");
        } else {
            XB_SPIN(xb_ld(&bar[XB_XGEN(b.x)]) == gen, bar);
            __builtin_amdgcn_fence(__ATOMIC_ACQUIRE, "agent");
            asm volatile("s_waitcnt vmcnt(0)" ::: "memory");
        }
    }
    __syncthreads();
}

namespace pg8 {
constexpr int BM = 256, BK = 64, HALF = 128, HTB = HALF * BK * 2, NXCD = 8, WGM = 8;
__host__ __device__ __forceinline__ int lds_byte(int r, int c) { const int st = (r >> 4) * 2 + (c >> 5), rr = r & 15, cc = c & 31, ob = rr * 64 + cc * 2; return st * 1024 + (ob ^ (((ob >> 9) & 1) << 5)); }
__host__ __device__ __forceinline__ void stage_rc(int b, int& R, int& C) { const int st = b / 1024, sb = b % 1024, swz = sb ^ (((sb >> 9) & 1) << 5); R = (st >> 1) * 16 + swz / 64; C = (st & 1) * 32 + (swz % 64) / 2; }
__host__ __device__ __forceinline__ int perm32(int rho) { const int n = rho >> 4, i = rho & 15; return 8 * (i >> 2) + 4 * n + (i & 3); }
struct Unit { int pm, pn, k0, nt, ks; };
struct Gemm { const bf16_t* A; const bf16_t* Bt; int M, N, K; };
struct StaticOrder {
    int nM, nN, nwg, G, c, kt;
    __device__ void init(int M, int N, int K, int G_, int c_) { nM = M / BM; nN = N / BM; nwg = nM * nN; G = G_; c = c_; kt = K / BK; }
    __device__ bool next(int i, Unit& u) const {
        const long L = (long)i * G + c; if (L >= nwg) return false;
        int wgid = (int)L; { const int q = nwg / NXCD, r = nwg % NXCD, xcd = wgid % NXCD, off = wgid / NXCD; wgid = (xcd < r ? xcd * (q + 1) : r * (q + 1) + (xcd - r) * q) + off; }
        const int nig = WGM * nN, gid = wgid / nig, fm = gid * WGM, gsz = (nM - fm) < WGM ? (nM - fm) : WGM;
        u.pm = fm + ((wgid % nig) % gsz); u.pn = (wgid % nig) / gsz; u.k0 = 0; u.nt = kt; u.ks = -1; return true;
    }
};
struct SplitOrder {
    StaticOrder so; int NS, ntk;
    __device__ void init(int K, int NS_, int G_, int c_) { so.init(NPROMPT, DM, K, G_, c_); NS = NS_; ntk = K / (BK * NS_); }
    __device__ bool next(int i, Unit& u) const {
        const long L = (long)i * so.G + so.c;
        if (L < so.nwg) return so.next(i, u);
        const int e = (int)(L - so.nwg); if (e >= 8 * NS) return false;
        const int tile = e / NS, ks = e % NS; u.pm = 64 + (tile >> 2); u.pn = tile & 3; u.k0 = ks * ntk * BK; u.nt = ntk; u.ks = ks; return true;
    }
};

template <class Epi, class Sched>
__device__ __forceinline__ void gemm_phase(LAS unsigned char* lds, const Gemm g, const Sched& S, const Epi& E) {
    const int tid = threadIdx.x, wid = __builtin_amdgcn_readfirstlane(tid >> 6), lane = tid & 63, wr = wid >> 2, wc = wid & 3, fr = lane & 15, fq = lane >> 4;
    const int K = g.K;
    unsigned voffA[2], voffB[2];
#pragma unroll
    for (int i = 0; i < 2; ++i) { int R, C; stage_rc(tid * 16 + i * 8192, R, C); const int Rb = (R & ~31) + perm32(R & 31);
        voffA[i] = (unsigned)(R * K + C) * 2u; voffB[i] = (unsigned)(Rb * K + C) * 2u; }
    const size_t kstep = (size_t)(BK * 2);
    const size_t hstep = (size_t)HALF * K * 2;
    const size_t tstep = 2 * hstep;
    const unsigned ldsw = (unsigned)wid * 1024u;
    const int aoff = lds_byte(wr * 64 + fr, fq * 8), boff = lds_byte(wc * 32 + fr, fq * 8);
#define PG8_SA(b, h) (((b) * 2 + (h)) * HTB)
#define PG8_SB(b, h) ((4 + (b) * 2 + (h)) * HTB)
#define PG8_STAGE(bufoff, gbase, voff) do { _Pragma("unroll") for (int _i = 0; _i < 2; ++_i) \
        __builtin_amdgcn_global_load_lds((const unsigned*)((const char*)(gbase) + (voff)[_i]), (LAS unsigned*)(lds + (bufoff) + ldsw + _i * 8192), 16, 0, 0); } while (0)
#define PG8_LDA(dst, b, h) do { _Pragma("unroll") for (int m = 0; m < 4; ++m) _Pragma("unroll") for (int k = 0; k < 2; ++k) dst[m][k] = *(const LAS bf16x8*)(lds + PG8_SA(b, h) + aoff + m * 2048 + k * 1024); } while (0)
#define PG8_LDB(dst, b, h) do { _Pragma("unroll") for (int n = 0; n < 2; ++n) _Pragma("unroll") for (int k = 0; k < 2; ++k) dst[n][k] = *(const LAS bf16x8*)(lds + PG8_SB(b, h) + boff + n * 2048 + k * 1024); } while (0)
#define PG8_MMA(ai, bj, At, Bt) do { __builtin_amdgcn_s_setprio(1); _Pragma("unroll") for (int m = 0; m < 4; ++m) _Pragma("unroll") for (int n = 0; n < 2; ++n) _Pragma("unroll") for (int k = 0; k < 2; ++k) \
        acc[ai][bj][m][n] = __builtin_amdgcn_mfma_f32_16x16x32_bf16(Bt[n][k], At[m][k], acc[ai][bj][m][n], 0, 0, 0); __builtin_amdgcn_s_setprio(0); } while (0)
#define PG8_WAIT_V(n) asm volatile("s_waitcnt vmcnt(" #n ")" ::: "memory")
#define PG8_WAIT_L(n) asm volatile("s_waitcnt lgkmcnt(" #n ")" ::: "memory")
#define PG8_BAR __builtin_amdgcn_s_barrier()
#define PG8_SCHED __builtin_amdgcn_sched_barrier(0)
    Unit cur, nxt; int ui = 0;
    if (!S.next(0, cur)) return;
    f32x4 acc[2][2][4][2];
#pragma unroll
    for (int a = 0; a < 2; ++a)
#pragma unroll
        for (int b = 0; b < 2; ++b)
#pragma unroll
            for (int m = 0; m < 4; ++m)
#pragma unroll
                for (int n = 0; n < 2; ++n) acc[a][b][m][n] = (f32x4){0.f, 0.f, 0.f, 0.f};
    bf16x8 At[4][2], B0[2][2], B1[2][2];
    const char* cA = (const char*)g.A + (size_t)cur.pm * tstep + (size_t)cur.k0 * 2; const char* cB = (const char*)g.Bt + (size_t)cur.pn * tstep + (size_t)cur.k0 * 2;
    PG8_STAGE(PG8_SB(0, 0), cB, voffB); PG8_STAGE(PG8_SA(0, 0), cA, voffA); PG8_STAGE(PG8_SB(0, 1), cB + hstep, voffB); PG8_STAGE(PG8_SA(0, 1), cA + hstep, voffA);
    if (wr == 1) PG8_BAR;
    PG8_WAIT_V(4); PG8_BAR;
    PG8_STAGE(PG8_SB(1, 0), cB + kstep, voffB); PG8_STAGE(PG8_SA(1, 0), cA + kstep, voffA); PG8_STAGE(PG8_SB(1, 1), cB + hstep + kstep, voffB);
    PG8_WAIT_V(6); PG8_BAR;
    for (;;) {
        const bool has_next = S.next(ui + 1, nxt);
        const char* nA = has_next ? (const char*)g.A + (size_t)nxt.pm * tstep + (size_t)nxt.k0 * 2 : cA; const char* nB = has_next ? (const char*)g.Bt + (size_t)nxt.pn * tstep + (size_t)nxt.k0 * 2 : cB;
        const int nt = cur.nt;
        for (int t = 0; t < nt; t += 2) {
            const bool last = (t == nt - 2);
            const char* a1 = cA + (size_t)(t + 1) * kstep;
            const char* a2 = last ? nA : cA + (size_t)(t + 2) * kstep; const char* b2 = last ? nB : cB + (size_t)(t + 2) * kstep;
            const char* a3 = a2 + kstep; const char* b3 = b2 + kstep;
            PG8_LDB(B0, 0, 0); PG8_SCHED; PG8_LDA(At, 0, 0); PG8_STAGE(PG8_SA(1, 1), a1 + hstep, voffA);
            PG8_WAIT_L(8); PG8_BAR; PG8_WAIT_L(0); PG8_MMA(0, 0, At, B0); PG8_BAR; PG8_SCHED;
            PG8_LDB(B1, 0, 1); PG8_STAGE(PG8_SB(0, 0), b2, voffB);
            PG8_BAR; PG8_WAIT_L(0); PG8_MMA(0, 1, At, B1); PG8_BAR;
            PG8_LDA(At, 0, 1); PG8_STAGE(PG8_SA(0, 0), a2, voffA);
            PG8_BAR; PG8_WAIT_L(0); PG8_MMA(1, 0, At, B0); PG8_BAR; PG8_SCHED;
            PG8_STAGE(PG8_SB(0, 1), b2 + hstep, voffB);
            PG8_WAIT_V(6); PG8_BAR; PG8_MMA(1, 1, At, B1); PG8_BAR;
            PG8_LDB(B0, 1, 0); PG8_SCHED; PG8_LDA(At, 1, 0); PG8_STAGE(PG8_SA(0, 1), a2 + hstep, voffA);
            PG8_WAIT_L(8); PG8_BAR; PG8_WAIT_L(0); PG8_MMA(0, 0, At, B0); PG8_BAR; PG8_SCHED;
            PG8_LDB(B1, 1, 1); PG8_STAGE(PG8_SB(1, 0), b3, voffB);
            PG8_BAR; PG8_WAIT_L(0); PG8_MMA(0, 1, At, B1); PG8_BAR;
            PG8_LDA(At, 1, 1); PG8_STAGE(PG8_SA(1, 0), a3, voffA);
            PG8_BAR; PG8_WAIT_L(0); PG8_MMA(1, 0, At, B0); PG8_BAR; PG8_SCHED;
            PG8_STAGE(PG8_SB(1, 1), b3 + hstep, voffB);
            PG8_WAIT_V(6); PG8_BAR; PG8_MMA(1, 1, At, B1); PG8_BAR;
        }
        E(acc, cur, wr, wc, fr, fq);
        if (!has_next) break;
#pragma unroll
        for (int a = 0; a < 2; ++a)
#pragma unroll
            for (int b = 0; b < 2; ++b)
#pragma unroll
                for (int m = 0; m < 4; ++m)
#pragma unroll
                    for (int n = 0; n < 2; ++n) acc[a][b][m][n] = (f32x4){0.f, 0.f, 0.f, 0.f};
        cur = nxt; cA = nA; cB = nB; ++ui;
    }
    PG8_WAIT_V(0);
    if (wr == 0) PG8_BAR;
    PG8_BAR;
#undef PG8_SA
#undef PG8_SB
#undef PG8_STAGE
#undef PG8_LDA
#undef PG8_LDB
#undef PG8_MMA
#undef PG8_WAIT_V
#undef PG8_WAIT_L
#undef PG8_BAR
#undef PG8_SCHED
}
}
using pg8::Unit;

#define EPI_LOOP_BEGIN \
    _Pragma("unroll") for (int ai = 0; ai < 2; ++ai) _Pragma("unroll") for (int m = 0; m < 4; ++m) { const int row = u.pm * 256 + ai * 128 + wr * 64 + m * 16 + fr; \
    _Pragma("unroll") for (int bj = 0; bj < 2; ++bj) { const int lc = bj * 128 + wc * 32 + 8 * fq; const f32x4 v0 = acc[ai][bj][m][0], v1 = acc[ai][bj][m][1];
#define EPI_LOOP_END } }

struct EpiZ {
    bf16_t* Z; bf16_t* QKV; bf16_t* KT;
    __device__ __forceinline__ void operator()(const f32x4 (&acc)[2][2][4][2], const Unit& u, int wr, int wc, int fr, int fq) const {
        const int pn = u.pn;
        if (pn >= 4 && pn < 12) {
#pragma unroll
            for (int ai = 0; ai < 2; ++ai)
#pragma unroll
                for (int m = 0; m < 4; ++m) { const int row = u.pm * 256 + ai * 128 + wr * 64 + m * 16 + fr;
                    const f32x4 a0 = acc[ai][0][m][0] * acc[ai][1][m][0], a1 = acc[ai][0][m][1] * acc[ai][1][m][1];
                    u32x4 w; w.x = cvt_pk_bf16(a0[0], a0[1]); w.y = cvt_pk_bf16(a0[2], a0[3]); w.z = cvt_pk_bf16(a1[0], a1[1]); w.w = cvt_pk_bf16(a1[2], a1[3]);
                    *(u32x4*)(Z + (size_t)row * ZC + Z_U + (pn - 4) * 128 + wc * 32 + 8 * fq) = w; }
            return;
        }
        if (pn >= 12 && pn < 24) {
            const int grp = (pn - 12) >> 2, hh = (pn - 12) & 3;
            bf16_t* dst = QKV + (size_t)grp * NTOK * DM;
            EPI_LOOP_BEGIN
                const size_t rr = row < NPROMPT ? (size_t)((row >> 11) * 4 + hh) * SEQ + (row & 2047) : (size_t)HM_SAMPLE0 + (size_t)(((row - NPROMPT) >> 2) * 4 + hh) * 4 + ((row - NPROMPT) & 3);
                u32x4 w; w.x = cvt_pk_bf16(v0[0], v0[1]); w.y = cvt_pk_bf16(v0[2], v0[3]); w.z = cvt_pk_bf16(v1[0], v1[1]); w.w = cvt_pk_bf16(v1[2], v1[3]);
                *(u32x4*)(dst + rr * 256 + lc) = w;
            EPI_LOOP_END
            return;
        }
        const int zc0 = pn < 4 ? pn * 256 : Z_O + (pn - 24) * 256;
        const bool sg = pn >= 24;
        EPI_LOOP_BEGIN
            f32x4 a0 = v0, a1 = v1;
            if (sg) {
#pragma unroll
                for (int j = 0; j < 4; ++j) { a0[j] = sigmoidf_(a0[j]); a1[j] = sigmoidf_(a1[j]); }
            }
            u32x4 w; w.x = cvt_pk_bf16(a0[0], a0[1]); w.y = cvt_pk_bf16(a0[2], a0[3]); w.z = cvt_pk_bf16(a1[0], a1[1]); w.w = cvt_pk_bf16(a1[2], a1[3]);
            *(u32x4*)(Z + (size_t)row * ZC + zc0 + lc) = w;
        EPI_LOOP_END
    }
};
struct EpiGate {
    bf16_t* O; const bf16_t* T; const bf16_t* Z; int gcol; int add;
    __device__ __forceinline__ void operator()(const f32x4 (&acc)[2][2][4][2], const Unit& u, int wr, int wc, int fr, int fq) const {
        EPI_LOOP_BEGIN
            const int col = u.pn * 256 + lc;
            const u32x4 gw = *(const u32x4*)(Z + (size_t)row * ZC + gcol + col);
            f32x4 a0, a1;
            a0[0] = bf_lo(gw.x) * v0[0]; a0[1] = bf_hi(gw.x) * v0[1]; a0[2] = bf_lo(gw.y) * v0[2]; a0[3] = bf_hi(gw.y) * v0[3];
            a1[0] = bf_lo(gw.z) * v1[0]; a1[1] = bf_hi(gw.z) * v1[1]; a1[2] = bf_lo(gw.w) * v1[2]; a1[3] = bf_hi(gw.w) * v1[3];
            if (add) { const u32x4 tw = *(const u32x4*)(T + (size_t)row * DM + col);
                a0[0] += bf_lo(tw.x); a0[1] += bf_hi(tw.x); a0[2] += bf_lo(tw.y); a0[3] += bf_hi(tw.y); a1[0] += bf_lo(tw.z); a1[1] += bf_hi(tw.z); a1[2] += bf_lo(tw.w); a1[3] += bf_hi(tw.w); }
            u32x4 w; w.x = cvt_pk_bf16(a0[0], a0[1]); w.y = cvt_pk_bf16(a0[2], a0[3]); w.z = cvt_pk_bf16(a1[0], a1[1]); w.w = cvt_pk_bf16(a1[2], a1[3]);
            *(u32x4*)(O + (size_t)row * DM + col) = w;
        EPI_LOOP_END
    }
};
#define EPI_SLAB_PATH \
        if (u.ks >= 0) { float* sl = SL + (size_t)u.ks * NSAMPLE * DM; \
            EPI_LOOP_BEGIN \
                float* dp = sl + (size_t)(row - NPROMPT) * DM + u.pn * 256 + lc; *(f32x4*)dp = v0; *(f32x4*)(dp + 4) = v1; \
            EPI_LOOP_END \
            return; }
struct EpiResX {
    bf16_t* R; const float* xp; const float* xs; float* SL;
    __device__ __forceinline__ void operator()(const f32x4 (&acc)[2][2][4][2], const Unit& u, int wr, int wc, int fr, int fq) const {
        EPI_SLAB_PATH
        EPI_LOOP_BEGIN
            const int col = u.pn * 256 + lc;
            const float* xr = (row < NPROMPT ? xp + (size_t)row * DM : xs + (size_t)(row - NPROMPT) * DM) + col;
            const f32x4 x0 = *(const f32x4*)xr, x1 = *(const f32x4*)(xr + 4);
            const f32x4 a0 = x0 * ALPHA + v0, a1 = x1 * ALPHA + v1;
            u32x4 w; w.x = cvt_pk_bf16(a0[0], a0[1]); w.y = cvt_pk_bf16(a0[2], a0[3]); w.z = cvt_pk_bf16(a1[0], a1[1]); w.w = cvt_pk_bf16(a1[2], a1[3]);
            *(u32x4*)(R + (size_t)row * DM + col) = w;
        EPI_LOOP_END
    }
};
struct EpiResB {
    bf16_t* R; const bf16_t* X1; float* SL;
    __device__ __forceinline__ void operator()(const f32x4 (&acc)[2][2][4][2], const Unit& u, int wr, int wc, int fr, int fq) const {
        EPI_SLAB_PATH
        EPI_LOOP_BEGIN
            const int col = u.pn * 256 + lc;
            const u32x4 xw = *(const u32x4*)(X1 + (size_t)row * DM + col);
            f32x4 a0, a1;
            a0[0] = bf_lo(xw.x) * ALPHA + v0[0]; a0[1] = bf_hi(xw.x) * ALPHA + v0[1]; a0[2] = bf_lo(xw.y) * ALPHA + v0[2]; a0[3] = bf_hi(xw.y) * ALPHA + v0[3];
            a1[0] = bf_lo(xw.z) * ALPHA + v1[0]; a1[1] = bf_hi(xw.z) * ALPHA + v1[1]; a1[2] = bf_lo(xw.w) * ALPHA + v1[2]; a1[3] = bf_hi(xw.w) * ALPHA + v1[3];
            u32x4 w; w.x = cvt_pk_bf16(a0[0], a0[1]); w.y = cvt_pk_bf16(a0[2], a0[3]); w.z = cvt_pk_bf16(a1[0], a1[1]); w.w = cvt_pk_bf16(a1[2], a1[3]);
            *(u32x4*)(R + (size_t)row * DM + col) = w;
        EPI_LOOP_END
    }
};
struct EpiHid {
    bf16_t* Hd;
    __device__ __forceinline__ void operator()(const f32x4 (&acc)[2][2][4][2], const Unit& u, int wr, int wc, int fr, int fq) const {
        EPI_LOOP_BEGIN
            const int col = u.pn * 256 + lc;
            f32x4 a0, a1;
#pragma unroll
            for (int j = 0; j < 4; ++j) { const float r0 = fmaxf(v0[j], 0.f), r1 = fmaxf(v1[j], 0.f); a0[j] = r0 * r0; a1[j] = r1 * r1; }
            u32x4 w; w.x = cvt_pk_bf16(a0[0], a0[1]); w.y = cvt_pk_bf16(a0[2], a0[3]); w.z = cvt_pk_bf16(a1[0], a1[1]); w.w = cvt_pk_bf16(a1[2], a1[3]);
            *(u32x4*)(Hd + (size_t)row * DFF + col) = w;
        EPI_LOOP_END
    }
};

__device__ __forceinline__ void transpose_item(const float* W, int ldw, int K, int src0, bf16_t* WT, int dst0, int kb, float scale, LAS float* scr, int lane) {
    const int k0 = kb * 64;
#pragma unroll 8
    for (int i = 0; i < 32; ++i) { const int kk = 2 * i + (lane >> 5); scr[kk * 33 + (lane & 31)] = W[(size_t)(k0 + kk) * ldw + src0 + (lane & 31)]; }
    LDS_WAIT();
    const int c = lane & 7;
#pragma unroll
    for (int j = 0; j < 4; ++j) { const int n = (lane >> 3) + 8 * j; const LAS float* s = scr + (8 * c) * 33 + n;
        u32x4 o; o.x = cvt_pk_bf16(s[0 * 33] * scale, s[1 * 33] * scale); o.y = cvt_pk_bf16(s[2 * 33] * scale, s[3 * 33] * scale);
        o.z = cvt_pk_bf16(s[4 * 33] * scale, s[5 * 33] * scale); o.w = cvt_pk_bf16(s[6 * 33] * scale, s[7 * 33] * scale);
        *(u32x4*)(WT + (size_t)(dst0 + n) * K + k0 + 8 * c) = o; }
    LDS_WAIT();
}
__device__ __forceinline__ void weight_items(const Params& p, LAS unsigned char* lds, int it_lo, int it_hi, int gw, int NGW) {
    const int wid = threadIdx.x >> 6, lane = threadIdx.x & 63;
    LAS float* scr = (LAS float*)(lds + wid * 8704);
    bf16_t* WIN = (bf16_t*)(p.ws + WS_WIN);
    constexpr int I_IN = 72 * 4 * 16, I_SQ = 32 * 16, I_F1 = 128 * 16;
    for (int it = it_lo + gw; it < it_hi; it += NGW) {
        int r = it;
        if (r < I_IN) { const int kb = r & 15, nb = r >> 4, g = nb >> 2, sub = nb & 3;
            int src; if (g < 8) src = g * 128; else if (g < 24) { const int pr = (g - 8) >> 1, hf = (g - 8) & 1; src = (hf ? 2048 : 1024) + pr * 128; } else if (g < 56) src = 3072 + (g - 24) * 128; else src = 7176 + (g - 56) * 128;
            const float sc = (g >= 32 && g < 40) ? 0.0625f : 1.0f;
            transpose_item(p.w_in, DIN, DM, src + sub * 32, WIN, g * 128 + sub * 32, kb, sc, scr, lane); continue; }
        r -= I_IN;
        if (r < 3 * I_SQ) { const int w = r / I_SQ, q = r % I_SQ, kb = q & 15, nb = q >> 4;
            const float* W = w == 0 ? p.w_co : (w == 1 ? p.w_mo : p.w_o); bf16_t* WT = (bf16_t*)(p.ws + (w == 0 ? WS_WC : (w == 1 ? WS_WM : WS_WO)));
            transpose_item(W, DM, DM, nb * 32, WT, nb * 32, kb, 1.0f, scr, lane); continue; }
        r -= 3 * I_SQ;
        if (r < I_F1) { const int kb = r & 15, nb = r >> 4; transpose_item(p.w_ff1, DFF, DM, nb * 32, (bf16_t*)(p.ws + WS_W1), nb * 32, kb, 1.0f, scr, lane); continue; }
        r -= I_F1;
        { const int kb = r & 63, nb = r >> 6; transpose_item(p.w_ff2, DM, DFF, nb * 32, (bf16_t*)(p.ws + WS_W2), nb * 32, kb, 1.0f, scr, lane); }
    }
}
#define P0_W_HI (gridDim.x == 256 ? WI_IN : WI_ALL)
constexpr int WI_IN = 72 * 4 * 16, WI_ALL = WI_IN + 3 * 32 * 16 + 128 * 16 + 32 * 64;
__device__ __forceinline__ void phase0(const Params& p, LAS unsigned char* lds) {
    const int tid = threadIdx.x, wid = tid >> 6, lane = tid & 63;
    const int gw = blockIdx.x * 8 + wid, NGW = gridDim.x * 8;
    LAS float* wg = (LAS float*)(lds + 73728);
    for (int e = tid; e < 2048; e += 512) { const int k = e >> 1, hf = e & 1; *(LAS f32x4*)(wg + k * 8 + hf * 4) = *(const f32x4*)(p.w_in + (size_t)k * DIN + 7168 + hf * 4); }
    __syncthreads();
    weight_items(p, lds, 0, P0_W_HI, gw, NGW);
    bf16_t* XB = (bf16_t*)(p.ws + WS_XB); float* G = (float*)(p.ws + WS_G);
    for (int r = gw; r < NTOK; r += NGW) {
        const float* xr = xrow(p, r);
        float g8[8];
#pragma unroll
        for (int j = 0; j < 8; ++j) g8[j] = 0.f;
#pragma unroll
        for (int j = 0; j < 4; ++j) { const int k = j * 256 + lane * 4; const f32x4 v = *(const f32x4*)(xr + k);
            u32x2 w; w.x = cvt_pk_bf16(v[0], v[1]); w.y = cvt_pk_bf16(v[2], v[3]); *(u32x2*)(XB + (size_t)r * DM + k) = w;
#pragma unroll
            for (int e = 0; e < 4; ++e) { const f32x4 wa = *(const LAS f32x4*)(wg + (k + e) * 8), wb = *(const LAS f32x4*)(wg + (k + e) * 8 + 4);
#pragma unroll
                for (int q = 0; q < 4; ++q) { g8[q] += v[e] * wa[q]; g8[4 + q] += v[e] * wb[q]; } } }
#pragma unroll
        for (int j = 0; j < 8; ++j) g8[j] = wave_sum(g8[j]);
        if (lane < 4) { G[(size_t)r * 8 + lane] = g8[0] * (lane == 0) + g8[1] * (lane == 1) + g8[2] * (lane == 2) + g8[3] * (lane == 3) + p.b_gate[lane]; }
        else if (lane < 8) { const float f = g8[4] * (lane == 4) + g8[5] * (lane == 5) + g8[6] * (lane == 6) + g8[7] * (lane == 7) + p.b_gate[lane];
            G[(size_t)r * 8 + lane] = fminf(f, 0.f) - log1pf(__expf(-fabsf(f))); }
    }
    __syncthreads();
}

constexpr int KS_LD = 264, VT_LD = 136;
constexpr int L_KSH = 0, L_CT = 128 * KS_LD * 2, L_VT = L_CT + 48 * KS_LD * 2, L_VW = L_VT + 48 * VT_LD * 2, L_SC = L_VW + 48 * VT_LD * 2;
__device__ __forceinline__ void mlstm_prompt_item(const Params& p, LAS unsigned char* lds, int bh, int vs) {
    const int tid = threadIdx.x, wid = __builtin_amdgcn_readfirstlane(tid >> 6), lane = tid & 63, li = lane & 15, kg = lane >> 4;
    const int b = bh >> 2, h = bh & 3, j0 = vs * 32;
    LAS bf16_t* Ksh = (LAS bf16_t*)(lds + L_KSH); LAS bf16_t* CTsh = (LAS bf16_t*)(lds + L_CT); LAS bf16_t* VTsh = (LAS bf16_t*)(lds + L_VT); LAS bf16_t* VWsh = (LAS bf16_t*)(lds + L_VW);
    LAS float* sA = (LAS float*)(lds + L_SC); LAS float* sG = sA + 128; LAS float* sB = sG + 128;
    const bf16_t* QH = (const bf16_t*)(p.ws + WS_QKV) + (size_t)bh * SEQ * 256; const bf16_t* KH = QH + (size_t)NTOK * DM; const bf16_t* VH = KH + (size_t)NTOK * DM;
    const float* G = (const float*)(p.ws + WS_G) + (size_t)b * SEQ * 8; bf16_t* H = (bf16_t*)(p.ws + WS_H);
    for (int e = tid; e < 48 * KS_LD / 2; e += 512) ((LAS unsigned*)CTsh)[e] = 0u;
    for (int e = tid; e < 16 * VT_LD; e += 512) { const int rr = e / VT_LD; VTsh[32 * VT_LD + e] = rr == 0 ? (bf16_t)0x3F80 : (bf16_t)0; VWsh[32 * VT_LD + e] = 0; }
    f32x4 Cacc[2][3];
#pragma unroll
    for (int db = 0; db < 2; ++db)
#pragma unroll
        for (int jb = 0; jb < 3; ++jb) Cacc[db][jb] = (f32x4){0.f, 0.f, 0.f, 0.f};
    float m_prev = 0.f;
    const int vs_s = tid >> 2, vs_q = tid & 3;
    u32x4 kp[8]; u32x4 vp; bf16x8 qf[8]; float gi0 = 0.f, gf0 = 0.f, gi1 = 0.f, gf1 = 0.f;
#pragma unroll
    for (int i = 0; i < 8; ++i) kp[i] = *(const u32x4*)(KH + (size_t)(i * 512 + tid) * 8);
    vp = *(const u32x4*)(VH + (size_t)vs_s * 256 + j0 + vs_q * 8);
#pragma unroll
    for (int kk = 0; kk < 8; ++kk) qf[kk] = *(const bf16x8*)(QH + (size_t)(16 * wid + li) * 256 + kk * 32 + kg * 8);
    if (wid == 0) { gi0 = G[(size_t)lane * 8 + h]; gf0 = G[(size_t)lane * 8 + 4 + h]; gi1 = G[(size_t)(64 + lane) * 8 + h]; gf1 = G[(size_t)(64 + lane) * 8 + 4 + h]; }
    for (int c = 0; c < 16; ++c) {
        const int t0 = c * 128, tn = (c < 15 ? c + 1 : c) * 128;
        if (wid == 0) {
            float b0 = gf0, b1 = gf1;
#pragma unroll
            for (int o = 1; o < 64; o <<= 1) { const float x0 = __shfl_up(b0, o), x1 = __shfl_up(b1, o); if (lane >= o) { b0 += x0; b1 += x1; } }
            b1 += __shfl(b0, 63);
            const float a0 = gi0 - b0, a1 = gi1 - b1;
            float p0 = a0, p1 = a1;
#pragma unroll
            for (int o = 1; o < 64; o <<= 1) { const float x0 = __shfl_up(p0, o), x1 = __shfl_up(p1, o); if (lane >= o) { p0 = fmaxf(p0, x0); p1 = fmaxf(p1, x1); } }
            p1 = fmaxf(p1, __shfl(p0, 63));
            sA[lane] = a0; sA[64 + lane] = a1; sG[lane] = fmaxf(m_prev, p0); sG[64 + lane] = fmaxf(m_prev, p1); sB[lane] = b0; sB[64 + lane] = b1;
            gi0 = G[(size_t)(tn + lane) * 8 + h]; gf0 = G[(size_t)(tn + lane) * 8 + 4 + h]; gi1 = G[(size_t)(tn + 64 + lane) * 8 + h]; gf1 = G[(size_t)(tn + 64 + lane) * 8 + 4 + h];
        }
        __syncthreads();
        const float g_last = sG[127], b_last = sB[127];
#pragma unroll
        for (int i = 0; i < 8; ++i) { const int pc = i * 512 + tid, row = pc >> 5, c8 = pc & 31; *(LAS u32x4*)(Ksh + row * KS_LD + c8 * 8) = kp[i]; }
        {
            const float wsv = __expf(sA[vs_s] - g_last);
            const unsigned vw[4] = {vp.x, vp.y, vp.z, vp.w};
#pragma unroll
            for (int e = 0; e < 4; ++e) { const int j = vs_q * 8 + 2 * e; const float lo = bf_lo(vw[e]), hi = bf_hi(vw[e]);
                VTsh[j * VT_LD + vs_s] = (bf16_t)(vw[e] & 0xffff); VTsh[(j + 1) * VT_LD + vs_s] = (bf16_t)(vw[e] >> 16);
                const unsigned sw = cvt_pk_bf16(lo * wsv, hi * wsv);
                VWsh[j * VT_LD + vs_s] = (bf16_t)(sw & 0xffff); VWsh[(j + 1) * VT_LD + vs_s] = (bf16_t)(sw >> 16); }
            if (vs_q == 0) VWsh[32 * VT_LD + vs_s] = (bf16_t)(cvt_pk_bf16(wsv, 0.f) & 0xffff);
        }
#pragma unroll
        for (int i = 0; i < 8; ++i) kp[i] = *(const u32x4*)(KH + (size_t)tn * 256 + (size_t)(i * 512 + tid) * 8);
        vp = *(const u32x4*)(VH + (size_t)(tn + vs_s) * 256 + j0 + vs_q * 8);
        __syncthreads();
        {
            const int t_loc = 16 * wid + li;
            const float g_t = sG[t_loc], b_t = sB[t_loc];
            f32x4 ST[8];
#pragma unroll
            for (int sb = 0; sb < 8; ++sb) ST[sb] = (f32x4){0.f, 0.f, 0.f, 0.f};
#pragma unroll
            for (int kk = 0; kk < 8; ++kk) {
#pragma unroll
                for (int hf = 0; hf < 2; ++hf) {
                    bf16x8 kf[4];
#pragma unroll
                    for (int sb = 0; sb < 4; ++sb) kf[sb] = *(const LAS bf16x8*)(Ksh + ((hf * 4 + sb) * 16 + li) * KS_LD + kk * 32 + kg * 8);
#pragma unroll
                    for (int sb = 0; sb < 4; ++sb) ST[hf * 4 + sb] = __builtin_amdgcn_mfma_f32_16x16x32_bf16(kf[sb], qf[kk], ST[hf * 4 + sb], 0, 0, 0);
                }
            }
#pragma unroll
            for (int sb = 0; sb < 8; ++sb) { const f32x4 av = *(const LAS f32x4*)(sA + sb * 16 + kg * 4);
#pragma unroll
                for (int r = 0; r < 4; ++r) { const float wgt = __expf(av[r] - g_t); const bool ok = (sb * 16 + kg * 4 + r) <= t_loc; ST[sb][r] = ok ? ST[sb][r] * wgt : 0.f; } }
            f32x4 nt[3], it[3];
#pragma unroll
            for (int jb = 0; jb < 3; ++jb) { nt[jb] = (f32x4){0.f, 0.f, 0.f, 0.f}; it[jb] = (f32x4){0.f, 0.f, 0.f, 0.f}; }
#pragma unroll
            for (int k2 = 0; k2 < 4; ++k2) {
                u32x4 pw; pw.x = cvt_pk_bf16(ST[2 * k2][0], ST[2 * k2][1]); pw.y = cvt_pk_bf16(ST[2 * k2][2], ST[2 * k2][3]);
                pw.z = cvt_pk_bf16(ST[2 * k2 + 1][0], ST[2 * k2 + 1][1]); pw.w = cvt_pk_bf16(ST[2 * k2 + 1][2], ST[2 * k2 + 1][3]);
                bf16x8 pf; __builtin_memcpy(&pf, &pw, 16);
#pragma unroll
                for (int jb = 0; jb < 3; ++jb) { const LAS bf16_t* vr = VTsh + (jb * 16 + li) * VT_LD + k2 * 32 + kg * 4;
                    u32x4 vw4; const u32x2 lo = *(const LAS u32x2*)vr, hi = *(const LAS u32x2*)(vr + 16); vw4.x = lo.x; vw4.y = lo.y; vw4.z = hi.x; vw4.w = hi.y;
                    bf16x8 vf; __builtin_memcpy(&vf, &vw4, 16);
                    nt[jb] = __builtin_amdgcn_mfma_f32_16x16x32_bf16(vf, pf, nt[jb], 0, 0, 0); } }
#pragma unroll
            for (int kk = 0; kk < 8; ++kk)
#pragma unroll
                for (int jb = 0; jb < 3; ++jb) { const bf16x8 cf = *(const LAS bf16x8*)(CTsh + (jb * 16 + li) * KS_LD + kk * 32 + kg * 8);
                    it[jb] = __builtin_amdgcn_mfma_f32_16x16x32_bf16(cf, qf[kk], it[jb], 0, 0, 0); }
#pragma unroll
            for (int kk = 0; kk < 8; ++kk) qf[kk] = *(const bf16x8*)(QH + (size_t)(tn + 16 * wid + li) * 256 + kk * 32 + kg * 8);
            const float w_int = __expf(m_prev - g_t);
#pragma unroll
            for (int jb = 0; jb < 3; ++jb) nt[jb] = nt[jb] + it[jb] * w_int;
            const float den = __shfl(nt[2][0], li);
            const float rden = 1.0f / fmaxf(fabsf(den), __expf(-(b_t + g_t)));
#pragma unroll
            for (int jb = 0; jb < 2; ++jb) { u32x2 w; w.x = cvt_pk_bf16(nt[jb][0] * rden, nt[jb][1] * rden); w.y = cvt_pk_bf16(nt[jb][2] * rden, nt[jb][3] * rden);
                *(u32x2*)(H + (size_t)(b * SEQ + t0 + t_loc) * DM + h * 256 + j0 + jb * 16 + kg * 4) = w; }
        }
        __syncthreads();
        {
            const float decay = __expf(m_prev - g_last);
#pragma unroll
            for (int db = 0; db < 2; ++db)
#pragma unroll
                for (int jb = 0; jb < 3; ++jb) Cacc[db][jb] = Cacc[db][jb] * decay;
            u32x2 kt2[2][4][2];
            {
                const unsigned tb = (unsigned)(uintptr_t)(lds + L_KSH) + (unsigned)(((kg * 8 + (li >> 2)) * KS_LD + (2 * wid) * 16 + 4 * (li & 3)) * 2);
#pragma unroll
                for (int db = 0; db < 2; ++db)
#pragma unroll
                    for (int k2 = 0; k2 < 4; ++k2)
#pragma unroll
                        for (int hf = 0; hf < 2; ++hf)
                            asm volatile("ds_read_b64_tr_b16 %0, %1 offset:%2" : "=&v"(kt2[db][k2][hf]) : "v"(tb), "i"(((k2 * 32 + hf * 4) * KS_LD + db * 16) * 2) : "memory");
#pragma unroll
                for (int db = 0; db < 2; ++db)
                    asm volatile("s_waitcnt lgkmcnt(0)" : "+v"(kt2[db][0][0]), "+v"(kt2[db][0][1]), "+v"(kt2[db][1][0]), "+v"(kt2[db][1][1]), "+v"(kt2[db][2][0]), "+v"(kt2[db][2][1]), "+v"(kt2[db][3][0]), "+v"(kt2[db][3][1]) :: "memory");
            }
#pragma unroll
            for (int k2 = 0; k2 < 4; ++k2)
#pragma unroll
                for (int jb = 0; jb < 3; ++jb) { const bf16x8 vf = *(const LAS bf16x8*)(VWsh + (jb * 16 + li) * VT_LD + k2 * 32 + kg * 8);
#pragma unroll
                    for (int db = 0; db < 2; ++db) { u32x4 kw; kw.x = kt2[db][k2][0].x; kw.y = kt2[db][k2][0].y; kw.z = kt2[db][k2][1].x; kw.w = kt2[db][k2][1].y; bf16x8 kf8; __builtin_memcpy(&kf8, &kw, 16);
                        Cacc[db][jb] = __builtin_amdgcn_mfma_f32_16x16x32_bf16(kf8, vf, Cacc[db][jb], 0, 0, 0); } }
#pragma unroll
            for (int db = 0; db < 2; ++db)
#pragma unroll
                for (int jb = 0; jb < 3; ++jb) { u32x2 w; w.x = cvt_pk_bf16(Cacc[db][jb][0], Cacc[db][jb][1]); w.y = cvt_pk_bf16(Cacc[db][jb][2], Cacc[db][jb][3]);
                    *(LAS u32x2*)(CTsh + (jb * 16 + li) * KS_LD + (2 * wid + db) * 16 + kg * 4) = w; }
            m_prev = b_last + g_last;
        }
    }
#pragma unroll
    for (int db = 0; db < 2; ++db) { const int d0 = (2 * wid + db) * 16 + kg * 4;
#pragma unroll
        for (int jb = 0; jb < 2; ++jb)
#pragma unroll
            for (int r = 0; r < 4; ++r) p.out[O_CP + ((size_t)(bh * 256 + d0 + r)) * 256 + j0 + jb * 16 + li] = Cacc[db][jb][r];
        if (vs == 0 && li == 0) {
#pragma unroll
            for (int r = 0; r < 4; ++r) p.out[O_NP + (size_t)bh * 256 + d0 + r] = Cacc[db][2][r]; } }
    if (vs == 0 && tid == 0) p.out[O_MP + bh] = m_prev;
    __syncthreads();
}

template <bool UPD>
__device__ __forceinline__ void mlstm_sample_item(const Params& p, LAS unsigned char* lds, int item) {
    const int tid = threadIdx.x, bs = item >> 2, h = item & 3, tok0 = NPROMPT + bs * 4;
    LAS float* sq = (LAS float*)lds; LAS float* sk = sq + 1024; LAS float* sv = sk + 1024; LAS float* sn0 = sv + 1024; LAS float* sdot = sn0 + 256; LAS float* sc = sdot + 32; LAS float* sred = sc + 64;
    const bf16_t* QS = (const bf16_t*)(p.ws + WS_QKV) + ((size_t)HM_SAMPLE0 + (size_t)item * 4) * 256;
    const float* G = (const float*)(p.ws + WS_G); bf16_t* H = (bf16_t*)(p.ws + WS_H);
    const int c4 = tid & 63, rw = tid >> 6, col = c4 * 4;
    const float* C0 = p.sC + (size_t)item * 65536 + (size_t)(rw * 32) * 256 + col; float* C1 = p.out + O_CS + (size_t)item * 65536 + (size_t)(rw * 32) * 256 + col;
    f32x4 cv[8];
#pragma unroll
    for (int j = 0; j < 8; ++j) cv[j] = __builtin_nontemporal_load((const f32x4*)(C0 + j * 256));
    for (int e = tid; e < 3072; e += 512) { const int which = e >> 10, idx = e & 1023; sq[e] = bf2f(QS[(size_t)which * NTOK * DM + idx]); }
    if (tid < 256) sn0[tid] = p.sn[(size_t)item * 256 + tid];
    __syncthreads();
    {
        const int id = tid >> 4, part = tid & 15;
        if (id < 20) { const LAS float* va = id < 16 ? sq + (id >> 2) * 256 : sq + (id - 16) * 256; const LAS float* vb = id < 16 ? sk + (id & 3) * 256 : sn0;
            float s = 0.f;
#pragma unroll
            for (int e = 0; e < 16; ++e) s += va[part * 16 + e] * vb[part * 16 + e];
            s += __shfl_xor(s, 8); s += __shfl_xor(s, 4); s += __shfl_xor(s, 2); s += __shfl_xor(s, 1);
            if (part == 0) sdot[id] = s; }
    }
    __syncthreads();
    if (tid == 0) {
        const float m0 = p.sm[item];
        float li_[4], lf_[4], bb[4], aa[4], gg[4];
#pragma unroll
        for (int s = 0; s < 4; ++s) { li_[s] = G[(size_t)(tok0 + s) * 8 + h]; lf_[s] = G[(size_t)(tok0 + s) * 8 + 4 + h]; }
        float cum = 0.f, pm = m0;
#pragma unroll
        for (int s = 0; s < 4; ++s) { cum += lf_[s]; bb[s] = cum; aa[s] = li_[s] - cum; pm = fmaxf(pm, aa[s]); gg[s] = pm; }
#pragma unroll
        for (int t = 0; t < 4; ++t) { const float wi = __expf(m0 - gg[t]); float den = wi * sdot[16 + t];
#pragma unroll
            for (int s = 0; s < 4; ++s) { const float S = s <= t ? sdot[t * 4 + s] * __expf(aa[s] - gg[t]) : 0.f; sc[16 + t * 4 + s] = S; den += S; }
            sc[t] = wi; sc[12 + t] = 1.0f / fmaxf(fabsf(den), __expf(-(bb[t] + gg[t]))); }
#pragma unroll
        for (int s = 0; s < 4; ++s) sc[4 + s] = __expf(aa[s] - gg[3]);
        sc[8] = __expf(m0 - gg[3]); sc[9] = bb[3] + gg[3];
    }
    __syncthreads();
    const float decay = sc[8]; const float ws0 = sc[4], ws1 = sc[5], ws2 = sc[6], ws3 = sc[7];
    const f32x4 v0 = *(const LAS f32x4*)(sv + col), v1 = *(const LAS f32x4*)(sv + 256 + col), v2 = *(const LAS f32x4*)(sv + 512 + col), v3 = *(const LAS f32x4*)(sv + 768 + col);
    f32x4 a0 = {0.f, 0.f, 0.f, 0.f}, a1 = a0, a2 = a0, a3 = a0;
#pragma unroll
    for (int rb = 0; rb < 4; ++rb) {
        f32x4 cn[8];
        if (rb < 3) {
#pragma unroll
            for (int j = 0; j < 8; ++j) cn[j] = __builtin_nontemporal_load((const f32x4*)(C0 + ((rb + 1) * 8 + j) * 256));
        }
#pragma unroll
        for (int j = 0; j < 8; ++j) { const int d = rw * 32 + rb * 8 + j; const f32x4 x = cv[j];
            a0 += x * sq[d]; a1 += x * sq[256 + d]; a2 += x * sq[512 + d]; a3 += x * sq[768 + d];
            const f32x4 y = x * decay + v0 * (ws0 * sk[d]) + v1 * (ws1 * sk[256 + d]) + v2 * (ws2 * sk[512 + d]) + v3 * (ws3 * sk[768 + d]);
            if (UPD) __builtin_nontemporal_store(y, (f32x4*)(C1 + (rb * 8 + j) * 256)); }
        if (rb < 3) {
#pragma unroll
            for (int j = 0; j < 8; ++j) cv[j] = cn[j];
        }
    }
    *(LAS f32x4*)(sred + (rw * 4 + 0) * 256 + col) = a0; *(LAS f32x4*)(sred + (rw * 4 + 1) * 256 + col) = a1; *(LAS f32x4*)(sred + (rw * 4 + 2) * 256 + col) = a2; *(LAS f32x4*)(sred + (rw * 4 + 3) * 256 + col) = a3;
    __syncthreads();
#pragma unroll
    for (int e = 0; e < 2; ++e) { const int o = tid + 512 * e, t = o >> 8, cx = o & 255;
        float inter = 0.f;
#pragma unroll
        for (int w = 0; w < 8; ++w) inter += sred[(w * 4 + t) * 256 + cx];
        float num = sc[t] * inter;
#pragma unroll
        for (int s = 0; s < 4; ++s) num += sc[16 + t * 4 + s] * sv[s * 256 + cx];
        H[(size_t)(tok0 + t) * DM + h * 256 + cx] = (bf16_t)(cvt_pk_bf16(num * sc[12 + t], 0.f) & 0xffff); }
    if (tid < 256) p.out[O_NS + (size_t)item * 256 + tid] = decay * sn0[tid] + ws0 * sk[tid] + ws1 * sk[256 + tid] + ws2 * sk[512 + tid] + ws3 * sk[768 + tid];
    if (tid == 0) p.out[O_MS + item] = sc[9];
    __syncthreads();
}

__device__ __forceinline__ void mlstm_sample_upd(const Params& p, LAS unsigned char* lds, int item) {
    const int tid = threadIdx.x, bs = item >> 2, h = item & 3, tok0 = NPROMPT + bs * 4;
    LAS float* sk = (LAS float*)lds; LAS float* sv = sk + 1024; LAS float* sc = sv + 1024;
    const bf16_t* KS = (const bf16_t*)(p.ws + WS_QKV) + (size_t)NTOK * DM + ((size_t)HM_SAMPLE0 + (size_t)item * 4) * 256;
    const float* G = (const float*)(p.ws + WS_G);
    const int c4 = tid & 63, rw = tid >> 6, col = c4 * 4;
    const float* C0 = p.sC + (size_t)item * 65536 + (size_t)(rw * 32) * 256 + col; float* C1 = p.out + O_CS + (size_t)item * 65536 + (size_t)(rw * 32) * 256 + col;
    f32x4 cv[8];
#pragma unroll
    for (int j = 0; j < 8; ++j) cv[j] = __builtin_nontemporal_load((const f32x4*)(C0 + j * 256));
    for (int e = tid; e < 2048; e += 512) { const int which = e >> 10, idx = e & 1023; sk[e] = bf2f(KS[(size_t)which * NTOK * DM + idx]); }
    if (tid == 0) {
        const float m0 = p.sm[item];
        float cum = 0.f, pm = m0, aa[4];
#pragma unroll
        for (int s = 0; s < 4; ++s) { cum += G[(size_t)(tok0 + s) * 8 + 4 + h]; aa[s] = G[(size_t)(tok0 + s) * 8 + h] - cum; pm = fmaxf(pm, aa[s]); }
#pragma unroll
        for (int s = 0; s < 4; ++s) sc[4 + s] = __expf(aa[s] - pm);
        sc[8] = __expf(m0 - pm);
    }
    __syncthreads();
    const float decay = sc[8]; const float ws0 = sc[4], ws1 = sc[5], ws2 = sc[6], ws3 = sc[7];
    const f32x4 v0 = *(const LAS f32x4*)(sv + col), v1 = *(const LAS f32x4*)(sv + 256 + col), v2 = *(const LAS f32x4*)(sv + 512 + col), v3 = *(const LAS f32x4*)(sv + 768 + col);
#pragma unroll
    for (int rb = 0; rb < 4; ++rb) {
        f32x4 cn[8];
        if (rb < 3) {
#pragma unroll
            for (int j = 0; j < 8; ++j) cn[j] = __builtin_nontemporal_load((const f32x4*)(C0 + ((rb + 1) * 8 + j) * 256));
        }
#pragma unroll
        for (int j = 0; j < 8; ++j) { const int d = rw * 32 + rb * 8 + j; const f32x4 x = cv[j];
            const f32x4 y = x * decay + v0 * (ws0 * sk[d]) + v1 * (ws1 * sk[256 + d]) + v2 * (ws2 * sk[512 + d]) + v3 * (ws3 * sk[768 + d]);
            __builtin_nontemporal_store(y, (f32x4*)(C1 + (rb * 8 + j) * 256)); }
        if (rb < 3) {
#pragma unroll
            for (int j = 0; j < 8; ++j) cv[j] = cn[j];
        }
    }
    __syncthreads();
}
__device__ __forceinline__ void upd_slot(const Params& p, LAS unsigned char* lds, int lo, int hi, int wk, int nwk) { for (int it = lo + wk; it < hi; it += nwk) mlstm_sample_upd(p, lds, it); }
constexpr int UPD_A = 128, UPD_B = 320;

__device__ __forceinline__ void conv_unit(const Params& p, const bf16_t* Z, bf16_t* AC, int r, int ch, const float (&cw)[24], u32x4 uw, u32x4 bw, u32x4 w1, u32x4 w2) {
    float u0[8], u1[8], u2[8], bg[8];
    const unsigned uu[4] = {uw.x, uw.y, uw.z, uw.w}, bb[4] = {bw.x, bw.y, bw.z, bw.w}, q1[4] = {w1.x, w1.y, w1.z, w1.w}, q2[4] = {w2.x, w2.y, w2.z, w2.w};
#pragma unroll
    for (int e = 0; e < 4; ++e) { u2[2 * e] = bf_lo(uu[e]); u2[2 * e + 1] = bf_hi(uu[e]); bg[2 * e] = bf_lo(bb[e]); bg[2 * e + 1] = bf_hi(bb[e]);
        u1[2 * e] = bf_lo(q1[e]); u1[2 * e + 1] = bf_hi(q1[e]); u0[2 * e] = bf_lo(q2[e]); u0[2 * e + 1] = bf_hi(q2[e]); }
    const bool prompt = r < NPROMPT; const int t = prompt ? (r & 2047) : ((r - NPROMPT) & 3); const int bs = (r - NPROMPT) >> 2;
    if (t < 1) { if (prompt) {
#pragma unroll
            for (int e = 0; e < 8; ++e) u1[e] = 0.f; }
        else { const float* sp = p.sconv + ((size_t)bs * 2 + 1) * DM + ch;
#pragma unroll
            for (int e = 0; e < 8; ++e) u1[e] = sp[e]; } }
    if (t < 2) { if (prompt) {
#pragma unroll
            for (int e = 0; e < 8; ++e) u0[e] = 0.f; }
        else { const float* sp = p.sconv + ((size_t)bs * 2 + t) * DM + ch;
#pragma unroll
            for (int e = 0; e < 8; ++e) u0[e] = sp[e]; } }
    float o[8];
#pragma unroll
    for (int e = 0; e < 8; ++e) o[e] = bg[e] * (cw[e] * u0[e] + cw[8 + e] * u1[e] + cw[16 + e] * u2[e]);
    u32x4 w; w.x = cvt_pk_bf16(o[0], o[1]); w.y = cvt_pk_bf16(o[2], o[3]); w.z = cvt_pk_bf16(o[4], o[5]); w.w = cvt_pk_bf16(o[6], o[7]);
    *(u32x4*)(AC + (size_t)r * DM + ch) = w;
    float* so = nullptr;
    if (prompt) { if (t >= SEQ - 2) so = p.out + O_CONVP + ((size_t)(r >> 11) * 2 + (t - (SEQ - 2))) * DM + ch; }
    else if (t >= 2) so = p.out + O_CONVS + ((size_t)bs * 2 + (t - 2)) * DM + ch;
    if (so) {
#pragma unroll
        for (int e = 0; e < 8; ++e) so[e] = u2[e]; }
}
__device__ __forceinline__ void conv_items(const Params& p) {
    const bf16_t* Z = (const bf16_t*)(p.ws + WS_Z); bf16_t* AC = (bf16_t*)(p.ws + WS_AC);
    const int gt = blockIdx.x * 512 + threadIdx.x, NG = gridDim.x * 512;
    const int ch = (gt & 127) * 8, r0 = gt >> 7, rstep = NG >> 7;
    float cw[24];
#pragma unroll
    for (int e = 0; e < 8; ++e) { cw[e] = p.conv_w[ch + e]; cw[8 + e] = p.conv_w[DM + ch + e]; cw[16 + e] = p.conv_w[2 * DM + ch + e]; }
    for (int rb = r0; rb < NTOK; rb += 4 * rstep) {
        u32x4 uw[4], bw[4], w1[4], w2[4];
#pragma unroll
        for (int j = 0; j < 4; ++j) { const int r = rb + j * rstep; if (r < NTOK) { const int r1 = r >= 1 ? r - 1 : r, r2 = r >= 2 ? r - 2 : r;
            uw[j] = *(const u32x4*)(Z + (size_t)r * ZC + Z_U + ch); bw[j] = *(const u32x4*)(Z + (size_t)r * ZC + Z_BG + ch);
            w1[j] = *(const u32x4*)(Z + (size_t)r1 * ZC + Z_U + ch); w2[j] = *(const u32x4*)(Z + (size_t)r2 * ZC + Z_U + ch); } }
#pragma unroll
        for (int j = 0; j < 4; ++j) { const int r = rb + j * rstep; if (r < NTOK) conv_unit(p, Z, AC, r, ch, cw, uw[j], bw[j], w1[j], w2[j]); }
    }
}

__device__ __forceinline__ void hn_items(const Params& p, int wblk, int nwblk) {
    const bf16_t* Z = (const bf16_t*)(p.ws + WS_Z); const bf16_t* H = (const bf16_t*)(p.ws + WS_H); bf16_t* HN = (bf16_t*)(p.ws + WS_HN);
    const int lane = threadIdx.x & 63, gw = wblk * 8 + (threadIdx.x >> 6), NGW = nwblk * 8, c0 = lane * 16;
    f32x4 mg[4];
#pragma unroll
    for (int j = 0; j < 4; ++j) mg[j] = *(const f32x4*)(p.mh_g + c0 + 4 * j);
    for (int r = gw; r < NTOK; r += NGW) {
        const u32x4 h0 = *(const u32x4*)(H + (size_t)r * DM + c0), h1 = *(const u32x4*)(H + (size_t)r * DM + c0 + 8);
        const u32x4 o0 = *(const u32x4*)(Z + (size_t)r * ZC + Z_O + c0), o1 = *(const u32x4*)(Z + (size_t)r * ZC + Z_O + c0 + 8);
        const unsigned hw[8] = {h0.x, h0.y, h0.z, h0.w, h1.x, h1.y, h1.z, h1.w}, ow[8] = {o0.x, o0.y, o0.z, o0.w, o1.x, o1.y, o1.z, o1.w};
        float v[16]; float s = 0.f;
#pragma unroll
        for (int e = 0; e < 8; ++e) { v[2 * e] = bf_lo(hw[e]); v[2 * e + 1] = bf_hi(hw[e]); s += v[2 * e] + v[2 * e + 1]; }
        s += __shfl_xor(s, 1); s += __shfl_xor(s, 2); s += __shfl_xor(s, 4); s += __shfl_xor(s, 8);
        const float mean = s * (1.0f / 256.0f); float q = 0.f;
#pragma unroll
        for (int e = 0; e < 16; ++e) { v[e] -= mean; q += v[e] * v[e]; }
        q += __shfl_xor(q, 1); q += __shfl_xor(q, 2); q += __shfl_xor(q, 4); q += __shfl_xor(q, 8);
        const float rstd = 1.0f / sqrtf(q * (1.0f / 256.0f) + LN_EPS);
        unsigned ww[8];
#pragma unroll
        for (int e = 0; e < 8; ++e) { const float g0 = mg[(2 * e) >> 2][(2 * e) & 3], g1 = mg[(2 * e + 1) >> 2][(2 * e + 1) & 3];
            ww[e] = cvt_pk_bf16(v[2 * e] * rstd * g0 * bf_lo(ow[e]), v[2 * e + 1] * rstd * g1 * bf_hi(ow[e])); }
        u32x4 w0, w1; w0.x = ww[0]; w0.y = ww[1]; w0.z = ww[2]; w0.w = ww[3]; w1.x = ww[4]; w1.y = ww[5]; w1.z = ww[6]; w1.w = ww[7];
        *(u32x4*)(HN + (size_t)r * DM + c0) = w0; *(u32x4*)(HN + (size_t)r * DM + c0 + 8) = w1;
    }
}

template <bool OUT_F32>
__device__ __forceinline__ void ln_rows(const bf16_t* R, const float* gam, const float* bet, void* out, const float* SL, int NS, const float* xs, const bf16_t* X1) {
    const int lane = threadIdx.x & 63, gw = blockIdx.x * 8 + (threadIdx.x >> 6), NGW = gridDim.x * 8;
    f32x4 gv[4], bv[4];
#pragma unroll
    for (int j = 0; j < 4; ++j) { gv[j] = *(const f32x4*)(gam + j * 256 + lane * 4); bv[j] = *(const f32x4*)(bet + j * 256 + lane * 4); }
    for (int r = gw; r < NTOK; r += NGW) {
        f32x4 v[4]; float s = 0.f;
        if (r < NPROMPT) {
#pragma unroll
            for (int j = 0; j < 4; ++j) { const u32x2 w = *(const u32x2*)(R + (size_t)r * DM + j * 256 + lane * 4); v[j] = (f32x4){bf_lo(w.x), bf_hi(w.x), bf_lo(w.y), bf_hi(w.y)}; }
        } else {
            const int rs = r - NPROMPT;
#pragma unroll
            for (int j = 0; j < 4; ++j) { const int cc = j * 256 + lane * 4;
                if (xs) v[j] = *(const f32x4*)(xs + (size_t)rs * DM + cc) * ALPHA;
                else { const u32x2 w = *(const u32x2*)(X1 + (size_t)r * DM + cc); v[j] = (f32x4){bf_lo(w.x), bf_hi(w.x), bf_lo(w.y), bf_hi(w.y)} * ALPHA; }
                for (int k = 0; k < NS; ++k) v[j] += *(const f32x4*)(SL + ((size_t)k * NSAMPLE + rs) * DM + cc); }
        }
#pragma unroll
        for (int j = 0; j < 4; ++j) s += (v[j][0] + v[j][1]) + (v[j][2] + v[j][3]);
        const float mean = wave_sum(s) * (1.0f / DM); float q = 0.f;
#pragma unroll
        for (int j = 0; j < 4; ++j) { v[j] = v[j] - mean; q += (v[j][0] * v[j][0] + v[j][1] * v[j][1]) + (v[j][2] * v[j][2] + v[j][3] * v[j][3]); }
        const float rstd = 1.0f / sqrtf(wave_sum(q) * (1.0f / DM) + LN_EPS);
#pragma unroll
        for (int j = 0; j < 4; ++j) { const f32x4 y = v[j] * rstd * gv[j] + bv[j];
            if (OUT_F32) *(f32x4*)((float*)out + (size_t)r * DM + j * 256 + lane * 4) = y;
            else { u32x2 w; w.x = cvt_pk_bf16(y[0], y[1]); w.y = cvt_pk_bf16(y[2], y[3]); *(u32x2*)((bf16_t*)out + (size_t)r * DM + j * 256 + lane * 4) = w; } }
    }
}

__global__ void __launch_bounds__(512, 2) mega(Params p) {
    extern __shared__ __attribute__((aligned(16))) unsigned char shm_raw[];
    LAS unsigned char* lds = (LAS unsigned char*)shm_raw;
    const int G = gridDim.x, c = blockIdx.x;
    unsigned char* ws = p.ws;
    volatile LAS unsigned* xst = (volatile LAS unsigned*)(lds + 131072);
    if (threadIdx.x == 0) { xst[0] = 0u; xst[1] = 0u; }
    __syncthreads();
    const XcdBarrier xb = xcd_barrier_post((unsigned*)(ws + WS_BAR), xst);
    if (p.ph_hi > 64) cg::this_grid().sync();
#if MK_MULTI
#define PH_SYNC(k)
#else
#define PH_SYNC(k) do { if (p.ph_lo <= (k) && (k) + 1 < p.ph_hi) xcd_barrier(xb); } while (0)
#endif
#define PH_ON(k) (((PHMASK >> (k)) & 1) && p.ph_lo <= (k) && (k) < p.ph_hi)
#ifndef REPMASK
#define REPMASK 0
#endif
    if (PH_ON(0)) phase0(p, lds);
    PH_SYNC(0);
    if (PH_ON(1)) { pg8::StaticOrder S; S.init(NTOK, NZ, DM, G, c); pg8::Gemm g{(const bf16_t*)(ws + WS_XB), (const bf16_t*)(ws + WS_WIN), NTOK, NZ, DM};
        EpiZ E{(bf16_t*)(ws + WS_Z), (bf16_t*)(ws + WS_QKV), (bf16_t*)(ws + WS_KT)}; pg8::gemm_phase(lds, g, S, E);
        if (G == 256 && c >= 72) weight_items(p, lds, WI_IN, WI_ALL, (c - 72) * 8 + (threadIdx.x >> 6), (256 - 72) * 8); }
    PH_SYNC(1);
    if (PH_ON(2)) {
        const bool sample_first = ((c >> 6) & 1) != 0;
        if (sample_first) { for (int it = c; it < 512; it += G) { if (G == 256) mlstm_sample_item<false>(p, lds, it); else mlstm_sample_item<true>(p, lds, it); } }
        for (int it = c; it < 256; it += G) { const int xcd = it & 7, idx = it >> 3; mlstm_prompt_item(p, lds, xcd * 4 + (idx >> 3), idx & 7); }
        if (!sample_first) { for (int it = c; it < 512; it += G) { if (G == 256) mlstm_sample_item<false>(p, lds, it); else mlstm_sample_item<true>(p, lds, it); } }
        conv_items(p);
    }
    PH_SYNC(2);
    if (PH_ON(3)) {
        const int extra = (264 > G && 264 < 2 * G) ? 264 - G : 0;
        pg8::StaticOrder S; S.init(NTOK, DM, DM, G, c); pg8::Gemm g{(const bf16_t*)(ws + WS_AC), (const bf16_t*)(ws + WS_WC), NTOK, DM, DM};
        EpiGate E{(bf16_t*)(ws + WS_XB), nullptr, (const bf16_t*)(ws + WS_Z), Z_GC, 0}; pg8::gemm_phase(lds, g, S, E);
        if (c >= extra) { hn_items(p, c - extra, G - extra); if (G == 256) upd_slot(p, lds, 0, UPD_A, c - extra, G - extra); } }
    PH_SYNC(3);
    if (PH_ON(4)) { pg8::StaticOrder S; S.init(NTOK, DM, DM, G, c); pg8::Gemm g{(const bf16_t*)(ws + WS_HN), (const bf16_t*)(ws + WS_WM), NTOK, DM, DM};
        EpiGate E{(bf16_t*)(ws + WS_AC), (const bf16_t*)(ws + WS_XB), (const bf16_t*)(ws + WS_Z), Z_GM, 1}; pg8::gemm_phase(lds, g, S, E);
        if (G == 256 && c >= 8) upd_slot(p, lds, UPD_A, UPD_B, c - 8, 248); }
    PH_SYNC(4);
    if (PH_ON(5)) { pg8::SplitOrder S; S.init(DM, 4, G, c); pg8::Gemm g{(const bf16_t*)(ws + WS_AC), (const bf16_t*)(ws + WS_WO), NTOK, DM, DM};
        EpiResX E{(bf16_t*)(ws + WS_R), p.xp, p.xs, (float*)(ws + WS_KT)}; pg8::gemm_phase(lds, g, S, E); }
    PH_SYNC(5);
    if (PH_ON(6)) ln_rows<false>((const bf16_t*)(ws + WS_R), p.ln1g, p.ln1b, ws + WS_H, (const float*)(ws + WS_KT), 4, p.xs, nullptr);
    PH_SYNC(6);
    if (PH_ON(7)) { pg8::StaticOrder S; S.init(NTOK, DFF, DM, G, c); pg8::Gemm g{(const bf16_t*)(ws + WS_H), (const bf16_t*)(ws + WS_W1), NTOK, DFF, DM};
        EpiHid E{(bf16_t*)(ws + WS_HID)}; pg8::gemm_phase(lds, g, S, E);
        if (G == 256 && c >= 32) upd_slot(p, lds, UPD_B, 512, c - 32, 224); }
    PH_SYNC(7);
    if (PH_ON(8)) { pg8::SplitOrder S; S.init(DFF, 16, G, c); pg8::Gemm g{(const bf16_t*)(ws + WS_HID), (const bf16_t*)(ws + WS_W2), NTOK, DM, DFF};
        EpiResB E{(bf16_t*)(ws + WS_R), (const bf16_t*)(ws + WS_H), (float*)(ws + WS_KT)}; pg8::gemm_phase(lds, g, S, E); }
    PH_SYNC(8);
    if (PH_ON(9)) ln_rows<true>((const bf16_t*)(ws + WS_R), p.ln2g, p.ln2b, p.out + O_Y, (const float*)(ws + WS_KT), 16, nullptr, (const bf16_t*)(ws + WS_H));
#if MK_MULTI
    if (p.ph_lo == 11) { for (int it = c; it < 512; it += G) mlstm_sample_item<false>(p, lds, it); }
    if (p.ph_lo == 12) conv_items(p);
    if (p.ph_lo == 10) { for (int it = c; it < 256; it += G) { const int xcd = it & 7, idx = it >> 3; mlstm_prompt_item(p, lds, xcd * 4 + (idx >> 3), idx & 7); } }
#endif
}

extern "C" void kernel_launch(void* const* d_in, const int* in_sizes, int n_in, void* d_out, int out_size, void* d_ws, size_t ws_size, hipStream_t stream) {
    static int grid = 0;
    if (grid == 0) {
        if (n_in != 19 || ws_size < WS_END) { fprintf(stderr, "kernel_launch: unexpected inputs (n_in %d, ws %zu, need %zu)\n", n_in, ws_size, (size_t)WS_END); grid = -1; return; }
        int dev = 0, cus = 0, per_cu = 0;
        hipGetDevice(&dev); hipDeviceGetAttribute(&cus, hipDeviceAttributeMultiprocessorCount, dev);
        hipFuncSetAttribute((const void*)mega, hipFuncAttributeMaxDynamicSharedMemorySize, LDS_BYTES);
        hipOccupancyMaxActiveBlocksPerMultiprocessor(&per_cu, (const void*)mega, 512, LDS_BYTES);
        if (per_cu < 1 || cus < 1) { fprintf(stderr, "kernel_launch: occupancy query says %d blocks/CU on %d CUs\n", per_cu, cus); grid = -1; return; }
        grid = cus;
    }
    if (grid < 0) return;
    Params p{};
    const float** f = (const float**)&p;
    for (int i = 0; i < 19; ++i) f[i] = (const float*)d_in[i];
    p.out = (float*)d_out; p.ws = (unsigned char*)d_ws;
#if MK_MULTI
    for (int ph = 0; ph < 10; ++ph) for (int rep = 0; rep < ((REPMASK >> ph) & 1) + 1; ++rep) { p.ph_lo = ph; p.ph_hi = ph + 1; hipLaunchKernelGGL(mega, dim3(grid), dim3(512), LDS_BYTES, stream, p); }
#ifdef EXTRA_PH
    { p.ph_lo = EXTRA_PH; p.ph_hi = EXTRA_PH + 1; hipLaunchKernelGGL(mega, dim3(grid), dim3(512), LDS_BYTES, stream, p); }
#endif
#else
    p.ph_lo = 0; p.ph_hi = 10;
    if (hipMemsetAsync((char*)d_ws + WS_BAR, 0, 16384, stream) != hipSuccess) { fprintf(stderr, "memset failed\n"); return; }
    void* args[] = {&p};
    hipError_t e = hipLaunchCooperativeKernel((const void*)mega, dim3(grid), dim3(512), args, LDS_BYTES, stream);
    if (e != hipSuccess) fprintf(stderr, "cooperative launch failed: %s (grid %d)\n", hipGetErrorString(e), grid);
#endif
}
```
